# Optimizing an MI355X kernel written in HIP

```python
import jax, jax.numpy as jnp
from jax import lax
import numpy as np

D_MODEL = 1024
BATCH = 8
SEQ = 4096
DEPTH = 4

N_MIXERS = 4
GROUP_WIDTH = D_MODEL // N_MIXERS
HEAD_DIM = 64
FOX_HEADS = GROUP_WIDTH // HEAD_DIM
RET_HEADS = GROUP_WIDTH // HEAD_DIM
POOL_WINDOWS = (2, 4, 8, 16)
POOL_GROUPS = len(POOL_WINDOWS)
POOL_GROUP_DIM = GROUP_WIDTH // POOL_GROUPS
CONV_WIDTH = 31
CONV_CH = GROUP_WIDTH
N_IN = 3 * GROUP_WIDTH + FOX_HEADS + GROUP_WIDTH + 4 * GROUP_WIDTH + 2 * CONV_CH
D_FF = ((8 * D_MODEL + 3 * 256 - 1) // (3 * 256)) * 256
Q_BLOCK = 128
RET_CHUNK = 128
ROPE_BASE = 10000.0
EPS = 1e-6

kernel_name = "hymba_style_fox_pool_retnet_conformer_trunk"


def rmsnorm(x, g):
    xf = x.astype(jnp.float32)
    y = xf * lax.rsqrt(jnp.mean(xf * xf, axis=-1, keepdims=True) + EPS)
    return (y * g.astype(jnp.float32)).astype(x.dtype)


def layernorm(x, g, b):
    xf = x.astype(jnp.float32)
    mu = jnp.mean(xf, axis=-1, keepdims=True)
    var = jnp.mean(jnp.square(xf - mu), axis=-1, keepdims=True)
    y = (xf - mu) * lax.rsqrt(var + EPS)
    return (y * g.astype(jnp.float32) + b.astype(jnp.float32)).astype(x.dtype)


def rope(x, positions):
    half = x.shape[-1] // 2
    inv = ROPE_BASE ** (-jnp.arange(half, dtype=jnp.float32) / half)
    ang = positions.astype(jnp.float32)[..., None] * inv
    cos = jnp.cos(ang)[:, :, None, :]
    sin = jnp.sin(ang)[:, :, None, :]
    x1, x2 = x[..., :half], x[..., half:]
    return jnp.concatenate([x1 * cos - x2 * sin, x1 * sin + x2 * cos], axis=-1).astype(x.dtype)


def fox_attention(q, k, v, f_logit, f_bias):
    B, S, H, Dh = q.shape
    log_f = jax.nn.log_sigmoid((f_logit + f_bias).astype(jnp.float32))
    cum = jnp.cumsum(log_f, axis=1).transpose(0, 2, 1)
    key_pos = jnp.arange(S)
    scale = Dh ** -0.5

    def block(i):
        start = i * Q_BLOCK
        qb = lax.dynamic_slice_in_dim(q, start, Q_BLOCK, axis=1)
        cq = lax.dynamic_slice_in_dim(cum, start, Q_BLOCK, axis=2)
        s = jnp.einsum('bqhd,bkhd->bhqk', qb, k).astype(jnp.float32) * scale
        s = s + cq[..., :, None] - cum[:, :, None, :]
        q_pos = start + jnp.arange(Q_BLOCK)
        causal = key_pos[None, :] <= q_pos[:, None]
        s = jnp.where(causal, s, -jnp.inf)
        p = jax.nn.softmax(s, axis=-1).astype(v.dtype)
        return jnp.einsum('bhqk,bkhd->bqhd', p, v)

    out = lax.map(block, jnp.arange(S // Q_BLOCK))
    return out.transpose(1, 0, 2, 3, 4).reshape(B, S, H * Dh)


def pool_mixer(u, pool_w, pool_scale):
    B, S, _ = u.shape
    ug = u.reshape(B, S, POOL_GROUPS, POOL_GROUP_DIM)
    cs = jnp.cumsum(ug.astype(jnp.float32), axis=1)
    pos = jnp.arange(S)
    means = []
    for gi, w in enumerate(POOL_WINDOWS):
        c_g = cs[:, :, gi]
        shifted = jnp.pad(c_g, ((0, 0), (w, 0), (0, 0)))[:, :S]
        count = jnp.minimum(pos + 1, w).astype(jnp.float32)[None, :, None]
        means.append((c_g - shifted) / count)
    pooled = jnp.stack(means, axis=2)
    delta = (pooled - ug.astype(jnp.float32)).astype(u.dtype)
    mixed = jnp.einsum('bsgc,gcd->bsgd', delta, pool_w).reshape(B, S, GROUP_WIDTH)
    return mixed * pool_scale


def retention(q, k, v, g, positions, gn_g):
    B, S, H, Dh = q.shape
    q = rope(q, positions)
    k = rope(k, positions) * (Dh ** -0.5)
    log_gamma = jnp.log(1.0 - 2.0 ** (-5.0 - jnp.arange(H, dtype=jnp.float32)))
    C = RET_CHUNK
    NC = S // C
    idx = jnp.arange(C, dtype=jnp.float32)
    diff = idx[:, None] - idx[None, :]
    dmask = jnp.where(diff >= 0, jnp.exp(log_gamma[:, None, None] * jnp.maximum(diff, 0.0)), 0.0)
    zeta = jnp.exp(log_gamma[:, None] * (C - 1 - idx))
    xi = jnp.exp(log_gamma[:, None] * (idx + 1))
    chunk_decay = jnp.exp(log_gamma * C)

    qc = q.reshape(B, NC, C, H, Dh)
    kc = k.reshape(B, NC, C, H, Dh)
    vc = v.reshape(B, NC, C, H, Dh)
    intra_s = jnp.einsum('bnqhd,bnkhd->bnhqk', qc, kc) * dmask
    intra = jnp.einsum('bnhqk,bnkhe->bnqhe', intra_s, vc)
    kv = jnp.einsum('bnkhd,hk,bnkhe->bnhde', kc, zeta, vc)

    def step(state, xs):
        q_n, kv_n = xs
        cross = jnp.einsum('bqhd,bhde->bqhe', q_n, state)
        new = (state * chunk_decay[None, :, None, None] + kv_n).astype(state.dtype)
        return new, cross

    state0 = jnp.zeros((B, H, Dh, Dh), dtype=kv.dtype)
    _, cross = lax.scan(step, state0, (qc.transpose(1, 0, 2, 3, 4), kv.transpose(1, 0, 2, 3, 4)))
    cross = cross.transpose(1, 0, 2, 3, 4) * xi.T[None, None, :, :, None]
    o = (intra + cross).reshape(B, S, H, Dh).astype(jnp.float32)
    mu = jnp.mean(o, axis=-1, keepdims=True)
    var = jnp.mean(jnp.square(o - mu), axis=-1, keepdims=True)
    o = (o - mu) * lax.rsqrt(var + EPS) * gn_g.reshape(H, Dh).astype(jnp.float32)
    o = o.reshape(B, S, H * Dh).astype(g.dtype)
    return jax.nn.silu(g) * o


def conformer_conv(u, conv_w, conv_b, ln_g, ln_b):
    a, gate = jnp.split(u, 2, axis=-1)
    h = a * jax.nn.sigmoid(gate)
    h = lax.conv_general_dilated(
        h, conv_w[:, None, :], window_strides=(1,), padding=[(CONV_WIDTH - 1, 0)],
        dimension_numbers=('NWC', 'WIO', 'NWC'), feature_group_count=CONV_CH) + conv_b
    return jax.nn.silu(layernorm(h, ln_g, ln_b))


def setup_inputs(seed: int = 0) -> dict:
    key = jax.random.key(seed)
    ks = jax.random.split(key, 24)
    f32 = jnp.float32
    D, G = D_MODEL, GROUP_WIDTH
    nrm = lambda k, shape, s: jax.random.normal(k, shape, f32) * s
    return {
        "x": jax.random.normal(ks[0], (BATCH, SEQ, D), f32),
        "c": jax.random.normal(ks[1], (BATCH, D), f32),
        "positions": jnp.broadcast_to(jnp.arange(SEQ, dtype=jnp.int32)[None, :], (BATCH, SEQ)),
        "ada_w": nrm(ks[2], (DEPTH, D, 6 * D), 0.5 * D ** -0.5),
        "ada_b": nrm(ks[3], (DEPTH, 6 * D), 0.01),
        "norm_mix_g": 1.0 + nrm(ks[4], (DEPTH, D), 0.1),
        "norm_ffn_g": 1.0 + nrm(ks[5], (DEPTH, D), 0.1),
        "w_in": nrm(ks[6], (DEPTH, D, N_IN), D ** -0.5),
        "fox_fb": jax.random.uniform(ks[7], (DEPTH, FOX_HEADS), f32, 2.0, 5.0),
        "pool_w": nrm(ks[8], (DEPTH, POOL_GROUPS, POOL_GROUP_DIM, POOL_GROUP_DIM), POOL_GROUP_DIM ** -0.5),
        "pool_scale": 1.0 + nrm(ks[9], (DEPTH, G), 0.1),
        "ret_gn_g": 1.0 + nrm(ks[10], (DEPTH, G), 0.1),
        "conv_w": nrm(ks[11], (DEPTH, CONV_WIDTH, CONV_CH), CONV_WIDTH ** -0.5),
        "conv_b": nrm(ks[12], (DEPTH, CONV_CH), 0.01),
        "conv_ln_g": 1.0 + nrm(ks[13], (DEPTH, CONV_CH), 0.1),
        "conv_ln_b": nrm(ks[14], (DEPTH, CONV_CH), 0.01),
        "w_out": nrm(ks[15], (DEPTH, D, D), D ** -0.5),
        "ffn_w1": nrm(ks[16], (DEPTH, D, D_FF), D ** -0.5),
        "ffn_w3": nrm(ks[17], (DEPTH, D, D_FF), D ** -0.5),
        "ffn_w2": nrm(ks[18], (DEPTH, D_FF, D), D_FF ** -0.5),
        "final_g": 1.0 + nrm(ks[19], (D,), 0.1),
    }


def reference(x, c, positions, ada_w, ada_b, norm_mix_g, norm_ffn_g, w_in, fox_fb,
              pool_w, pool_scale, ret_gn_g, conv_w, conv_b, conv_ln_g, conv_ln_b,
              w_out, ffn_w1, ffn_w3, ffn_w2, final_g):
    B, S, _ = x.shape
    G, H, Dh = GROUP_WIDTH, FOX_HEADS, HEAD_DIM
    bounds = [G, 2 * G, 3 * G, 3 * G + H,
              4 * G + H,
              5 * G + H, 6 * G + H, 7 * G + H, 8 * G + H]
    c_act = jax.nn.silu(c)
    for l in range(DEPTH):
        mod = (c_act @ ada_w[l] + ada_b[l])[:, None, :]
        sh1, sc1, g1, sh2, sc2, g2 = jnp.split(mod, 6, axis=-1)

        h = rmsnorm(x, norm_mix_g[l]) * (1.0 + sc1) + sh1
        u = h @ w_in[l]
        fq, fk, fv, ff, pu, rq, rk, rv, rg, cu = jnp.split(u, bounds, axis=-1)
        y_fox = fox_attention(fq.reshape(B, S, H, Dh), fk.reshape(B, S, H, Dh),
                              fv.reshape(B, S, H, Dh), ff, fox_fb[l])
        y_pool = pool_mixer(pu, pool_w[l], pool_scale[l])
        y_ret = retention(rq.reshape(B, S, RET_HEADS, Dh), rk.reshape(B, S, RET_HEADS, Dh),
                          rv.reshape(B, S, RET_HEADS, Dh), rg, positions, ret_gn_g[l])
        y_conv = conformer_conv(cu, conv_w[l], conv_b[l], conv_ln_g[l], conv_ln_b[l])
        mix = jnp.concatenate([y_fox, y_pool, y_ret, y_conv], axis=-1)
        x = x + g1 * (mix @ w_out[l])

        h = rmsnorm(x, norm_ffn_g[l]) * (1.0 + sc2) + sh2
        f = (jax.nn.silu(h @ ffn_w1[l]) * (h @ ffn_w3[l])) @ ffn_w2[l]
        x = x + g2 * f
    return rmsnorm(x, final_g)
```

```cpp
#include <hip/hip_runtime.h>
#include <hip/hip_cooperative_groups.h>
#include <cstdio>
#include <cstdint>
namespace pg8 {
#define PG8_LAS __attribute__((address_space(3)))
typedef unsigned short bf16_t;
typedef short bf16x8 __attribute__((ext_vector_type(8)));
typedef float f32x4 __attribute__((ext_vector_type(4)));
typedef unsigned u32x4 __attribute__((ext_vector_type(4)));
constexpr int BM = 256, BK = 64, HALF = 128, HTB = HALF * BK * 2  , STAGE_BYTES = 8 * HTB, NXCD = 8, WGM = 8;

__host__ __device__ __forceinline__ int lds_byte(int r, int c) { const int st = (r >> 4) * 2 + (c >> 5), rr = r & 15, cc = c & 31, ob = rr * 64 + cc * 2; return st * 1024 + (ob ^ (((ob >> 9) & 1) << 5)); }
__host__ __device__ __forceinline__ void stage_rc(int b, int& R, int& C) { const int st = b / 1024, sb = b % 1024, swz = sb ^ (((sb >> 9) & 1) << 5); R = (st >> 1) * 16 + swz / 64; C = (st & 1) * 32 + (swz % 64) / 2; }
__host__ __device__ __forceinline__ int perm32(int rho) { const int n = rho >> 4, i = rho & 15; return 8 * (i >> 2) + 4 * n + (i & 3); }

struct Unit { int pm, pn; };
struct Gemm { const bf16_t* A; const bf16_t* Bt; int M, N, K; };

struct StaticOrder {
    int nM, nN, nwg, G, c;
    __host__ __device__ void init(int M, int N, int G_, int c_) { nM = M / BM; nN = N / BM; nwg = nM * nN; G = G_; c = c_; }
    __host__ __device__ bool next(int i, Unit& u) const {
        const long L = (long)i * G + c; if (L >= nwg) return false;
        int wgid = (int)L; { const int q = nwg / NXCD, r = nwg % NXCD, xcd = wgid % NXCD, off = wgid / NXCD; wgid = (xcd < r ? xcd * (q + 1) : r * (q + 1) + (xcd - r) * q) + off; }
        const int nig = WGM * nN, gid = wgid / nig, fm = gid * WGM, gsz = (nM - fm) < WGM ? (nM - fm) : WGM;
        u.pm = fm + ((wgid % nig) % gsz); u.pn = (wgid % nig) / gsz; return true;
    }
    __device__ __forceinline__ void a_ready(const Unit&) const {}
    __device__ __forceinline__ void done(const Unit&) const {}
};

__device__ __forceinline__ unsigned cvt_pk_bf16(float lo, float hi) { unsigned r; asm volatile("v_cvt_pk_bf16_f32 %0, %1, %2" : "=v"(r) : "v"(lo), "v"(hi)); return r; }
typedef float f32x2 __attribute__((ext_vector_type(2)));
__device__ __forceinline__ float silu_f(float v) { return v * __builtin_amdgcn_rcpf(1.0f + __builtin_amdgcn_exp2f(-1.4426950408889634f * v)); }
struct EpiU {
    static constexpr bool PERM = true, AFTER_DRAIN = false;
    bf16_t* O; int ldc; float s0;
    __device__ __forceinline__ void operator()(const f32x4 (&acc)[2][2][4][2], const Unit& u, int wr, int wc, int fr, int fq) const {
        const int row0 = u.pm * BM + wr * 64 + fr, col0 = u.pn * BM + wc * 32 + 8 * fq;
        const float sc = (u.pn == 0) ? s0 : 1.f;
#pragma unroll
        for (int ai = 0; ai < 2; ++ai)
#pragma unroll
            for (int m = 0; m < 4; ++m) { bf16_t* rowp = O + (size_t)(row0 + ai * HALF + m * 16) * ldc + col0;
#pragma unroll
                for (int bj = 0; bj < 2; ++bj) { const f32x4 v0 = acc[ai][bj][m][0] * sc, v1 = acc[ai][bj][m][1] * sc;
                    u32x4 w; w.x = cvt_pk_bf16(v0[0], v0[1]); w.y = cvt_pk_bf16(v0[2], v0[3]); w.z = cvt_pk_bf16(v1[0], v1[1]); w.w = cvt_pk_bf16(v1[2], v1[3]);
                    *(u32x4*)(rowp + bj * HALF) = w; } }
    }
};
struct EpiRes {
    static constexpr bool PERM = false, AFTER_DRAIN = false;
    const float* base; float* out; const float* gate;
    __device__ __forceinline__ void operator()(const f32x4 (&acc)[2][2][4][2], const Unit& u, int wr, int wc, int fr, int fq) const {
        const float* gp = gate + (size_t)(u.pm >> 4) * 6144;
        const int col0 = u.pn * BM + wc * 32 + 4 * fq;
        f32x4 gv[2][2];
#pragma unroll
        for (int bj = 0; bj < 2; ++bj)
#pragma unroll
            for (int n = 0; n < 2; ++n) gv[bj][n] = *(const f32x4*)(gp + col0 + bj * HALF + n * 16);
#pragma unroll
        for (int ai = 0; ai < 2; ++ai)
#pragma unroll
            for (int m = 0; m < 4; ++m) { const size_t off = (size_t)(u.pm * BM + ai * HALF + wr * 64 + m * 16 + fr) * 1024 + col0;
#pragma unroll
                for (int bj = 0; bj < 2; ++bj)
#pragma unroll
                    for (int n = 0; n < 2; ++n) { const f32x4 bs = *(const f32x4*)(base + off + bj * HALF + n * 16);
                        *(f32x4*)(out + off + bj * HALF + n * 16) = bs + gv[bj][n] * acc[ai][bj][m][n]; } }
    }
};
struct EpiSwiGLU {
    static constexpr bool PERM = true, AFTER_DRAIN = false;
    bf16_t* O; int ldc;
    __device__ __forceinline__ void operator()(const f32x4 (&acc)[2][2][4][2], const Unit& u, int wr, int wc, int fr, int fq) const {
        const int row0 = u.pm * BM + wr * 64 + fr, col0 = u.pn * HALF + wc * 32 + 8 * fq;
#pragma unroll
        for (int ai = 0; ai < 2; ++ai)
#pragma unroll
            for (int m = 0; m < 4; ++m) { bf16_t* rowp = O + (size_t)(row0 + ai * HALF + m * 16) * ldc + col0;
                const f32x4 a0 = acc[ai][0][m][0], a1 = acc[ai][0][m][1], b0 = acc[ai][1][m][0], b1 = acc[ai][1][m][1];
                u32x4 w; w.x = cvt_pk_bf16(silu_f(a0[0]) * b0[0], silu_f(a0[1]) * b0[1]); w.y = cvt_pk_bf16(silu_f(a0[2]) * b0[2], silu_f(a0[3]) * b0[3]);
                w.z = cvt_pk_bf16(silu_f(a1[0]) * b1[0], silu_f(a1[1]) * b1[1]); w.w = cvt_pk_bf16(silu_f(a1[2]) * b1[2], silu_f(a1[3]) * b1[3]);
                *(u32x4*)rowp = w; }
    }
};
template <class Epi, class Sched, bool ALIGN_EPI = false, bool SP2 = false>
__device__ __forceinline__ void gemm_phase(PG8_LAS unsigned char* lds, const Gemm g, const Sched& S, const Epi& E) {
    int tid_ = threadIdx.x; asm volatile("" : "+v"(tid_));
    const int tid = tid_, wid = __builtin_amdgcn_readfirstlane(tid >> 6), lane = tid & 63, wr = wid >> 2, wc = wid & 3, fr = lane & 15, fq = lane >> 4;
    const int K = g.K, nt = K / BK;
    unsigned voffA[2], voffB[2];
#pragma unroll
    for (int i = 0; i < 2; ++i) { int R, C; stage_rc(tid * 16 + i * 8192, R, C); const int Rb = Epi::PERM ? ((R & ~31) + perm32(R & 31)) : R;
        voffA[i] = (unsigned)(R * K + C) * 2u; voffB[i] = (unsigned)(Rb * K + C) * 2u; }
    const size_t kstep = (size_t)(BK * 2);
    const size_t hstep = (size_t)HALF * K * 2;
    const size_t tstep = 2 * hstep;
    const unsigned ldsw = (unsigned)wid * 1024u;
    const int aoff = lds_byte(wr * 64 + fr, fq * 8), boff = lds_byte(wc * 32 + fr, fq * 8);
#define PG8_SA(b, h) (((b) * 2 + (h)) * HTB)
#define PG8_SB(b, h) ((4 + (b) * 2 + (h)) * HTB)
#define PG8_STAGE(bufoff, gbase, voff) do { _Pragma("unroll") for (int _i = 0; _i < 2; ++_i) \
        __builtin_amdgcn_global_load_lds((const unsigned*)((const char*)(gbase) + (voff)[_i]), (PG8_LAS unsigned*)(lds + (bufoff) + ldsw + _i * 8192), 16, 0, 0); } while (0)
#define PG8_LDA(dst, b, h) do { _Pragma("unroll") for (int m = 0; m < 4; ++m) _Pragma("unroll") for (int k = 0; k < 2; ++k) dst[m][k] = *(const PG8_LAS bf16x8*)(lds + PG8_SA(b, h) + aoff + m * 2048 + k * 1024); } while (0)
#define PG8_LDB(dst, b, h) do { _Pragma("unroll") for (int n = 0; n < 2; ++n) _Pragma("unroll") for (int k = 0; k < 2; ++k) dst[n][k] = *(const PG8_LAS bf16x8*)(lds + PG8_SB(b, h) + boff + n * 2048 + k * 1024); } while (0)
#define PG8_MMA(ai, bj, At, Bt) do { __builtin_amdgcn_s_setprio(1); _Pragma("unroll") for (int m = 0; m < 4; ++m) _Pragma("unroll") for (int n = 0; n < 2; ++n) _Pragma("unroll") for (int k = 0; k < 2; ++k) \
        acc[ai][bj][m][n] = __builtin_amdgcn_mfma_f32_16x16x32_bf16(Bt[n][k], At[m][k], acc[ai][bj][m][n], 0, 0, 0); __builtin_amdgcn_s_setprio(0); } while (0)
#define PG8_WAIT_V(n) asm volatile("s_waitcnt vmcnt(" #n ")" ::: "memory")
#define PG8_WAIT_L(n) asm volatile("s_waitcnt lgkmcnt(" #n ")" ::: "memory")
#define PG8_BAR __builtin_amdgcn_s_barrier()
#define PG8_SCHED __builtin_amdgcn_sched_barrier(0)
    Unit cur, nxt; int ui = 0;
    if (!S.next(0, cur)) return;
    f32x4 acc[2][2][4][2];
#pragma unroll
    for (int a = 0; a < 2; ++a)
#pragma unroll
        for (int b = 0; b < 2; ++b)
#pragma unroll
            for (int m = 0; m < 4; ++m)
#pragma unroll
                for (int n = 0; n < 2; ++n) acc[a][b][m][n] = (f32x4){0.f, 0.f, 0.f, 0.f};
    bf16x8 At[4][2], B0[2][2], B1[2][2];
    const char* cA = (const char*)g.A + (size_t)cur.pm * tstep; const char* cB = (const char*)g.Bt + (size_t)cur.pn * tstep;
    S.a_ready(cur);
    if constexpr (SP2) {
        PG8_STAGE(PG8_SB(0, 0), cB, voffB); PG8_STAGE(PG8_SB(0, 1), cB + hstep, voffB); PG8_STAGE(PG8_SA(0, 0), cA, voffA); PG8_STAGE(PG8_SA(0, 1), cA + hstep, voffA);
        if (wr == 1) PG8_BAR;
        PG8_WAIT_V(2); PG8_BAR;
        PG8_STAGE(PG8_SB(1, 0), cB + kstep, voffB); PG8_STAGE(PG8_SA(1, 0), cA + kstep, voffA); PG8_STAGE(PG8_SB(1, 1), cB + hstep + kstep, voffB);
        PG8_WAIT_V(6); PG8_BAR;
    } else {
        PG8_STAGE(PG8_SB(0, 0), cB, voffB); PG8_STAGE(PG8_SA(0, 0), cA, voffA); PG8_STAGE(PG8_SB(0, 1), cB + hstep, voffB); PG8_STAGE(PG8_SA(0, 1), cA + hstep, voffA);
        if (wr == 1) PG8_BAR;
        PG8_WAIT_V(4); PG8_BAR;
        PG8_STAGE(PG8_SB(1, 0), cB + kstep, voffB); PG8_STAGE(PG8_SA(1, 0), cA + kstep, voffA); PG8_STAGE(PG8_SB(1, 1), cB + hstep + kstep, voffB);
        PG8_WAIT_V(6); PG8_BAR;
    }
    for (;;) {
        const bool has_next = S.next(ui + 1, nxt);
        const char* nA = has_next ? (const char*)g.A + (size_t)nxt.pm * tstep : cA; const char* nB = has_next ? (const char*)g.Bt + (size_t)nxt.pn * tstep : cB;
        for (int t = 0; t < nt; t += 2) {
            const bool last = (t == nt - 2);
            const char* a1 = cA + (size_t)(t + 1) * kstep;
            const char* a2 = last ? nA : cA + (size_t)(t + 2) * kstep; const char* b2 = last ? nB : cB + (size_t)(t + 2) * kstep;
            const char* a3 = a2 + kstep; const char* b3 = b2 + kstep;
            if (last && has_next) S.a_ready(nxt);
            if constexpr (SP2) {
            PG8_LDB(B0, 0, 0); PG8_LDB(B1, 0, 1); PG8_SCHED; PG8_LDA(At, 0, 0); PG8_STAGE(PG8_SA(1, 1), a1 + hstep, voffA);
            PG8_WAIT_V(8); PG8_WAIT_L(0); PG8_BAR; PG8_MMA(0, 0, At, B0); PG8_MMA(0, 1, At, B1); PG8_BAR; PG8_SCHED;
            PG8_LDA(At, 0, 1); PG8_STAGE(PG8_SB(0, 0), b2, voffB); PG8_STAGE(PG8_SB(0, 1), b2 + hstep, voffB); PG8_STAGE(PG8_SA(0, 0), a2, voffA);
            PG8_WAIT_V(8); PG8_WAIT_L(0); PG8_BAR; PG8_MMA(1, 0, At, B0); PG8_MMA(1, 1, At, B1); PG8_BAR; PG8_SCHED;
            PG8_LDB(B0, 1, 0); PG8_LDB(B1, 1, 1); PG8_SCHED; PG8_LDA(At, 1, 0); PG8_STAGE(PG8_SA(0, 1), a2 + hstep, voffA);
            PG8_WAIT_V(8); PG8_WAIT_L(0); PG8_BAR; PG8_MMA(0, 0, At, B0); PG8_MMA(0, 1, At, B1); PG8_BAR; PG8_SCHED;
            PG8_LDA(At, 1, 1); PG8_STAGE(PG8_SB(1, 0), b3, voffB); PG8_STAGE(PG8_SB(1, 1), b3 + hstep, voffB); PG8_STAGE(PG8_SA(1, 0), a3, voffA);
            PG8_WAIT_V(8); PG8_WAIT_L(0); PG8_BAR; PG8_MMA(1, 0, At, B0); PG8_MMA(1, 1, At, B1); PG8_BAR; PG8_SCHED;
            } else {
            PG8_LDB(B0, 0, 0); PG8_SCHED; PG8_LDA(At, 0, 0); PG8_STAGE(PG8_SA(1, 1), a1 + hstep, voffA);
            PG8_WAIT_L(8); PG8_BAR; PG8_WAIT_L(0); PG8_MMA(0, 0, At, B0); PG8_BAR; PG8_SCHED;
            PG8_LDB(B1, 0, 1); PG8_STAGE(PG8_SB(0, 0), b2, voffB);
            PG8_BAR; PG8_WAIT_L(0); PG8_MMA(0, 1, At, B1); PG8_BAR;
            PG8_LDA(At, 0, 1); PG8_STAGE(PG8_SA(0, 0), a2, voffA);
            PG8_BAR; PG8_WAIT_L(0); PG8_MMA(1, 0, At, B0); PG8_BAR; PG8_SCHED;
            PG8_STAGE(PG8_SB(0, 1), b2 + hstep, voffB);
            PG8_WAIT_V(6); PG8_BAR; PG8_MMA(1, 1, At, B1); PG8_BAR;
            PG8_LDB(B0, 1, 0); PG8_SCHED; PG8_LDA(At, 1, 0); PG8_STAGE(PG8_SA(0, 1), a2 + hstep, voffA);
            PG8_WAIT_L(8); PG8_BAR; PG8_WAIT_L(0); PG8_MMA(0, 0, At, B0); PG8_BAR; PG8_SCHED;
            PG8_LDB(B1, 1, 1); PG8_STAGE(PG8_SB(1, 0), b3, voffB);
            PG8_BAR; PG8_WAIT_L(0); PG8_MMA(0, 1, At, B1); PG8_BAR;
            PG8_LDA(At, 1, 1); PG8_STAGE(PG8_SA(1, 0), a3, voffA);
            PG8_BAR; PG8_WAIT_L(0); PG8_MMA(1, 0, At, B0); PG8_BAR; PG8_SCHED;
            PG8_STAGE(PG8_SB(1, 1), b3 + hstep, voffB);
            PG8_WAIT_V(6); PG8_BAR; PG8_MMA(1, 1, At, B1); PG8_BAR;
            }
        }
        if constexpr (ALIGN_EPI) { if (wr == 0) PG8_BAR; }
        if constexpr (!Epi::AFTER_DRAIN) { E(acc, cur, wr, wc, fr, fq); S.done(cur); }
        if (!has_next) break;
#pragma unroll
        for (int a = 0; a < 2; ++a)
#pragma unroll
            for (int b = 0; b < 2; ++b)
#pragma unroll
                for (int m = 0; m < 4; ++m)
#pragma unroll
                    for (int n = 0; n < 2; ++n) acc[a][b][m][n] = (f32x4){0.f, 0.f, 0.f, 0.f};
        cur = nxt; cA = nA; cB = nB; ++ui;
        if constexpr (ALIGN_EPI) { if (wr == 1) PG8_BAR; }
    }
    PG8_WAIT_V(0);
    if constexpr (!ALIGN_EPI) { if (wr == 0) PG8_BAR; }
    PG8_BAR;
    if constexpr (Epi::AFTER_DRAIN) { E.fused(acc, cur, wr, wc, fr, fq, lds, wid, lane); S.done(cur); }
#undef PG8_SA
#undef PG8_SB
#undef PG8_STAGE
#undef PG8_LDA
#undef PG8_LDB
#undef PG8_MMA
#undef PG8_WAIT_V
#undef PG8_WAIT_L
#undef PG8_BAR
#undef PG8_SCHED
}
}
#include <hip/hip_bf16.h>
#include <cmath>
namespace attn_body {
using bf16=__hip_bfloat16;
using bf16x8=__attribute__((ext_vector_type(8)))short;
using s16x4=__attribute__((ext_vector_type(4)))short;
using f32x16=__attribute__((ext_vector_type(16)))float;
using u32x4=__attribute__((ext_vector_type(4)))unsigned;
constexpr int BATCH=8,NHEAD=4,SEQ=4096,D=64,DM=2560,DMO=1024;
constexpr int NW=8,QBLK=32,QB=QBLK*NW,KVBLK=64,NQB=SEQ/QB;
constexpr int ATTN_PITCH=DM, ATTN_UNIT_ROWS=QB;
__device__ __forceinline__ int crow(int r,int hi){return (r&3)+8*(r>>2)+4*hi;}
#define SBAR() __builtin_amdgcn_sched_barrier(0)
__device__ __forceinline__ void cmask(f32x16&p0,f32x16&p1,int jb,int qrel,int hi){
  const float NEG=-INFINITY; int kb=64*jb+4*hi;
  #pragma unroll
  for(int r=0;r<16;++r){int kv=kb+(r&3)+8*(r>>2); if(kv>qrel)p0[r]=NEG; if(kv+32>qrel)p1[r]=NEG;}
}

constexpr int NSLOT=3, SLOTB=8192;
constexpr int LDS_K=0, LDS_V=NSLOT*SLOTB, LDS_WS=2*NSLOT*SLOTB, LDS_OST=LDS_WS+NW*64*4, LDS_CUM=LDS_OST+NW*4096, LDS_BYTES=LDS_CUM+SEQ*4;
constexpr float C2=0.125f*1.4426950408889634f;
__device__ __forceinline__ void glds16(const void*gsrc,unsigned lds_dst){unsigned keep;
  asm volatile("s_mov_b32 %0, m0\n\ts_mov_b32 m0, %2\n\ts_nop 0\n\tglobal_load_lds_dwordx4 %1, off\n\ts_mov_b32 m0, %0":"=&s"(keep):"v"(gsrc),"s"(lds_dst):"memory");}
__device__ __forceinline__ float max3f(float a,float b,float c){float r;asm("v_max3_f32 %0, %1, %2, %3":"=v"(r):"v"(a),"v"(b),"v"(c));return r;}
__device__ __forceinline__ float max2f(float a,float b){float r;asm("v_max_f32_e32 %0, %1, %2":"=v"(r):"v"(a),"v"(b));return r;}
__device__ __forceinline__ float fadd_s(float a,float b){float r;asm("v_add_f32_e32 %0, %1, %2":"=v"(r):"v"(a),"v"(b));return r;}
__device__ __forceinline__ float fsub_s(float a,float b){float r;asm("v_sub_f32_e32 %0, %1, %2":"=v"(r):"v"(a),"v"(b));return r;}
typedef float f32x2_t __attribute__((ext_vector_type(2))); typedef __bf16 bf16x2_t __attribute__((ext_vector_type(2)));
__device__ __forceinline__ unsigned cvtpk_s(float lo,float hi){f32x2_t v={lo,hi};bf16x2_t b=__builtin_convertvector(v,bf16x2_t);return __builtin_bit_cast(unsigned,b);}
#define WAIT_BAR(N) asm volatile("s_waitcnt vmcnt(" #N ") lgkmcnt(0)\n\ts_barrier":::"memory")

__device__ __forceinline__ void qkt(f32x16&p0,f32x16&p1,const char*Kslot,const bf16x8*qr,const f32x16&negm,int r32,int hi){
  const char*kb=Kslot+hi*1024+r32*16;
  #pragma unroll
  for(int d0=0;d0<4;++d0){
    const bf16x8 b0=*reinterpret_cast<const bf16x8*>(kb+d0*2048);
    const bf16x8 b1=*reinterpret_cast<const bf16x8*>(kb+d0*2048+512);
    if(d0==0){p0=__builtin_amdgcn_mfma_f32_32x32x16_bf16(b0,qr[0],negm,0,0,0);p1=__builtin_amdgcn_mfma_f32_32x32x16_bf16(b1,qr[0],negm,0,0,0);}
    else{p0=__builtin_amdgcn_mfma_f32_32x32x16_bf16(b0,qr[d0],p0,0,0,0);p1=__builtin_amdgcn_mfma_f32_32x32x16_bf16(b1,qr[d0],p1,0,0,0);}}
}
typedef __attribute__((address_space(3))) const char* lds_cptr;
typedef short v4i16_t __attribute__((ext_vector_type(4)));
__device__ __forceinline__ void kload8(bf16x8*kf,lds_cptr kp){
  kf[0]=*(const __attribute__((address_space(3))) bf16x8*)(kp);      kf[1]=*(const __attribute__((address_space(3))) bf16x8*)(kp+512);
  kf[2]=*(const __attribute__((address_space(3))) bf16x8*)(kp+2048); kf[3]=*(const __attribute__((address_space(3))) bf16x8*)(kp+2560);
  kf[4]=*(const __attribute__((address_space(3))) bf16x8*)(kp+4096); kf[5]=*(const __attribute__((address_space(3))) bf16x8*)(kp+4608);
  kf[6]=*(const __attribute__((address_space(3))) bf16x8*)(kp+6144); kf[7]=*(const __attribute__((address_space(3))) bf16x8*)(kp+6656);
}
__device__ __forceinline__ void kload2(bf16x8*kf,lds_cptr kp,int j){ kf[2*j]=*(const __attribute__((address_space(3))) bf16x8*)(kp+j*2048); kf[2*j+1]=*(const __attribute__((address_space(3))) bf16x8*)(kp+j*2048+512); }
__device__ __forceinline__ s16x4 vtr(lds_cptr p){ return __builtin_bit_cast(s16x4,__builtin_amdgcn_ds_read_tr16_b64_v4i16((__attribute__((address_space(3))) v4i16_t*)p)); }
__device__ __forceinline__ float rowmax(const f32x16&p0,const f32x16&p1){
  float a=max3f(p0[0],p0[1],p1[0]),b=max3f(p0[2],p0[3],p1[1]);a=max3f(a,p1[2],p1[3]);
  #pragma unroll
  for(int r=4;r<16;r+=4){a=max3f(a,p0[r],p0[r+1]);b=max3f(b,p0[r+2],p0[r+3]);a=max3f(a,p1[r],p1[r+1]);b=max3f(b,p1[r+2],p1[r+3]);}
  const float m=max2f(a,b);
  auto rr=__builtin_amdgcn_permlane32_swap(__float_as_uint(m),__float_as_uint(m),false,false);
  return max2f(__uint_as_float(rr[0]),__uint_as_float(rr[1]));
}
__device__ __forceinline__ void pv(f32x16*o,int vb,bf16x8 pa0,bf16x8 pa1,bf16x8 pa2,bf16x8 pa3){
  #pragma unroll
  for(int d0=0;d0<2;++d0){s16x4 lo[4],hi[4];
    #pragma unroll
    for(int ks=0;ks<4;++ks){
      asm volatile("ds_read_b64_tr_b16 %0,%1 offset:%c2":"=&v"(lo[ks]):"v"(vb),"i"(d0*4096+ks*1024):"memory");
      asm volatile("ds_read_b64_tr_b16 %0,%1 offset:%c2":"=&v"(hi[ks]):"v"(vb),"i"(d0*4096+ks*1024+512):"memory");}
    asm volatile("s_waitcnt lgkmcnt(0)":::"memory");SBAR();
    #define PK(k) (bf16x8){lo[k][0],lo[k][1],lo[k][2],lo[k][3],hi[k][0],hi[k][1],hi[k][2],hi[k][3]}
    o[d0]=__builtin_amdgcn_mfma_f32_32x32x16_bf16(pa0,PK(0),o[d0],0,0,0);
    o[d0]=__builtin_amdgcn_mfma_f32_32x32x16_bf16(pa1,PK(1),o[d0],0,0,0);
    o[d0]=__builtin_amdgcn_mfma_f32_32x32x16_bf16(pa2,PK(2),o[d0],0,0,0);
    o[d0]=__builtin_amdgcn_mfma_f32_32x32x16_bf16(pa3,PK(3),o[d0],0,0,0);
    #undef PK
  }
}

#ifndef ATTN_STORE16
#define ATTN_STORE16(p,v) (*(u32x4*)(p)=(v))
#endif
template<int THRL> __device__ __forceinline__ void attn_unit(int b,int h,int qb,const bf16*Q,const bf16*__restrict__ K,const bf16*__restrict__ V,bf16*O,const float*__restrict__ cumg,char*shm){
  int tid_=threadIdx.x; asm volatile("":"+v"(tid_)); const int tid=tid_,lane=tid&63,r32=lane&31,hi=lane>>5; const int wid=__builtin_amdgcn_readfirstlane(tid>>6);
  const long rowbase=(long)b*SEQ; const int q0=qb*QB;
  typedef float f32x4_t __attribute__((ext_vector_type(4)));
  { __attribute__((address_space(3))) f32x4_t* cl=(__attribute__((address_space(3))) f32x4_t*)((__attribute__((address_space(3))) char*)shm+LDS_CUM);
    const f32x4_t* cgp=(const f32x4_t*)cumg; for(int i=tid;i<(q0+QB)/4;i+=NW*64)cl[i]=cgp[i]; }
  const float cqL=cumg[q0+wid*QBLK+r32];
  const __attribute__((address_space(3))) f32x4_t* cumq=(const __attribute__((address_space(3))) f32x4_t*)((__attribute__((address_space(3))) char*)shm+LDS_CUM)+hi;
  #define KBIAS(P0,P1,t) do{ const __attribute__((address_space(3))) f32x4_t* cb_=cumq+16*(t); _Pragma("unroll") for(int g_=0;g_<4;++g_){ const f32x4_t a_=cb_[2*g_], b_=cb_[8+2*g_]; \
      P0[4*g_]+=cqm-a_[0];P0[4*g_+1]+=cqm-a_[1];P0[4*g_+2]+=cqm-a_[2];P0[4*g_+3]+=cqm-a_[3]; P1[4*g_]+=cqm-b_[0];P1[4*g_+1]+=cqm-b_[1];P1[4*g_+2]+=cqm-b_[2];P1[4*g_+3]+=cqm-b_[3]; } }while(0)
  const bf16*Qw=Q+(rowbase+q0+wid*QBLK)*DM+h*D;
  const bf16*Kh=K+rowbase*DM+h*D,*Vh=V+rowbase*DM+h*D;
  const unsigned lds0=(unsigned)(uintptr_t)shm;
  float*wsf=(float*)(shm+LDS_WS)+wid*64;
  const bf16*ksrc=Kh+(long)lane*DM+wid*8;
  const bf16*vsrc=Vh+(long)(16*(wid&3)+(lane>>2))*DM+(wid>>2)*32+(lane&3)*8;
  const unsigned kdst=lds0+LDS_K+wid*1024, vdst=lds0+LDS_V+wid*1024;
  #define DMA_K(t,slot) glds16(ksrc+(long)(t)*KVBLK*DM,(unsigned)__builtin_amdgcn_readfirstlane(kdst+(slot)))
  #define DMA_V(t,slot) glds16(vsrc+(long)(t)*KVBLK*DM,(unsigned)__builtin_amdgcn_readfirstlane(vdst+(slot)))
  const int vb0=(int)(lds0+LDS_V)+((lane>>4)&1)*32+(lane&3)*8+(4*hi+((lane&15)>>2))*64;
  const char*Kbase=shm+LDS_K; bf16x8 kf[8];
  const lds_cptr shm3=(lds_cptr)shm; const lds_cptr kp0=shm3+LDS_K+hi*1024+r32*16; const lds_cptr vp0=shm3+LDS_V+((lane>>4)&1)*32+(lane&3)*8+(4*hi+((lane&15)>>2))*64;
  const int NT=(q0+QB)/KVBLK;
  DMA_K(0,0);DMA_V(0,0);DMA_K(1,SLOTB);
  bf16x8 qr[4];
  #pragma unroll
  for(int d0=0;d0<4;++d0)qr[d0]=*reinterpret_cast<const bf16x8*>(&Qw[(long)r32*DM+d0*16+hi*8]);
  float mhat=0.f,l_reg=0.f;f32x16 o[2];o[0]=f32x16{};o[1]=f32x16{};float cqm=cqL; const f32x16 negm=f32x16{};
  const int qrel=wid*QBLK+r32;
  #define CMASK(P0,P1,t) do{int jb_=(t)-(NT-4); if(jb_>=0)cmask(P0,P1,jb_,qrel,hi);}while(0)
  bool resc=false;
  #define START(P0,P1) do{ const float rm=rowmax(P0,P1); resc=false; \
    { const float dl=rm; mhat=fadd_s(mhat,dl); \
      _Pragma("unroll") for(int r=0;r<16;++r){P0[r]=fsub_s(P0[r],dl);P1[r]=fsub_s(P1[r],dl);} \
      cqm=cqL-mhat; } \
    _Pragma("unroll") for(int r=0;r<16;++r)P0[r]=__builtin_amdgcn_exp2f(P0[r]); }while(0)
  #define RESC() do{ if(resc){ asm volatile("s_waitcnt lgkmcnt(0)":::"memory"); \
      _Pragma("unroll") for(int d_=0;d_<2;++d_) _Pragma("unroll") for(int r=0;r<16;++r)o[d_][r]*=wsf[crow(r,hi)]; } }while(0)
  f32x16 pA0,pA1,pB0,pB1;
  int sl_prev=0,sl_cur=0,sl_next=SLOTB;
  #define ROT() do{sl_prev=sl_cur;sl_cur=sl_next;sl_next=(sl_next==(NSLOT-1)*SLOTB)?0:sl_next+SLOTB;}while(0)
  DMA_K(2,2*SLOTB);
  WAIT_BAR(3);
  qkt(pA0,pA1,Kbase,qr,negm,r32,hi);asm volatile("s_nop 15\n\ts_nop 7":"+v"(pA0),"+v"(pA1));KBIAS(pA0,pA1,0);CMASK(pA0,pA1,0);
  START(pA0,pA1);
  _Pragma("unroll") for(int r=0;r<16;++r)pA1[r]=__builtin_amdgcn_exp2f(pA1[r]);
  WAIT_BAR(0);
  DMA_K(3,0);DMA_V(1,SLOTB);
  ROT();
  kload8(kf,kp0+sl_cur);
  WAIT_BAR(2);
  s16x4 vlo[8],vhi[8]; u32x4 pw0,pw1,pw2,pw3;
  #define PKW(P,B) cvtpk_s(P[B],P[B+1])
  #define PAF(k) __builtin_bit_cast(bf16x8,pw##k)
  #define VFR(i) (bf16x8){vlo[i][0],vlo[i][1],vlo[i][2],vlo[i][3],vhi[i][0],vhi[i][1],vhi[i][2],vhi[i][3]}
  #define PIN(x) asm volatile("":"+v"(x))
  #define MX3(a,b,c) __builtin_fmaxf(__builtin_fmaxf((a),(b)),(c))
  #define GAPA(MF,A0,A1,A2,A3,W0,W1,PW) do{ MF; sacc+=A0; sacc+=A1; sacc+=A2; sacc+=A3; PIN(sacc); W0; W1; PIN(PW); SBAR(); }while(0)
  #define EX(v) __builtin_amdgcn_exp2f(v)
  #define GAPB(MF,X,B) do{ MF; X[B]=EX(X[B]); X[B+1]=EX(X[B+1]); X[B+2]=EX(X[B+2]); X[B+3]=EX(X[B+3]); PIN(X); SBAR(); }while(0)
  #define VRD(i) do{ vlo[i]=vtr(vp_+(((i)>>2)*4096+((i)&3)*1024)); vhi[i]=vtr(vp_+(((i)>>2)*4096+((i)&3)*1024+512)); }while(0)
  #define KRD(G,j) do{ if(G){ kload2(kf,kp0+sl_next,j); SBAR(); } }while(0)
  #define STEP(C0,C1,P0,P1,t,GK,GV,GL) do{ SBAR(); \
    const lds_cptr vp_=vp0+sl_prev; \
    VRD(0); SBAR(); float sacc=(P0[0]+P0[1]); \
    GAPA(C0=__builtin_amdgcn_mfma_f32_32x32x16_bf16(kf[0],qr[0],negm,0,0,0), P0[2],P0[3],P0[4],P0[5],     pw0[0]=PKW(P0,0), pw0[1]=PKW(P0,2), pw0); \
    VRD(4); SBAR(); GAPA(C1=__builtin_amdgcn_mfma_f32_32x32x16_bf16(kf[1],qr[0],negm,0,0,0), P0[6],P0[7],P0[8],P0[9],     pw0[2]=PKW(P0,4), pw0[3]=PKW(P0,6), pw0); \
    VRD(1); SBAR(); GAPA(C0=__builtin_amdgcn_mfma_f32_32x32x16_bf16(kf[2],qr[1],C0,0,0,0),   P0[10],P0[11],P0[12],P0[13], pw1[0]=PKW(P0,8), pw1[1]=PKW(P0,10), pw1); \
    VRD(5); SBAR(); GAPA(C1=__builtin_amdgcn_mfma_f32_32x32x16_bf16(kf[3],qr[1],C1,0,0,0),   P0[14],P0[15],P1[0],P1[1],   pw1[2]=PKW(P0,12),pw1[3]=PKW(P0,14), pw1); \
    VRD(2); SBAR(); GAPA(C0=__builtin_amdgcn_mfma_f32_32x32x16_bf16(kf[4],qr[2],C0,0,0,0),   P1[2],P1[3],P1[4],P1[5],     pw2[0]=PKW(P1,0), pw2[1]=PKW(P1,2), pw2); \
    VRD(6); SBAR(); GAPA(C1=__builtin_amdgcn_mfma_f32_32x32x16_bf16(kf[5],qr[2],C1,0,0,0),   P1[6],P1[7],P1[8],P1[9],     pw2[2]=PKW(P1,4), pw2[3]=PKW(P1,6), pw2); \
    VRD(3); SBAR(); GAPA(C0=__builtin_amdgcn_mfma_f32_32x32x16_bf16(kf[6],qr[3],C0,0,0,0),   P1[10],P1[11],P1[12],P1[13], pw3[0]=PKW(P1,8), pw3[1]=PKW(P1,10), pw3); \
    VRD(7); SBAR(); GAPA(C1=__builtin_amdgcn_mfma_f32_32x32x16_bf16(kf[7],qr[3],C1,0,0,0),   P1[14],P1[15],0.f,0.f,       pw3[2]=PKW(P1,12),pw3[3]=PKW(P1,14), pw3); \
    l_reg+=sacc; \
    if(GK){DMA_K((t)+3,sl_cur);} if(GV){DMA_V((t)+1,sl_next);} \
    KBIAS(C0,C1,t); CMASK(C0,C1,t); \
    { float a=MX3(C0[0],C0[1],C1[0]),b=MX3(C0[2],C0[3],C1[1]); a=MX3(a,C1[2],C1[3]); \
      _Pragma("unroll") for(int r=4;r<16;r+=4){a=MX3(a,C0[r],C0[r+1]);b=MX3(b,C0[r+2],C0[r+3]);a=MX3(a,C1[r],C1[r+1]);b=MX3(b,C1[r+2],C1[r+3]);} \
      float rm=__builtin_fmaxf(a,b); { auto rr=__builtin_amdgcn_permlane32_swap(__float_as_uint(rm),__float_as_uint(rm),false,false); rm=__builtin_fmaxf(__uint_as_float(rr[0]),__uint_as_float(rr[1])); } \
      resc=false; \
      if(__builtin_expect(__any(rm>(float)THRL),0)){ const float dl=__builtin_fmaxf(rm,0.f); mhat+=dl; \
        _Pragma("unroll") for(int r=0;r<16;++r){C0[r]-=dl;C1[r]-=dl;} \
        cqm=cqL-mhat; \
        const float f=__builtin_amdgcn_exp2f(-dl); l_reg*=f; if(hi==0)wsf[r32]=f; resc=true; } } \
    SBAR(); \
    GAPB(o[0]=__builtin_amdgcn_mfma_f32_32x32x16_bf16(PAF(0),VFR(0),o[0],0,0,0), C0,0); \
    GAPB(o[1]=__builtin_amdgcn_mfma_f32_32x32x16_bf16(PAF(0),VFR(4),o[1],0,0,0), C0,4); \
    KRD(GL,0); GAPB(o[0]=__builtin_amdgcn_mfma_f32_32x32x16_bf16(PAF(1),VFR(1),o[0],0,0,0), C0,8); \
    KRD(GL,1); GAPB(o[1]=__builtin_amdgcn_mfma_f32_32x32x16_bf16(PAF(1),VFR(5),o[1],0,0,0), C0,12); \
    KRD(GL,2); GAPB(o[0]=__builtin_amdgcn_mfma_f32_32x32x16_bf16(PAF(2),VFR(2),o[0],0,0,0), C1,0); \
    KRD(GL,3); GAPB(o[1]=__builtin_amdgcn_mfma_f32_32x32x16_bf16(PAF(2),VFR(6),o[1],0,0,0), C1,4); \
    GAPB(o[0]=__builtin_amdgcn_mfma_f32_32x32x16_bf16(PAF(3),VFR(3),o[0],0,0,0), C1,8); \
    GAPB(o[1]=__builtin_amdgcn_mfma_f32_32x32x16_bf16(PAF(3),VFR(7),o[1],0,0,0), C1,12); \
    }while(0)
  int t=1;
  #undef CMASK
  #define CMASK(P0,P1,t) do{}while(0)
  for(;t+5<NT;t+=2){
    STEP(pB0,pB1,pA0,pA1,t,true,true,true);     WAIT_BAR(2); RESC(); ROT();
    STEP(pA0,pA1,pB0,pB1,t+1,true,true,true);   WAIT_BAR(2); RESC(); ROT();
  }
  #undef CMASK
  #define CMASK(P0,P1,t) do{int jb_=(t)-(NT-4); if(jb_>=0)cmask(P0,P1,jb_,qrel,hi);}while(0)
  #define ENDW(tt) do{ if((tt)+3<NT){WAIT_BAR(2);} else if((tt)+2<NT){WAIT_BAR(1);} else {WAIT_BAR(0);} }while(0)
  for(;t+1<NT;t+=2){
    STEP(pB0,pB1,pA0,pA1,t,(t+3<NT),(t+1<NT),(t+1<NT));       ENDW(t);   RESC(); ROT();
    STEP(pA0,pA1,pB0,pB1,t+1,(t+4<NT),(t+2<NT),(t+2<NT));     ENDW(t+1); RESC(); ROT();
  }
  STEP(pB0,pB1,pA0,pA1,NT-1,false,false,false); RESC();
  { float sacc=pB0[0]+pB0[1]; _Pragma("unroll") for(int r=2;r<16;++r)sacc+=pB0[r]; _Pragma("unroll") for(int r=0;r<16;++r)sacc+=pB1[r]; l_reg+=sacc;
    pw0=(u32x4){PKW(pB0,0),PKW(pB0,2),PKW(pB0,4),PKW(pB0,6)};pw1=(u32x4){PKW(pB0,8),PKW(pB0,10),PKW(pB0,12),PKW(pB0,14)};pw2=(u32x4){PKW(pB1,0),PKW(pB1,2),PKW(pB1,4),PKW(pB1,6)};pw3=(u32x4){PKW(pB1,8),PKW(pB1,10),PKW(pB1,12),PKW(pB1,14)};
    SBAR(); pv(o,vb0+sl_cur,PAF(0),PAF(1),PAF(2),PAF(3)); }
  #undef PKW
  #undef PAF
  #undef VFR
  #undef PIN
  #undef MX3
  #undef GAPA
  #undef GAPB
  #undef EX
  #undef VRD
  #undef KRD
  #undef STEP
  #undef ENDW
  {auto rr=__builtin_amdgcn_permlane32_swap(__float_as_uint(l_reg),__float_as_uint(l_reg),false,false);l_reg=__uint_as_float(rr[0])+__uint_as_float(rr[1]);}
  if(hi==0)wsf[32+r32]=l_reg;asm volatile("s_waitcnt lgkmcnt(0)":::"memory");
  float rli[16];
  #pragma unroll
  for(int r=0;r<16;++r)rli[r]=__builtin_amdgcn_rcpf(wsf[32+crow(r,hi)]);
  bf16*Ow=O+(rowbase+q0+wid*QBLK)*DMO+h*D;
  { bf16*stg=(bf16*)(shm+LDS_OST)+wid*2048;
    #pragma unroll
    for(int r=0;r<16;++r){const int orow=crow(r,hi);
      #pragma unroll
      for(int d0=0;d0<2;++d0)stg[orow*64+d0*32+r32]=__float2bfloat16(o[d0][r]*rli[r]);}
    asm volatile("s_waitcnt lgkmcnt(0)":::"memory");
    #pragma unroll
    for(int i=0;i<4;++i){const int row=i*8+(lane>>3),ch=lane&7; const u32x4 v=*(const u32x4*)(stg+row*64+ch*8); ATTN_STORE16(Ow+(long)row*DMO+ch*8,v);} }
  asm volatile("s_waitcnt lgkmcnt(0)\n\ts_barrier":::"memory");
  #undef DMA_K
  #undef DMA_V
  #undef CMASK
  #undef START
  #undef RESC
  #undef ROT
  #undef KBIAS
}
constexpr int ATTN_LDS_BYTES=LDS_BYTES;
struct AttnTensors { const bf16* Q; const bf16* K; const bf16* V; bf16* O; const float* cum; };
struct AttnUnit { int bh; int qb; };
struct StaticOrder {
  int vcu;
  __device__ __forceinline__ explicit StaticOrder(int grid,int block):vcu((block%8)*(grid/8)+block/8){}
  __device__ __forceinline__ bool next(int i,AttnUnit&u)const{ if(i>=2)return false; const int s=vcu&7; u.bh=vcu>>3; u.qb=(i==0)?15-s:s; return true; }
  __device__ __forceinline__ void a_ready(const AttnUnit&)const{}
  __device__ __forceinline__ void done(const AttnUnit&)const{}
};
template<class Sched,int THRL=8> __device__ __forceinline__ void attn_phase(char*lds,const AttnTensors&T,const Sched&S){
  AttnUnit u;
  for(int i=0;S.next(i,u);++i){ S.a_ready(u); attn_unit<THRL>(u.bh/NHEAD,u.bh%NHEAD,u.qb,T.Q,T.K,T.V,T.O,T.cum+(long)u.bh*SEQ,lds); S.done(u); }
}
#undef SBAR
#undef WAIT_BAR
}
namespace cg = cooperative_groups;
#ifndef PH_PRO
#define PH_PRO 1
#endif
#ifndef PH_NORM
#define PH_NORM 1
#endif
#ifndef PH_GIN
#define PH_GIN 1
#endif
#ifndef PH_POOL
#define PH_POOL 1
#endif
#ifndef PH_CONV
#define PH_CONV 1
#endif
#ifndef PH_RKV
#define PH_RKV 1
#endif
#ifndef PH_ATT
#define PH_ATT 1
#endif
#ifndef PH_RET
#define PH_RET 1
#endif
#ifndef PH_GOUT
#define PH_GOUT 1
#endif
#ifndef PH_GUP
#define PH_GUP 1
#endif
#ifndef PH_GDN
#define PH_GDN 1
#endif
#define LAS __attribute__((address_space(3)))
typedef unsigned short bf16;
typedef unsigned v4u __attribute__((ext_vector_type(4)));
typedef unsigned v2u __attribute__((ext_vector_type(2)));
typedef float f32x4 __attribute__((ext_vector_type(4)));
typedef float f32x16 __attribute__((ext_vector_type(16)));
typedef short bf16x8 __attribute__((ext_vector_type(8)));

constexpr int NWAVES = 8, NTHR = 512;
constexpr int BATCH = 8, SEQ = 4096, DMODEL = 1024, MROWS = BATCH * SEQ, DEPTH = 4;
constexpr int NU = 2560, NIN = 2564, DFF = 2816, NH2 = 5632, MODW = 6144;
constexpr float EPS = 1e-6f, LOG2E = 1.4426950408889634f;
constexpr int LDS_BYTES = 147456;

constexpr size_t MiB = 1u << 20;
constexpr size_t WS_MOD = 1 * MiB, WS_CUM = 2 * MiB, WS_FF = 3 * MiB, WS_W = 4 * MiB;
constexpr size_t WOFF_IN = 0, WOFF_OUT = (size_t)NU * 1024, WOFF_13 = WOFF_OUT + 1024 * 1024, WOFF_2 = WOFF_13 + (size_t)NH2 * 1024, W_LAYER = WOFF_2 + (size_t)1024 * DFF;
constexpr size_t WS_H = 98 * MiB, WS_U = 162 * MiB, WS_MIX = 322 * MiB, WS_HID = 162 * MiB, WS_KV = 386 * MiB, WS_VT = 402 * MiB, WS_END = 418 * MiB;
static_assert(WS_W + DEPTH * W_LAYER * 2 <= WS_H, "weights fit");
static_assert(WS_HID + (size_t)MROWS * DFF * 2 <= WS_KV, "hid overlay fits");

#define LDS_WAIT() asm volatile("s_waitcnt lgkmcnt(0)" ::: "memory")
__device__ __forceinline__ unsigned f2bf(float f) { unsigned u = __builtin_bit_cast(unsigned, f); return (u + 0x7fffu + ((u >> 16) & 1u)) >> 16; }
__device__ __forceinline__ unsigned pk2(float lo, float hi) { return f2bf(lo) | (f2bf(hi) << 16); }
__device__ __forceinline__ float bf2f(unsigned b) { return __builtin_bit_cast(float, b << 16); }
__device__ __forceinline__ float bfe(const v4u& v, int e) { return bf2f((v[e >> 1] >> (16 * (e & 1))) & 0xffffu); }
__device__ __forceinline__ float bfe2(const v2u& v, int e) { return bf2f((v[e >> 1] >> (16 * (e & 1))) & 0xffffu); }
__device__ __forceinline__ float wave_sum(float v) {
#pragma unroll
    for (int o = 1; o < 64; o <<= 1) v += __shfl_xor(v, o);
    return v;
}
__device__ __forceinline__ float siluf(float v) { return v * __builtin_amdgcn_rcpf(1.0f + __builtin_amdgcn_exp2f(-LOG2E * v)); }
__device__ __forceinline__ int crow(int r, int hi) { return (r & 3) + 8 * (r >> 2) + 4 * hi; }

__device__ __forceinline__ void transpose_item(const float* W, int ld, int k0, int scol0, bf16* WT, int Kd, int drow0, LAS float* scr, int lane) {
#pragma unroll 8
    for (int i = 0; i < 32; ++i) { const int kk = 2 * i + (lane >> 5); scr[kk * 33 + (lane & 31)] = W[(size_t)(k0 + kk) * ld + scol0 + (lane & 31)]; }
    LDS_WAIT(); asm volatile("" ::: "memory");
    const int c = lane & 7;
#pragma unroll
    for (int j = 0; j < 4; ++j) { const int n = (lane >> 3) + 8 * j; const LAS float* s = scr + (8 * c) * 33 + n;
        v4u o; o.x = pk2(s[0 * 33], s[1 * 33]); o.y = pk2(s[2 * 33], s[3 * 33]); o.z = pk2(s[4 * 33], s[5 * 33]); o.w = pk2(s[6 * 33], s[7 * 33]);
        *(v4u*)(WT + (size_t)(drow0 + n) * Kd + k0 + 8 * c) = o; }
    LDS_WAIT(); asm volatile("" ::: "memory");
}

template <bool FF>
__device__ __forceinline__ void norm_phase(LAS unsigned char* lds, const float* xin, const float* g, const float* msc, const float* msh, bf16* hout, const float* wfcols, float* ffout,
                                           int bx, int G, int tid, int lane, int wave) {
    LAS f32x4* gs4 = (LAS f32x4*)lds; LAS f32x4* sh4 = (LAS f32x4*)(lds + 4096); LAS f32x4* wf4 = (LAS f32x4*)(lds + 8192);
    for (int rb = bx; rb < MROWS / 128; rb += G) {
        const int b = rb / (SEQ / 128);
        if (tid < 256) { const f32x4 gv = ((const f32x4*)g)[tid], scv = ((const f32x4*)(msc + (size_t)b * MODW))[tid]; gs4[tid] = gv * (1.0f + scv); sh4[tid] = ((const f32x4*)(msh + (size_t)b * MODW))[tid]; }
        if (FF) for (int k = tid; k < 1024; k += NTHR) wf4[k] = *(const f32x4*)(wfcols + (size_t)k * NIN);
        __syncthreads();
        for (int i = 0; i < 16; ++i) {
            const int row = rb * 128 + wave * 16 + i;
            const f32x4* xr = (const f32x4*)(xin + (size_t)row * 1024) + lane;
            f32x4 v[4]; float ss = 0.f;
#pragma unroll
            for (int j = 0; j < 4; ++j) { v[j] = xr[64 * j]; ss += (v[j].x * v[j].x + v[j].y * v[j].y) + (v[j].z * v[j].z + v[j].w * v[j].w); }
            ss = wave_sum(ss);
            const float rstd = 1.0f / sqrtf(ss * (1.0f / 1024.0f) + EPS);
            float f0 = 0.f, f1 = 0.f, f2 = 0.f, f3 = 0.f;
            unsigned long long* o8 = (unsigned long long*)(hout + (size_t)row * 1024) + lane;
#pragma unroll
            for (int j = 0; j < 4; ++j) {
                const f32x4 hv = v[j] * rstd * gs4[lane + 64 * j] + sh4[lane + 64 * j];
                o8[64 * j] = (unsigned long long)pk2(hv.x, hv.y) | ((unsigned long long)pk2(hv.z, hv.w) << 32);
                if (FF) { const int k = 4 * lane + 256 * j; const f32x4 w0 = wf4[k], w1 = wf4[k + 1], w2 = wf4[k + 2], w3 = wf4[k + 3];
                    f0 += hv.x * w0.x + hv.y * w1.x + hv.z * w2.x + hv.w * w3.x; f1 += hv.x * w0.y + hv.y * w1.y + hv.z * w2.y + hv.w * w3.y;
                    f2 += hv.x * w0.z + hv.y * w1.z + hv.z * w2.z + hv.w * w3.z; f3 += hv.x * w0.w + hv.y * w1.w + hv.z * w2.w + hv.w * w3.w; }
            }
            if (FF) { f0 = wave_sum(f0); f1 = wave_sum(f1); f2 = wave_sum(f2); f3 = wave_sum(f3); if (lane == 0) *(f32x4*)(ffout + (size_t)row * 4) = (f32x4){f0, f1, f2, f3}; }
        }
        __syncthreads();
    }
}

__device__ __forceinline__ void cum_scan(LAS unsigned char* lds, const float* ff, const float* fb, float* cumL, int bh, int tid, int lane, int wave) {
    const int b = bh >> 2, h = bh & 3; const float fbh = fb[h];
    float v[8]; float run = 0.f;
#pragma unroll
    for (int i = 0; i < 8; ++i) { const int s = tid * 8 + i; const float z = ff[((size_t)b * SEQ + s) * 4 + h] + fbh;
        const float ls = fminf(z, 0.f) - log1pf(expf(-fabsf(z))); run += ls * LOG2E; v[i] = run; }
    float incl = run;
#pragma unroll
    for (int o = 1; o < 64; o <<= 1) { const float t = __shfl_up(incl, o); if (lane >= o) incl += t; }
    LAS float* wt = (LAS float*)lds;
    if (lane == 63) wt[wave] = incl;
    __syncthreads();
    float off = incl - run;
    for (int ww = 0; ww < wave; ++ww) off += wt[ww];
    float* op = cumL + (size_t)bh * SEQ + tid * 8;
    *(f32x4*)op = (f32x4){v[0] + off, v[1] + off, v[2] + off, v[3] + off}; *(f32x4*)(op + 4) = (f32x4){v[4] + off, v[5] + off, v[6] + off, v[7] + off};
    __syncthreads();
}

constexpr int TP = 146;
__device__ __forceinline__ void pool_unit(LAS unsigned char* lds, const bf16* U, const float* pw, const float* psc, bf16* MIX, int u, int tid) {
    const int b = u >> 5, s0 = (u & 31) * 128;
    LAS bf16* tile = (LAS bf16*)lds;
    for (int task = tid; task < 143 * 32; task += NTHR) {
        const int tt = task >> 5, c8 = task & 31, s = s0 - 15 + tt;
        v4u v = (v4u){0u, 0u, 0u, 0u};
        if (s >= 0) v = *(const v4u*)(U + ((size_t)b * SEQ + s) * NU + 768 + 8 * c8);
#pragma unroll
        for (int e = 0; e < 8; ++e) tile[(8 * c8 + e) * TP + tt] = (bf16)((v[e >> 1] >> (16 * (e & 1))) & 0xffffu);
    }
    __syncthreads();
    {
        const int t = tid & 127, gi = __builtin_amdgcn_readfirstlane(tid >> 7), w = 2 << gi, s = s0 + t;
        const float inv = 1.0f / (float)((s + 1 < w) ? (s + 1) : w);
        float acc[64];
#pragma unroll
        for (int d = 0; d < 64; ++d) acc[d] = 0.f;
        const LAS bf16* base = tile + (gi * 64) * TP + t + 15;
        const float* pwg = pw + gi * 4096;
#pragma unroll 1
        for (int c = 0; c < 64; ++c) {
            const LAS bf16* bc = base + c * TP;
            float sum = 0.f;
            for (int j = 0; j < w; ++j) sum += bf2f(bc[-j]);
            const float dv = sum * inv - bf2f(bc[0]);
#pragma unroll
            for (int d = 0; d < 64; ++d) acc[d] += dv * pwg[c * 64 + d];
        }
        bf16* op = MIX + ((size_t)b * SEQ + s) * 1024 + 256 + gi * 64;
        const float* ps = psc + gi * 64;
#pragma unroll
        for (int q = 0; q < 8; ++q) { v4u o; o.x = pk2(acc[8 * q] * ps[8 * q], acc[8 * q + 1] * ps[8 * q + 1]); o.y = pk2(acc[8 * q + 2] * ps[8 * q + 2], acc[8 * q + 3] * ps[8 * q + 3]);
            o.z = pk2(acc[8 * q + 4] * ps[8 * q + 4], acc[8 * q + 5] * ps[8 * q + 5]); o.w = pk2(acc[8 * q + 6] * ps[8 * q + 6], acc[8 * q + 7] * ps[8 * q + 7]); *(v4u*)(op + 8 * q) = o; }
    }
    __syncthreads();
}

__device__ __forceinline__ void conv_unit(LAS unsigned char* lds, const bf16* U, const float* cw, const float* cb, const float* lng, const float* lnb, bf16* MIX, int u, int tid, int lane, int wave) {
    const int b = u >> 6, s0 = (u & 63) * 64;
    LAS float* hg = (LAS float*)lds;
    for (int task = tid; task < 94 * 32; task += NTHR) {
        const int tt = task >> 5, c8 = task & 31, s = s0 - 30 + tt;
        f32x4 h0 = (f32x4){0.f, 0.f, 0.f, 0.f}, h1 = h0;
        if (s >= 0) { const bf16* ur = U + ((size_t)b * SEQ + s) * NU + 2048 + 8 * c8; const v4u av = *(const v4u*)ur, gv = *(const v4u*)(ur + 256);
#pragma unroll
            for (int e = 0; e < 4; ++e) { h0[e] = bfe(av, e) * __builtin_amdgcn_rcpf(1.0f + __builtin_amdgcn_exp2f(-LOG2E * bfe(gv, e)));
                                          h1[e] = bfe(av, e + 4) * __builtin_amdgcn_rcpf(1.0f + __builtin_amdgcn_exp2f(-LOG2E * bfe(gv, e + 4))); } }
        *(LAS f32x4*)(hg + tt * 256 + 8 * c8) = h0; *(LAS f32x4*)(hg + tt * 256 + 8 * c8 + 4) = h1;
    }
    __syncthreads();
    {
        const int ch = tid & 255, half = tid >> 8;
        float w[31], acc[32];
#pragma unroll
        for (int j = 0; j < 31; ++j) w[j] = cw[j * 256 + ch];
        const float bias = cb[ch];
#pragma unroll
        for (int o = 0; o < 32; ++o) acc[o] = bias;
        const LAS float* hp = hg + (32 * half) * 256 + ch;
#pragma unroll
        for (int j = 0; j < 62; ++j) { const float v = hp[j * 256];
#pragma unroll
            for (int o = 0; o < 32; ++o) if (j - o >= 0 && j - o <= 30) acc[o] += v * w[j - o]; }
        __syncthreads();
#pragma unroll
        for (int o = 0; o < 32; ++o) hg[(32 * half + o) * 256 + ch] = acc[o];
    }
    __syncthreads();
    for (int i = 0; i < 8; ++i) {
        const int tok = wave * 8 + i;
        const f32x4 y = *(const LAS f32x4*)(hg + tok * 256 + 4 * lane);
        const float mean = wave_sum((y.x + y.y) + (y.z + y.w)) * (1.0f / 256.0f);
        const f32x4 d = y - mean;
        const float var = wave_sum((d.x * d.x + d.y * d.y) + (d.z * d.z + d.w * d.w)) * (1.0f / 256.0f);
        const float rstd = 1.0f / sqrtf(var + EPS);
        const f32x4 z = d * rstd * *(const f32x4*)(lng + 4 * lane) + *(const f32x4*)(lnb + 4 * lane);
        v2u o; o.x = pk2(siluf(z.x), siluf(z.y)); o.y = pk2(siluf(z.z), siluf(z.w));
        *(v2u*)(MIX + ((size_t)b * SEQ + s0 + tok) * 1024 + 768 + 4 * lane) = o;
    }
    __syncthreads();
}

constexpr int TJ = 136, TS = 72;
__device__ __forceinline__ void retkv_unit(LAS unsigned char* lds, bf16* U, const int* positions, float* KV, bf16* VT, int u, int tid, int lane, int wave) {
    const int b = u >> 7, n = (u >> 2) & 31, h = u & 3;
    LAS bf16* Kt = (LAS bf16*)lds;
    LAS bf16* Vt = (LAS bf16*)(lds + 64 * TJ * 2);
    const float lg = log2f(1.0f - exp2f(-5.0f - (float)h));
    {
        const int j = tid >> 2, p = tid & 3;
        const size_t row = (size_t)b * SEQ + n * 128 + j;
        bf16* ur = U + row * NU;
        const float pos = (float)positions[row];
        const float gq = exp2f(lg * (float)j), gk = 0.125f * exp2f(-lg * (float)j);
        const v4u q1 = *(const v4u*)(ur + 1024 + 64 * h + 8 * p), q2 = *(const v4u*)(ur + 1024 + 64 * h + 32 + 8 * p);
        const v4u k1 = *(const v4u*)(ur + 1280 + 64 * h + 8 * p), k2 = *(const v4u*)(ur + 1280 + 64 * h + 32 + 8 * p);
        const v4u v1 = *(const v4u*)(ur + 1536 + 64 * h + 8 * p), v2 = *(const v4u*)(ur + 1536 + 64 * h + 32 + 8 * p);
        unsigned qa[8], qb[8], ka[8], kb[8];
#pragma unroll
        for (int ii = 0; ii < 8; ++ii) {
            const int i = 8 * p + ii;
            const float inv = exp2f(-(float)i * (13.287712379549449f / 32.0f));
            const float ang = pos * inv;
            float rev = ang * 0.15915494309189535f; rev -= floorf(rev);
            const float sn = __builtin_amdgcn_sinf(rev), cs = __builtin_amdgcn_cosf(rev);
            const float a = bfe(q1, ii), c = bfe(q2, ii), ak = bfe(k1, ii), ck = bfe(k2, ii);
            qa[ii] = f2bf((a * cs - c * sn) * gq); qb[ii] = f2bf((a * sn + c * cs) * gq);
            ka[ii] = f2bf((ak * cs - ck * sn) * gk); kb[ii] = f2bf((ak * sn + ck * cs) * gk);
            Kt[(8 * p + ii) * TJ + j] = (bf16)ka[ii]; Kt[(32 + 8 * p + ii) * TJ + j] = (bf16)kb[ii];
            Vt[(8 * p + ii) * TJ + j] = (bf16)((v1[ii >> 1] >> (16 * (ii & 1))) & 0xffffu); Vt[(32 + 8 * p + ii) * TJ + j] = (bf16)((v2[ii >> 1] >> (16 * (ii & 1))) & 0xffffu);
        }
        *(v4u*)(ur + 1024 + 64 * h + 8 * p) = (v4u){qa[0] | (qa[1] << 16), qa[2] | (qa[3] << 16), qa[4] | (qa[5] << 16), qa[6] | (qa[7] << 16)};
        *(v4u*)(ur + 1024 + 64 * h + 32 + 8 * p) = (v4u){qb[0] | (qb[1] << 16), qb[2] | (qb[3] << 16), qb[4] | (qb[5] << 16), qb[6] | (qb[7] << 16)};
        *(v4u*)(ur + 1280 + 64 * h + 8 * p) = (v4u){ka[0] | (ka[1] << 16), ka[2] | (ka[3] << 16), ka[4] | (ka[5] << 16), ka[6] | (ka[7] << 16)};
        *(v4u*)(ur + 1280 + 64 * h + 32 + 8 * p) = (v4u){kb[0] | (kb[1] << 16), kb[2] | (kb[3] << 16), kb[4] | (kb[5] << 16), kb[6] | (kb[7] << 16)};
    }
    __syncthreads();
    if (wave < 4) {
        const int db = wave >> 1, eb = wave & 1, r32 = lane & 31, hi = lane >> 5;
        f32x16 acc;
#pragma unroll
        for (int r = 0; r < 16; ++r) acc[r] = 0.f;
#pragma unroll
        for (int ks = 0; ks < 8; ++ks) {
            const bf16x8 A = *(const LAS bf16x8*)(Kt + (32 * db + r32) * TJ + 16 * ks + 8 * hi);
            const bf16x8 B = *(const LAS bf16x8*)(Vt + (32 * eb + r32) * TJ + 16 * ks + 8 * hi);
            acc = __builtin_amdgcn_mfma_f32_32x32x16_bf16(A, B, acc, 0, 0, 0);
        }
        const float g127 = exp2f(lg * 127.0f);
        float* kvp = KV + (size_t)u * 4096;
#pragma unroll
        for (int r = 0; r < 16; ++r) kvp[(32 * db + crow(r, hi)) * 64 + 32 * eb + r32] = acc[r] * g127;
    }
    for (int p = tid; p < 1024; p += NTHR) { const int e = p >> 4, jc = p & 15; *(v4u*)(VT + (size_t)u * 8192 + e * 128 + 8 * jc) = *(const LAS v4u*)(Vt + e * TJ + 8 * jc); }
    __syncthreads();
}

__device__ __forceinline__ void retout_pair(LAS unsigned char* lds, const bf16* U, const float* KV, const bf16* VT, const float* gn, bf16* MIX, int up, int tid, int lane, int wave) {
    const int half = wave >> 2, w4 = wave & 3, t256 = tid & 255;
    const int u = up * 2 + half; const int b = u >> 7, n = (u >> 2) & 31, h = u & 3;
    LAS bf16* St = (LAS bf16*)(lds + half * (64 * TS * 2));
    const float lg = log2f(1.0f - exp2f(-5.0f - (float)h));
    {
        const float decay = exp2f(lg * 128.0f), gam = exp2f(lg);
        const int d = t256 >> 2, e0 = (t256 & 3) * 16;
        f32x4 s[4];
#pragma unroll
        for (int q = 0; q < 4; ++q) s[q] = (f32x4){0.f, 0.f, 0.f, 0.f};
        const float* kvb = KV + ((size_t)(b * 32) * 4 + h) * 4096 + d * 64 + e0;
        for (int m = 0; m < n; ++m) { const f32x4* p = (const f32x4*)(kvb + (size_t)m * 4 * 4096);
#pragma unroll
            for (int q = 0; q < 4; ++q) s[q] = s[q] * decay + p[q]; }
#pragma unroll
        for (int q = 0; q < 4; ++q)
#pragma unroll
            for (int c = 0; c < 4; ++c) St[(e0 + 4 * q + c) * TS + d] = (bf16)f2bf(s[q][c] * gam);
    }
    __syncthreads();
    {
        const int ib = w4, r32 = lane & 31, hi = lane >> 5;
        const size_t row0 = (size_t)b * SEQ + n * 128;
        const bf16* qp = U + (row0 + 32 * ib + r32) * NU + 1024 + 64 * h + 8 * hi;
        bf16x8 qf[4];
#pragma unroll
        for (int d0 = 0; d0 < 4; ++d0) qf[d0] = *(const bf16x8*)(qp + 16 * d0);
        f32x16 o[2];
#pragma unroll
        for (int r = 0; r < 16; ++r) { o[0][r] = 0.f; o[1][r] = 0.f; }
#pragma unroll
        for (int d0 = 0; d0 < 4; ++d0)
#pragma unroll
            for (int eb = 0; eb < 2; ++eb) { const bf16x8 A = *(const LAS bf16x8*)(St + (32 * eb + r32) * TS + 16 * d0 + 8 * hi); o[eb] = __builtin_amdgcn_mfma_f32_32x32x16_bf16(A, qf[d0], o[eb], 0, 0, 0); }
        const bf16* vtb = VT + (size_t)u * 8192;
        for (int jb = 0; jb <= ib; ++jb) {
            const bf16* kp = U + (row0 + 32 * jb + r32) * NU + 1280 + 64 * h + 8 * hi;
            f32x16 st;
#pragma unroll
            for (int r = 0; r < 16; ++r) st[r] = 0.f;
#pragma unroll
            for (int d0 = 0; d0 < 4; ++d0) st = __builtin_amdgcn_mfma_f32_32x32x16_bf16(*(const bf16x8*)(kp + 16 * d0), qf[d0], st, 0, 0, 0);
            if (jb == ib) {
#pragma unroll
                for (int r = 0; r < 16; ++r) if (crow(r, hi) > r32) st[r] = 0.f;
            }
#pragma unroll
            for (int k = 0; k < 2; ++k) {
                v4u pbw; pbw.x = pk2(st[8 * k], st[8 * k + 1]); pbw.y = pk2(st[8 * k + 2], st[8 * k + 3]); pbw.z = pk2(st[8 * k + 4], st[8 * k + 5]); pbw.w = pk2(st[8 * k + 6], st[8 * k + 7]);
                const bf16x8 pb = __builtin_bit_cast(bf16x8, pbw);
#pragma unroll
                for (int eb = 0; eb < 2; ++eb) {
                    const bf16* vp = vtb + (32 * eb + r32) * 128 + 32 * jb + 16 * k + 4 * hi;
                    const v2u lo = *(const v2u*)vp, hh = *(const v2u*)(vp + 8);
                    const bf16x8 A = __builtin_bit_cast(bf16x8, (v4u){lo.x, lo.y, hh.x, hh.y});
                    o[eb] = __builtin_amdgcn_mfma_f32_32x32x16_bf16(A, pb, o[eb], 0, 0, 0);
                }
            }
        }
        float sum = 0.f;
#pragma unroll
        for (int r = 0; r < 16; ++r) sum += o[0][r] + o[1][r];
        sum += __shfl_xor(sum, 32);
        const float mu = sum * (1.0f / 64.0f);
        float var = 0.f;
#pragma unroll
        for (int r = 0; r < 16; ++r) { const float d0 = o[0][r] - mu, d1 = o[1][r] - mu; var += d0 * d0 + d1 * d1; }
        var += __shfl_xor(var, 32);
        const float rstd = 1.0f / sqrtf(var * (1.0f / 64.0f) + EPS);
        const size_t tok = row0 + 32 * ib + r32;
        const bf16* gp = U + tok * NU + 1792 + 64 * h;
        bf16* op = MIX + tok * 1024 + 512 + 64 * h;
#pragma unroll
        for (int eb = 0; eb < 2; ++eb)
#pragma unroll
            for (int g4 = 0; g4 < 4; ++g4) {
                const int e = 32 * eb + 8 * g4 + 4 * hi;
                const v2u gw = *(const v2u*)(gp + e); const f32x4 gg = *(const f32x4*)(gn + 64 * h + e);
                float y[4];
#pragma unroll
                for (int c = 0; c < 4; ++c) y[c] = siluf(bfe2(gw, c)) * ((o[eb][4 * g4 + c] - mu) * rstd * gg[c]);
                v2u ov; ov.x = pk2(y[0], y[1]); ov.y = pk2(y[2], y[3]);
                *(v2u*)(op + e) = ov;
            }
    }
    __syncthreads();
}

struct Args { const void* in[21]; float* out; unsigned char* ws; };
__global__ void __launch_bounds__(NTHR, 2) fwd_kernel(Args a) {
    extern __shared__ __attribute__((aligned(16))) unsigned char lds_raw[];
    cg::grid_group grid = cg::this_grid();
    LAS unsigned char* lds = (LAS unsigned char*)lds_raw;
    int tid = threadIdx.x, lane = tid & 63, wave = __builtin_amdgcn_readfirstlane(tid >> 6);
    const int G = gridDim.x; int bx = blockIdx.x;
    int vcu = (G % 8 == 0) ? (bx % 8) * (G / 8) + bx / 8 : bx;
#define RELAUNDER() do { tid = threadIdx.x; asm volatile("" : "+v"(tid)); lane = tid & 63; wave = __builtin_amdgcn_readfirstlane(tid >> 6); bx = blockIdx.x; asm volatile("" : "+s"(bx)); vcu = (G % 8 == 0) ? (bx % 8) * (G / 8) + bx / 8 : bx; } while (0)
    const float* xin = (const float*)a.in[0]; const float* cin = (const float*)a.in[1]; const int* positions = (const int*)a.in[2];
    const float* ada_w = (const float*)a.in[3]; const float* ada_b = (const float*)a.in[4];
    const float* norm_mix_g = (const float*)a.in[5]; const float* norm_ffn_g = (const float*)a.in[6];
    const float* w_in = (const float*)a.in[7]; const float* fox_fb = (const float*)a.in[8];
    const float* pool_w = (const float*)a.in[9]; const float* pool_scale = (const float*)a.in[10]; const float* ret_gn_g = (const float*)a.in[11];
    const float* conv_w = (const float*)a.in[12]; const float* conv_b = (const float*)a.in[13]; const float* conv_ln_g = (const float*)a.in[14]; const float* conv_ln_b = (const float*)a.in[15];
    const float* w_out = (const float*)a.in[16]; const float* ffn_w1 = (const float*)a.in[17]; const float* ffn_w3 = (const float*)a.in[18]; const float* ffn_w2 = (const float*)a.in[19];
    const float* final_g = (const float*)a.in[20];
    float* out = a.out; unsigned char* ws = a.ws;
    float* mod = (float*)(ws + WS_MOD); float* cumL = (float*)(ws + WS_CUM); float* ffb = (float*)(ws + WS_FF);
    bf16* WB = (bf16*)(ws + WS_W); bf16* H = (bf16*)(ws + WS_H); bf16* U = (bf16*)(ws + WS_U); bf16* MIX = (bf16*)(ws + WS_MIX); bf16* HID = (bf16*)(ws + WS_HID);
    float* KV = (float*)(ws + WS_KV); bf16* VT = (bf16*)(ws + WS_VT);

    if (PH_PRO) {
        LAS float* scr = (LAS float*)(lds + wave * 16384);
        const int gw = bx * NWAVES + wave, NGW = G * NWAVES;
        for (int it = gw; it < DEPTH * 6016; it += NGW) {
            const int l = it / 6016; int r = it - l * 6016;
            bf16* wl = WB + (size_t)l * W_LAYER;
            if (r < 1280) { const int kb = r / 80, n0 = 32 * (r % 80); transpose_item(w_in + (size_t)l * 1024 * NIN, NIN, 64 * kb, n0 + (n0 >= 768 ? 4 : 0), wl + WOFF_IN, 1024, n0, scr, lane); continue; } r -= 1280;
            if (r < 512) { const int kb = r / 32, n0 = 32 * (r % 32); transpose_item(w_out + (size_t)l * 1024 * 1024, 1024, 64 * kb, n0, wl + WOFF_OUT, 1024, n0, scr, lane); continue; } r -= 512;
            if (r < 1408) { const int kb = r / 88, n0 = 32 * (r % 88); transpose_item(ffn_w1 + (size_t)l * 1024 * DFF, DFF, 64 * kb, n0, wl + WOFF_13, 1024, (n0 / 128) * 256 + (n0 % 128), scr, lane); continue; } r -= 1408;
            if (r < 1408) { const int kb = r / 88, n0 = 32 * (r % 88); transpose_item(ffn_w3 + (size_t)l * 1024 * DFF, DFF, 64 * kb, n0, wl + WOFF_13, 1024, (n0 / 128) * 256 + 128 + (n0 % 128), scr, lane); continue; } r -= 1408;
            { const int kb = r / 32, n0 = 32 * (r % 32); transpose_item(ffn_w2 + (size_t)l * DFF * 1024, 1024, 64 * kb, n0, wl + WOFF_2, DFF, n0, scr, lane); }
        }
    }
    __syncthreads();
    if (PH_PRO) {
        LAS float* cact = (LAS float*)lds;
        LAS float* part = (LAS float*)(lds + 32768);
        for (int i = tid; i < BATCH * 1024; i += NTHR) { const float v = cin[i]; cact[i] = v / (1.0f + expf(-v)); }
        __syncthreads();
        for (int ch = bx; ch < DEPTH * 96; ch += G) {
            const int l = ch / 96, n0 = (ch % 96) * 64;
            const float* wp = ada_w + ((size_t)l * 1024 + wave * 128) * MODW + n0 + lane;
            float acc[8];
#pragma unroll
            for (int b = 0; b < 8; ++b) acc[b] = 0.f;
#pragma unroll 4
            for (int k = 0; k < 128; k += 4) {
                const float w0 = wp[(size_t)k * MODW], w1 = wp[(size_t)(k + 1) * MODW], w2 = wp[(size_t)(k + 2) * MODW], w3 = wp[(size_t)(k + 3) * MODW];
#pragma unroll
                for (int b = 0; b < 8; ++b) { const f32x4 cv = *(const LAS f32x4*)(cact + b * 1024 + wave * 128 + k); acc[b] += (cv.x * w0 + cv.y * w1) + (cv.z * w2 + cv.w * w3); }
            }
#pragma unroll
            for (int b = 0; b < 8; ++b) part[(wave * 8 + b) * 64 + lane] = acc[b];
            __syncthreads();
            { float s = ada_b[(size_t)l * MODW + n0 + lane];
#pragma unroll
              for (int ww = 0; ww < 8; ++ww) s += part[(ww * 8 + wave) * 64 + lane];
              mod[((size_t)l * 8 + wave) * MODW + n0 + lane] = s; }
            __syncthreads();
        }
    }
    grid.sync(); RELAUNDER();

    for (int l = 0; l < DEPTH; ++l) {
        const float* modl = mod + (size_t)l * 8 * MODW;
        bf16* wl = WB + (size_t)l * W_LAYER;
        const float* xcur = (l == 0) ? xin : out;
        if (PH_NORM) norm_phase<true>(lds, xcur, norm_mix_g + l * 1024, modl + 1024, modl, H, w_in + (size_t)l * 1024 * NIN + 768, ffb, bx, G, tid, lane, wave);
        grid.sync(); RELAUNDER();
        if (PH_GIN) {
            if (bx < 32) cum_scan(lds, ffb, fox_fb + l * 4, cumL, bx, tid, lane, wave);
            __syncthreads();
            pg8::Gemm g{H, wl + WOFF_IN, MROWS, NU, 1024}; pg8::StaticOrder S; S.init(MROWS, NU, G, bx);
            pg8::EpiU E{U, NU, attn_body::C2};
            pg8::gemm_phase<pg8::EpiU, pg8::StaticOrder, true, true>(lds, g, S, E);
        }
        grid.sync(); RELAUNDER();
        if (PH_POOL) for (int u = vcu; u < 256; u += G) pool_unit(lds, U, pool_w + (size_t)l * 4 * 4096, pool_scale + l * 256, MIX, u, tid);
        RELAUNDER();
        if (PH_CONV) for (int u = vcu; u < 512; u += G) conv_unit(lds, U, conv_w + (size_t)l * 31 * 256, conv_b + l * 256, conv_ln_g + l * 256, conv_ln_b + l * 256, MIX, u, tid, lane, wave);
        RELAUNDER();
        if (PH_RKV) for (int u = vcu; u < 1024; u += G) retkv_unit(lds, U, positions, KV, VT, u, tid, lane, wave);
        grid.sync(); RELAUNDER();
        if (PH_ATT) {
            const attn_body::AttnTensors AT{(const attn_body::bf16*)U, (const attn_body::bf16*)(U + 256), (const attn_body::bf16*)(U + 512), (attn_body::bf16*)MIX, cumL};
            const attn_body::StaticOrder S(G, bx);
            attn_body::attn_phase<attn_body::StaticOrder>((char*)lds_raw, AT, S);
        }
        __syncthreads(); RELAUNDER();
        if (PH_RET) for (int up = vcu; up < 512; up += G) retout_pair(lds, U, KV, VT, ret_gn_g + l * 256, MIX, up, tid, lane, wave);
        grid.sync(); RELAUNDER();
        if (PH_GOUT) {
            pg8::Gemm g{MIX, wl + WOFF_OUT, MROWS, 1024, 1024}; pg8::StaticOrder S; S.init(MROWS, 1024, G, bx);
            pg8::EpiRes E{xcur, out, modl + 2048};
            pg8::gemm_phase<pg8::EpiRes, pg8::StaticOrder, true, true>(lds, g, S, E);
        }
        grid.sync(); RELAUNDER();
        if (PH_NORM) norm_phase<false>(lds, out, norm_ffn_g + l * 1024, modl + 4096, modl + 3072, H, nullptr, nullptr, bx, G, tid, lane, wave);
        grid.sync(); RELAUNDER();
        if (PH_GUP) {
            pg8::Gemm g{H, wl + WOFF_13, MROWS, NH2, 1024}; pg8::StaticOrder S; S.init(MROWS, NH2, G, bx);
            pg8::EpiSwiGLU E{HID, DFF};
            pg8::gemm_phase<pg8::EpiSwiGLU, pg8::StaticOrder, true, true>(lds, g, S, E);
        }
        grid.sync(); RELAUNDER();
        if (PH_GDN) {
            pg8::Gemm g{HID, wl + WOFF_2, MROWS, 1024, DFF}; pg8::StaticOrder S; S.init(MROWS, 1024, G, bx);
            pg8::EpiRes E{out, out, modl + 5120};
            pg8::gemm_phase<pg8::EpiRes, pg8::StaticOrder, true, true>(lds, g, S, E);
        }
        grid.sync(); RELAUNDER();
    }
    {
        const int gw = bx * NWAVES + wave, NGW = G * NWAVES;
        for (int row = gw; row < MROWS; row += NGW) {
            f32x4* xr = (f32x4*)(out + (size_t)row * 1024) + lane;
            f32x4 v[4]; float ss = 0.f;
#pragma unroll
            for (int j = 0; j < 4; ++j) { v[j] = xr[64 * j]; ss += (v[j].x * v[j].x + v[j].y * v[j].y) + (v[j].z * v[j].z + v[j].w * v[j].w); }
            ss = wave_sum(ss);
            const float rstd = 1.0f / sqrtf(ss * (1.0f / 1024.0f) + EPS);
#pragma unroll
            for (int j = 0; j < 4; ++j) xr[64 * j] = v[j] * rstd * ((const f32x4*)final_g)[lane + 64 * j];
        }
    }
}

extern "C" void kernel_launch(void* const* d_in, const int* in_sizes, int n_in, void* d_out, int out_size, void* d_ws, size_t ws_size, hipStream_t stream) {
    static int grid = 0;
    if (grid == 0) {
        if (n_in != 21 || out_size != MROWS * 1024 || ws_size < WS_END) { fprintf(stderr, "kernel_launch: unexpected shapes: n_in %d out %d ws %zu (need %zu)\n", n_in, out_size, ws_size, (size_t)WS_END); grid = -1; return; }
        int dev = 0, cus = 0, per_cu = 0;
        hipGetDevice(&dev); hipDeviceGetAttribute(&cus, hipDeviceAttributeMultiprocessorCount, dev);
        if (hipFuncSetAttribute((const void*)fwd_kernel, hipFuncAttributeMaxDynamicSharedMemorySize, LDS_BYTES) != hipSuccess) { fprintf(stderr, "kernel_launch: hipFuncSetAttribute failed\n"); grid = -1; return; }
        if (hipOccupancyMaxActiveBlocksPerMultiprocessor(&per_cu, (const void*)fwd_kernel, NTHR, LDS_BYTES) != hipSuccess || per_cu < 1) { fprintf(stderr, "kernel_launch: occupancy query says %d\n", per_cu); per_cu = 1; }
        (void)hipGetLastError();
        grid = cus;
        if (grid != 256) fprintf(stderr, "kernel_launch: %d CUs; the attention deal assumes 256\n", grid);
    }
    if (grid < 0) return;
    Args a{};
    for (int i = 0; i < 21; ++i) a.in[i] = d_in[i];
    a.out = (float*)d_out; a.ws = (unsigned char*)d_ws;
    void* args[] = {&a};
    hipError_t e = hipLaunchCooperativeKernel((const void*)fwd_kernel, dim3(grid), dim3(NTHR), args, LDS_BYTES, stream);
    if (e != hipSuccess) fprintf(stderr, "kernel_launch: cooperative launch failed: %s (grid %d)\n", hipGetErrorString(e), grid);
}
```

```cpp
#include <hip/hip_runtime.h>
#include <hip/hip_cooperative_groups.h>
#include <cstdio>
#include <cstdint>
namespace pg8 {
#define PG8_LAS __attribute__((address_space(3)))
typedef unsigned short bf16_t;
typedef short bf16x8 __attribute__((ext_vector_type(8)));
typedef float f32x4 __attribute__((ext_vector_type(4)));
typedef unsigned u32x4 __attribute__((ext_vector_type(4)));
constexpr int BM = 256, BK = 64, HALF = 128, HTB = HALF * BK * 2  , STAGE_BYTES = 8 * HTB, NXCD = 8, WGM = 8;

__host__ __device__ __forceinline__ int lds_byte(int r, int c) { const int st = (r >> 4) * 2 + (c >> 5), rr = r & 15, cc = c & 31, ob = rr * 64 + cc * 2; return st * 1024 + (ob ^ (((ob >> 9) & 1) << 5)); }
__host__ __device__ __forceinline__ void stage_rc(int b, int& R, int& C) { const int st = b / 1024, sb = b % 1024, swz = sb ^ (((sb >> 9) & 1) << 5); R = (st >> 1) * 16 + swz / 64; C = (st & 1) * 32 + (swz % 64) / 2; }
__host__ __device__ __forceinline__ int perm32(int rho) { const int n = rho >> 4, i = rho & 15; return 8 * (i >> 2) + 4 * n + (i & 3); }

struct Unit { int pm, pn; };
struct Gemm { const bf16_t* A; const bf16_t* Bt; int M, N, K; };

struct StaticOrder {
    int nM, nN, nwg, G, c;
    __host__ __device__ void init(int M, int N, int G_, int c_) { nM = M / BM; nN = N / BM; nwg = nM * nN; G = G_; c = c_; }
    __host__ __device__ bool next(int i, Unit& u) const {
        const long L = (long)i * G + c; if (L >= nwg) return false;
        int wgid = (int)L; { const int q = nwg / NXCD, r = nwg % NXCD, xcd = wgid % NXCD, off = wgid / NXCD; wgid = (xcd < r ? xcd * (q + 1) : r * (q + 1) + (xcd - r) * q) + off; }
        const int nig = WGM * nN, gid = wgid / nig, fm = gid * WGM, gsz = (nM - fm) < WGM ? (nM - fm) : WGM;
        u.pm = fm + ((wgid % nig) % gsz); u.pn = (wgid % nig) / gsz; return true;
    }
    __device__ __forceinline__ void a_ready(const Unit&) const {}
    __device__ __forceinline__ void done(const Unit&) const {}
};

__device__ __forceinline__ unsigned cvt_pk_bf16(float lo, float hi) { unsigned r; asm volatile("v_cvt_pk_bf16_f32 %0, %1, %2" : "=v"(r) : "v"(lo), "v"(hi)); return r; }
typedef float f32x2 __attribute__((ext_vector_type(2)));
__device__ __forceinline__ float silu_f(float v) { return v * __builtin_amdgcn_rcpf(1.0f + __builtin_amdgcn_exp2f(-1.4426950408889634f * v)); }
struct EpiU {
    static constexpr bool PERM = true, AFTER_DRAIN = false;
    bf16_t* O; int ldc; float s0;
    __device__ __forceinline__ void operator()(const f32x4 (&acc)[2][2][4][2], const Unit& u, int wr, int wc, int fr, int fq) const {
        const int row0 = u.pm * BM + wr * 64 + fr, col0 = u.pn * BM + wc * 32 + 8 * fq;
        const float sc = (u.pn == 0) ? s0 : 1.f;
#pragma unroll
        for (int ai = 0; ai < 2; ++ai)
#pragma unroll
            for (int m = 0; m < 4; ++m) { bf16_t* rowp = O + (size_t)(row0 + ai * HALF + m * 16) * ldc + col0;
#pragma unroll
                for (int bj = 0; bj < 2; ++bj) { const f32x4 v0 = acc[ai][bj][m][0] * sc, v1 = acc[ai][bj][m][1] * sc;
                    u32x4 w; w.x = cvt_pk_bf16(v0[0], v0[1]); w.y = cvt_pk_bf16(v0[2], v0[3]); w.z = cvt_pk_bf16(v1[0], v1[1]); w.w = cvt_pk_bf16(v1[2], v1[3]);
                    *(u32x4*)(rowp + bj * HALF) = w; } }
    }
};
struct EpiRes {
    static constexpr bool PERM = false, AFTER_DRAIN = false;
    const float* base; float* out; const float* gate;
    __device__ __forceinline__ void operator()(const f32x4 (&acc)[2][2][4][2], const Unit& u, int wr, int wc, int fr, int fq) const {
        const float* gp = gate + (size_t)(u.pm >> 4) * 6144;
        const int col0 = u.pn * BM + wc * 32 + 4 * fq;
        f32x4 gv[2][2];
#pragma unroll
        for (int bj = 0; bj < 2; ++bj)
#pragma unroll
            for (int n = 0; n < 2; ++n) gv[bj][n] = *(const f32x4*)(gp + col0 + bj * HALF + n * 16);
#pragma unroll
        for (int ai = 0; ai < 2; ++ai)
#pragma unroll
            for (int m = 0; m < 4; ++m) { const size_t off = (size_t)(u.pm * BM + ai * HALF + wr * 64 + m * 16 + fr) * 1024 + col0;
#pragma unroll
                for (int bj = 0; bj < 2; ++bj)
#pragma unroll
                    for (int n = 0; n < 2; ++n) { const f32x4 bs = *(const f32x4*)(base + off + bj * HALF + n * 16);
                        *(f32x4*)(out + off + bj * HALF + n * 16) = bs + gv[bj][n] * acc[ai][bj][m][n]; } }
    }
};
struct EpiSwiGLU {
    static constexpr bool PERM = true, AFTER_DRAIN = false;
    bf16_t* O; int ldc;
    __device__ __forceinline__ void operator()(const f32x4 (&acc)[2][2][4][2], const Unit& u, int wr, int wc, int fr, int fq) const {
        const int row0 = u.pm * BM + wr * 64 + fr, col0 = u.pn * HALF + wc * 32 + 8 * fq;
#pragma unroll
        for (int ai = 0; ai < 2; ++ai)
#pragma unroll
            for (int m = 0; m < 4; ++m) { bf16_t* rowp = O + (size_t)(row0 + ai * HALF + m * 16) * ldc + col0;
                const f32x4 a0 = acc[ai][0][m][0], a1 = acc[ai][0][m][1], b0 = acc[ai][1][m][0], b1 = acc[ai][1][m][1];
                u32x4 w; w.x = cvt_pk_bf16(silu_f(a0[0]) * b0[0], silu_f(a0[1]) * b0[1]); w.y = cvt_pk_bf16(silu_f(a0[2]) * b0[2], silu_f(a0[3]) * b0[3]);
                w.z = cvt_pk_bf16(silu_f(a1[0]) * b1[0], silu_f(a1[1]) * b1[1]); w.w = cvt_pk_bf16(silu_f(a1[2]) * b1[2], silu_f(a1[3]) * b1[3]);
                *(u32x4*)rowp = w; }
    }
};
template <class Epi, class Sched, bool ALIGN_EPI = false, bool SP2 = false>
__device__ __forceinline__ void gemm_phase(PG8_LAS unsigned char* lds, const Gemm g, const Sched& S, const Epi& E) {
    int tid_ = threadIdx.x; asm volatile("" : "+v"(tid_));
    const int tid = tid_, wid = __builtin_amdgcn_readfirstlane(tid >> 6), lane = tid & 63, wr = wid >> 2, wc = wid & 3, fr = lane & 15, fq = lane >> 4;
    const int K = g.K, nt = K / BK;
    unsigned voffA[2], voffB[2];
#pragma unroll
    for (int i = 0; i < 2; ++i) { int R, C; stage_rc(tid * 16 + i * 8192, R, C); const int Rb = Epi::PERM ? ((R & ~31) + perm32(R & 31)) : R;
        voffA[i] = (unsigned)(R * K + C) * 2u; voffB[i] = (unsigned)(Rb * K + C) * 2u; }
    const size_t kstep = (size_t)(BK * 2);
    const size_t hstep = (size_t)HALF * K * 2;
    const size_t tstep = 2 * hstep;
    const unsigned ldsw = (unsigned)wid * 1024u;
    const int aoff = lds_byte(wr * 64 + fr, fq * 8), boff = lds_byte(wc * 32 + fr, fq * 8);
#define PG8_SA(b, h) (((b) * 2 + (h)) * HTB)
#define PG8_SB(b, h) ((4 + (b) * 2 + (h)) * HTB)
#define PG8_STAGE(bufoff, gbase, voff) do { _Pragma("unroll") for (int _i = 0; _i < 2; ++_i) \
        __builtin_amdgcn_global_load_lds((const unsigned*)((const char*)(gbase) + (voff)[_i]), (PG8_LAS unsigned*)(lds + (bufoff) + ldsw + _i * 8192), 16, 0, 0); } while (0)
#define PG8_LDA(dst, b, h) do { _Pragma("unroll") for (int m = 0; m < 4; ++m) _Pragma("unroll") for (int k = 0; k < 2; ++k) dst[m][k] = *(const PG8_LAS bf16x8*)(lds + PG8_SA(b, h) + aoff + m * 2048 + k * 1024); } while (0)
#define PG8_LDB(dst, b, h) do { _Pragma("unroll") for (int n = 0; n < 2; ++n) _Pragma("unroll") for (int k = 0; k < 2; ++k) dst[n][k] = *(const PG8_LAS bf16x8*)(lds + PG8_SB(b, h) + boff + n * 2048 + k * 1024); } while (0)
#define PG8_MMA(ai, bj, At, Bt) do { __builtin_amdgcn_s_setprio(1); _Pragma("unroll") for (int m = 0; m < 4; ++m) _Pragma("unroll") for (int n = 0; n < 2; ++n) _Pragma("unroll") for (int k = 0; k < 2; ++k) \
        acc[ai][bj][m][n] = __builtin_amdgcn_mfma_f32_16x16x32_bf16(Bt[n][k], At[m][k], acc[ai][bj][m][n], 0, 0, 0); __builtin_amdgcn_s_setprio(0); } while (0)
#define PG8_WAIT_V(n) asm volatile("s_waitcnt vmcnt(" #n ")" ::: "memory")
#define PG8_WAIT_L(n) asm volatile("s_waitcnt lgkmcnt(" #n ")" ::: "memory")
#define PG8_BAR __builtin_amdgcn_s_barrier()
#define PG8_SCHED __builtin_amdgcn_sched_barrier(0)
    Unit cur, nxt; int ui = 0;
    if (!S.next(0, cur)) return;
    f32x4 acc[2][2][4][2];
#pragma unroll
    for (int a = 0; a < 2; ++a)
#pragma unroll
        for (int b = 0; b < 2; ++b)
#pragma unroll
            for (int m = 0; m < 4; ++m)
#pragma unroll
                for (int n = 0; n < 2; ++n) acc[a][b][m][n] = (f32x4){0.f, 0.f, 0.f, 0.f};
    bf16x8 At[4][2], B0[2][2], B1[2][2];
    const char* cA = (const char*)g.A + (size_t)cur.pm * tstep; const char* cB = (const char*)g.Bt + (size_t)cur.pn * tstep;
    S.a_ready(cur);
    if constexpr (SP2) {
        PG8_STAGE(PG8_SB(0, 0), cB, voffB); PG8_STAGE(PG8_SB(0, 1), cB + hstep, voffB); PG8_STAGE(PG8_SA(0, 0), cA, voffA); PG8_STAGE(PG8_SA(0, 1), cA + hstep, voffA);
        if (wr == 1) PG8_BAR;
        PG8_WAIT_V(2); PG8_BAR;
        PG8_STAGE(PG8_SB(1, 0), cB + kstep, voffB); PG8_STAGE(PG8_SA(1, 0), cA + kstep, voffA); PG8_STAGE(PG8_SB(1, 1), cB + hstep + kstep, voffB);
        PG8_WAIT_V(6); PG8_BAR;
    } else {
        PG8_STAGE(PG8_SB(0, 0), cB, voffB); PG8_STAGE(PG8_SA(0, 0), cA, voffA); PG8_STAGE(PG8_SB(0, 1), cB + hstep, voffB); PG8_STAGE(PG8_SA(0, 1), cA + hstep, voffA);
        if (wr == 1) PG8_BAR;
        PG8_WAIT_V(4); PG8_BAR;
        PG8_STAGE(PG8_SB(1, 0), cB + kstep, voffB); PG8_STAGE(PG8_SA(1, 0), cA + kstep, voffA); PG8_STAGE(PG8_SB(1, 1), cB + hstep + kstep, voffB);
        PG8_WAIT_V(6); PG8_BAR;
    }
    for (;;) {
        const bool has_next = S.next(ui + 1, nxt);
        const char* nA = has_next ? (const char*)g.A + (size_t)nxt.pm * tstep : cA; const char* nB = has_next ? (const char*)g.Bt + (size_t)nxt.pn * tstep : cB;
        for (int t = 0; t < nt; t += 2) {
            const bool last = (t == nt - 2);
            const char* a1 = cA + (size_t)(t + 1) * kstep;
            const char* a2 = last ? nA : cA + (size_t)(t + 2) * kstep; const char* b2 = last ? nB : cB + (size_t)(t + 2) * kstep;
            const char* a3 = a2 + kstep; const char* b3 = b2 + kstep;
            if (last && has_next) S.a_ready(nxt);
            if constexpr (SP2) {
            PG8_LDB(B0, 0, 0); PG8_LDB(B1, 0, 1); PG8_SCHED; PG8_LDA(At, 0, 0); PG8_STAGE(PG8_SA(1, 1), a1 + hstep, voffA);
            PG8_WAIT_V(8); PG8_WAIT_L(0); PG8_BAR; PG8_MMA(0, 0, At, B0); PG8_MMA(0, 1, At, B1); PG8_BAR; PG8_SCHED;
            PG8_LDA(At, 0, 1); PG8_STAGE(PG8_SB(0, 0), b2, voffB); PG8_STAGE(PG8_SB(0, 1), b2 + hstep, voffB); PG8_STAGE(PG8_SA(0, 0), a2, voffA);
            PG8_WAIT_V(8); PG8_WAIT_L(0); PG8_BAR; PG8_MMA(1, 0, At, B0); PG8_MMA(1, 1, At, B1); PG8_BAR; PG8_SCHED;
            PG8_LDB(B0, 1, 0); PG8_LDB(B1, 1, 1); PG8_SCHED; PG8_LDA(At, 1, 0); PG8_STAGE(PG8_SA(0, 1), a2 + hstep, voffA);
            PG8_WAIT_V(8); PG8_WAIT_L(0); PG8_BAR; PG8_MMA(0, 0, At, B0); PG8_MMA(0, 1, At, B1); PG8_BAR; PG8_SCHED;
            PG8_LDA(At, 1, 1); PG8_STAGE(PG8_SB(1, 0), b3, voffB); PG8_STAGE(PG8_SB(1, 1), b3 + hstep, voffB); PG8_STAGE(PG8_SA(1, 0), a3, voffA);
            PG8_WAIT_V(8); PG8_WAIT_L(0); PG8_BAR; PG8_MMA(1, 0, At, B0); PG8_MMA(1, 1, At, B1); PG8_BAR; PG8_SCHED;
            } else {
            PG8_LDB(B0, 0, 0); PG8_SCHED; PG8_LDA(At, 0, 0); PG8_STAGE(PG8_SA(1, 1), a1 + hstep, voffA);
            PG8_WAIT_L(8); PG8_BAR; PG8_WAIT_L(0); PG8_MMA(0, 0, At, B0); PG8_BAR; PG8_SCHED;
            PG8_LDB(B1, 0, 1); PG8_STAGE(PG8_SB(0, 0), b2, voffB);
            PG8_BAR; PG8_WAIT_L(0); PG8_MMA(0, 1, At, B1); PG8_BAR;
            PG8_LDA(At, 0, 1); PG8_STAGE(PG8_SA(0, 0), a2, voffA);
            PG8_BAR; PG8_WAIT_L(0); PG8_MMA(1, 0, At, B0); PG8_BAR; PG8_SCHED;
            PG8_STAGE(PG8_SB(0, 1), b2 + hstep, voffB);
            PG8_WAIT_V(6); PG8_BAR; PG8_MMA(1, 1, At, B1); PG8_BAR;
            PG8_LDB(B0, 1, 0); PG8_SCHED; PG8_LDA(At, 1, 0); PG8_STAGE(PG8_SA(0, 1), a2 + hstep, voffA);
            PG8_WAIT_L(8); PG8_BAR; PG8_WAIT_L(0); PG8_MMA(0, 0, At, B0); PG8_BAR; PG8_SCHED;
            PG8_LDB(B1, 1, 1); PG8_STAGE(PG8_SB(1, 0), b3, voffB);
            PG8_BAR; PG8_WAIT_L(0); PG8_MMA(0, 1, At, B1); PG8_BAR;
            PG8_LDA(At, 1, 1); PG8_STAGE(PG8_SA(1, 0), a3, voffA);
            PG8_BAR; PG8_WAIT_L(0); PG8_MMA(1, 0, At, B0); PG8_BAR; PG8_SCHED;
            PG8_STAGE(PG8_SB(1, 1), b3 + hstep, voffB);
            PG8_WAIT_V(6); PG8_BAR; PG8_MMA(1, 1, At, B1); PG8_BAR;
            }
        }
        if constexpr (ALIGN_EPI) { if (wr == 0) PG8_BAR; }
        if constexpr (!Epi::AFTER_DRAIN) { E(acc, cur, wr, wc, fr, fq); S.done(cur); }
        if (!has_next) break;
#pragma unroll
        for (int a = 0; a < 2; ++a)
#pragma unroll
            for (int b = 0; b < 2; ++b)
#pragma unroll
                for (int m = 0; m < 4; ++m)
#pragma unroll
                    for (int n = 0; n < 2; ++n) acc[a][b][m][n] = (f32x4){0.f, 0.f, 0.f, 0.f};
        cur = nxt; cA = nA; cB = nB; ++ui;
        if constexpr (ALIGN_EPI) { if (wr == 1) PG8_BAR; }
    }
    PG8_WAIT_V(0);
    if constexpr (!ALIGN_EPI) { if (wr == 0) PG8_BAR; }
    PG8_BAR;
    if constexpr (Epi::AFTER_DRAIN) { E.fused(acc, cur, wr, wc, fr, fq, lds, wid, lane); S.done(cur); }
#undef PG8_SA
#undef PG8_SB
#undef PG8_STAGE
#undef PG8_LDA
#undef PG8_LDB
#undef PG8_MMA
#undef PG8_WAIT_V
#undef PG8_WAIT_L
#undef PG8_BAR
#undef PG8_SCHED
}
}
#include <hip/hip_bf16.h>
#include <cmath>
namespace attn_body {
using bf16=__hip_bfloat16;
using bf16x8=__attribute__((ext_vector_type(8)))short;
using s16x4=__attribute__((ext_vector_type(4)))short;
using f32x16=__attribute__((ext_vector_type(16)))float;
using u32x4=__attribute__((ext_vector_type(4)))unsigned;
constexpr int BATCH=8,NHEAD=4,SEQ=4096,D=64,DM=2560,DMO=1024;
constexpr int NW=8,QBLK=32,QB=QBLK*NW,KVBLK=64,NQB=SEQ/QB;
constexpr int ATTN_PITCH=DM, ATTN_UNIT_ROWS=QB;
__device__ __forceinline__ int crow(int r,int hi){return (r&3)+8*(r>>2)+4*hi;}
#define SBAR() __builtin_amdgcn_sched_barrier(0)
__device__ __forceinline__ void cmask(f32x16&p0,f32x16&p1,int jb,int qrel,int hi){
  const float NEG=-INFINITY; int kb=64*jb+4*hi;
  #pragma unroll
  for(int r=0;r<16;++r){int kv=kb+(r&3)+8*(r>>2); if(kv>qrel)p0[r]=NEG; if(kv+32>qrel)p1[r]=NEG;}
}

constexpr int NSLOT=3, SLOTB=8192;
constexpr int LDS_K=0, LDS_V=NSLOT*SLOTB, LDS_WS=2*NSLOT*SLOTB, LDS_OST=LDS_WS+NW*64*4, LDS_CUM=LDS_OST+NW*4096, LDS_BYTES=LDS_CUM+SEQ*4;
constexpr float C2=0.125f*1.4426950408889634f;
__device__ __forceinline__ void glds16(const void*gsrc,unsigned lds_dst){unsigned keep;
  asm volatile("s_mov_b32 %0, m0\n\ts_mov_b32 m0, %2\n\ts_nop 0\n\tglobal_load_lds_dwordx4 %1, off\n\ts_mov_b32 m0, %0":"=&s"(keep):"v"(gsrc),"s"(lds_dst):"memory");}
__device__ __forceinline__ float max3f(float a,float b,float c){float r;asm("v_max3_f32 %0, %1, %2, %3":"=v"(r):"v"(a),"v"(b),"v"(c));return r;}
__device__ __forceinline__ float max2f(float a,float b){float r;asm("v_max_f32_e32 %0, %1, %2":"=v"(r):"v"(a),"v"(b));return r;}
__device__ __forceinline__ float fadd_s(float a,float b){float r;asm("v_add_f32_e32 %0, %1, %2":"=v"(r):"v"(a),"v"(b));return r;}
__device__ __forceinline__ float fsub_s(float a,float b){float r;asm("v_sub_f32_e32 %0, %1, %2":"=v"(r):"v"(a),"v"(b));return r;}
typedef float f32x2_t __attribute__((ext_vector_type(2))); typedef __bf16 bf16x2_t __attribute__((ext_vector_type(2)));
__device__ __forceinline__ unsigned cvtpk_s(float lo,float hi){f32x2_t v={lo,hi};bf16x2_t b=__builtin_convertvector(v,bf16x2_t);return __builtin_bit_cast(unsigned,b);}
#define WAIT_BAR(N) asm volatile("s_waitcnt vmcnt(" #N ") lgkmcnt(0)\n\ts_barrier":::"memory")

__device__ __forceinline__ void qkt(f32x16&p0,f32x16&p1,const char*Kslot,const bf16x8*qr,const f32x16&negm,int r32,int hi){
  const char*kb=Kslot+hi*1024+r32*16;
  #pragma unroll
  for(int d0=0;d0<4;++d0){
    const bf16x8 b0=*reinterpret_cast<const bf16x8*>(kb+d0*2048);
    const bf16x8 b1=*reinterpret_cast<const bf16x8*>(kb+d0*2048+512);
    if(d0==0){p0=__builtin_amdgcn_mfma_f32_32x32x16_bf16(b0,qr[0],negm,0,0,0);p1=__builtin_amdgcn_mfma_f32_32x32x16_bf16(b1,qr[0],negm,0,0,0);}
    else{p0=__builtin_amdgcn_mfma_f32_32x32x16_bf16(b0,qr[d0],p0,0,0,0);p1=__builtin_amdgcn_mfma_f32_32x32x16_bf16(b1,qr[d0],p1,0,0,0);}}
}
typedef __attribute__((address_space(3))) const char* lds_cptr;
typedef short v4i16_t __attribute__((ext_vector_type(4)));
__device__ __forceinline__ void kload8(bf16x8*kf,lds_cptr kp){
  kf[0]=*(const __attribute__((address_space(3))) bf16x8*)(kp);      kf[1]=*(const __attribute__((address_space(3))) bf16x8*)(kp+512);
  kf[2]=*(const __attribute__((address_space(3))) bf16x8*)(kp+2048); kf[3]=*(const __attribute__((address_space(3))) bf16x8*)(kp+2560);
  kf[4]=*(const __attribute__((address_space(3))) bf16x8*)(kp+4096); kf[5]=*(const __attribute__((address_space(3))) bf16x8*)(kp+4608);
  kf[6]=*(const __attribute__((address_space(3))) bf16x8*)(kp+6144); kf[7]=*(const __attribute__((address_space(3))) bf16x8*)(kp+6656);
}
__device__ __forceinline__ void kload2(bf16x8*kf,lds_cptr kp,int j){ kf[2*j]=*(const __attribute__((address_space(3))) bf16x8*)(kp+j*2048); kf[2*j+1]=*(const __attribute__((address_space(3))) bf16x8*)(kp+j*2048+512); }
__device__ __forceinline__ s16x4 vtr(lds_cptr p){ return __builtin_bit_cast(s16x4,__builtin_amdgcn_ds_read_tr16_b64_v4i16((__attribute__((address_space(3))) v4i16_t*)p)); }
__device__ __forceinline__ float rowmax(const f32x16&p0,const f32x16&p1){
  float a=max3f(p0[0],p0[1],p1[0]),b=max3f(p0[2],p0[3],p1[1]);a=max3f(a,p1[2],p1[3]);
  #pragma unroll
  for(int r=4;r<16;r+=4){a=max3f(a,p0[r],p0[r+1]);b=max3f(b,p0[r+2],p0[r+3]);a=max3f(a,p1[r],p1[r+1]);b=max3f(b,p1[r+2],p1[r+3]);}
  const float m=max2f(a,b);
  auto rr=__builtin_amdgcn_permlane32_swap(__float_as_uint(m),__float_as_uint(m),false,false);
  return max2f(__uint_as_float(rr[0]),__uint_as_float(rr[1]));
}
__device__ __forceinline__ void pv(f32x16*o,int vb,bf16x8 pa0,bf16x8 pa1,bf16x8 pa2,bf16x8 pa3){
  #pragma unroll
  for(int d0=0;d0<2;++d0){s16x4 lo[4],hi[4];
    #pragma unroll
    for(int ks=0;ks<4;++ks){
      asm volatile("ds_read_b64_tr_b16 %0,%1 offset:%c2":"=&v"(lo[ks]):"v"(vb),"i"(d0*4096+ks*1024):"memory");
      asm volatile("ds_read_b64_tr_b16 %0,%1 offset:%c2":"=&v"(hi[ks]):"v"(vb),"i"(d0*4096+ks*1024+512):"memory");}
    asm volatile("s_waitcnt lgkmcnt(0)":::"memory");SBAR();
    #define PK(k) (bf16x8){lo[k][0],lo[k][1],lo[k][2],lo[k][3],hi[k][0],hi[k][1],hi[k][2],hi[k][3]}
    o[d0]=__builtin_amdgcn_mfma_f32_32x32x16_bf16(pa0,PK(0),o[d0],0,0,0);
    o[d0]=__builtin_amdgcn_mfma_f32_32x32x16_bf16(pa1,PK(1),o[d0],0,0,0);
    o[d0]=__builtin_amdgcn_mfma_f32_32x32x16_bf16(pa2,PK(2),o[d0],0,0,0);
    o[d0]=__builtin_amdgcn_mfma_f32_32x32x16_bf16(pa3,PK(3),o[d0],0,0,0);
    #undef PK
  }
}

#ifndef ATTN_STORE16
#define ATTN_STORE16(p,v) (*(u32x4*)(p)=(v))
#endif
template<int THRL> __device__ __forceinline__ void attn_unit(int b,int h,int qb,const bf16*Q,const bf16*__restrict__ K,const bf16*__restrict__ V,bf16*O,const float*__restrict__ cumg,char*shm){
  int tid_=threadIdx.x; asm volatile("":"+v"(tid_)); const int tid=tid_,lane=tid&63,r32=lane&31,hi=lane>>5; const int wid=__builtin_amdgcn_readfirstlane(tid>>6);
  const long rowbase=(long)b*SEQ; const int q0=qb*QB;
  typedef float f32x4_t __attribute__((ext_vector_type(4)));
  { __attribute__((address_space(3))) f32x4_t* cl=(__attribute__((address_space(3))) f32x4_t*)((__attribute__((address_space(3))) char*)shm+LDS_CUM);
    const f32x4_t* cgp=(const f32x4_t*)cumg; for(int i=tid;i<(q0+QB)/4;i+=NW*64)cl[i]=cgp[i]; }
  const float cqL=cumg[q0+wid*QBLK+r32];
  const __attribute__((address_space(3))) f32x4_t* cumq=(const __attribute__((address_space(3))) f32x4_t*)((__attribute__((address_space(3))) char*)shm+LDS_CUM)+hi;
  #define KBIAS(P0,P1,t) do{ const __attribute__((address_space(3))) f32x4_t* cb_=cumq+16*(t); _Pragma("unroll") for(int g_=0;g_<4;++g_){ const f32x4_t a_=cb_[2*g_], b_=cb_[8+2*g_]; \
      P0[4*g_]+=cqm-a_[0];P0[4*g_+1]+=cqm-a_[1];P0[4*g_+2]+=cqm-a_[2];P0[4*g_+3]+=cqm-a_[3]; P1[4*g_]+=cqm-b_[0];P1[4*g_+1]+=cqm-b_[1];P1[4*g_+2]+=cqm-b_[2];P1[4*g_+3]+=cqm-b_[3]; } }while(0)
  const bf16*Qw=Q+(rowbase+q0+wid*QBLK)*DM+h*D;
  const bf16*Kh=K+rowbase*DM+h*D,*Vh=V+rowbase*DM+h*D;
  const unsigned lds0=(unsigned)(uintptr_t)shm;
  float*wsf=(float*)(shm+LDS_WS)+wid*64;
  const bf16*ksrc=Kh+(long)lane*DM+wid*8;
  const bf16*vsrc=Vh+(long)(16*(wid&3)+(lane>>2))*DM+(wid>>2)*32+(lane&3)*8;
  const unsigned kdst=lds0+LDS_K+wid*1024, vdst=lds0+LDS_V+wid*1024;
  #define DMA_K(t,slot) glds16(ksrc+(long)(t)*KVBLK*DM,(unsigned)__builtin_amdgcn_readfirstlane(kdst+(slot)))
  #define DMA_V(t,slot) glds16(vsrc+(long)(t)*KVBLK*DM,(unsigned)__builtin_amdgcn_readfirstlane(vdst+(slot)))
  const int vb0=(int)(lds0+LDS_V)+((lane>>4)&1)*32+(lane&3)*8+(4*hi+((lane&15)>>2))*64;
  const char*Kbase=shm+LDS_K; bf16x8 kf[8];
  const lds_cptr shm3=(lds_cptr)shm; const lds_cptr kp0=shm3+LDS_K+hi*1024+r32*16; const lds_cptr vp0=shm3+LDS_V+((lane>>4)&1)*32+(lane&3)*8+(4*hi+((lane&15)>>2))*64;
  const int NT=(q0+QB)/KVBLK;
  DMA_K(0,0);DMA_V(0,0);DMA_K(1,SLOTB);
  bf16x8 qr[4];
  #pragma unroll
  for(int d0=0;d0<4;++d0)qr[d0]=*reinterpret_cast<const bf16x8*>(&Qw[(long)r32*DM+d0*16+hi*8]);
  float mhat=0.f,l_reg=0.f;f32x16 o[2];o[0]=f32x16{};o[1]=f32x16{};float cqm=cqL; const f32x16 negm=f32x16{};
  const int qrel=wid*QBLK+r32;
  #define CMASK(P0,P1,t) do{int jb_=(t)-(NT-4); if(jb_>=0)cmask(P0,P1,jb_,qrel,hi);}while(0)
  bool resc=false;
  #define START(P0,P1) do{ const float rm=rowmax(P0,P1); resc=false; \
    { const float dl=rm; mhat=fadd_s(mhat,dl); \
      _Pragma("unroll") for(int r=0;r<16;++r){P0[r]=fsub_s(P0[r],dl);P1[r]=fsub_s(P1[r],dl);} \
      cqm=cqL-mhat; } \
    _Pragma("unroll") for(int r=0;r<16;++r)P0[r]=__builtin_amdgcn_exp2f(P0[r]); }while(0)
  #define RESC() do{ if(resc){ asm volatile("s_waitcnt lgkmcnt(0)":::"memory"); \
      _Pragma("unroll") for(int d_=0;d_<2;++d_) _Pragma("unroll") for(int r=0;r<16;++r)o[d_][r]*=wsf[crow(r,hi)]; } }while(0)
  f32x16 pA0,pA1,pB0,pB1;
  int sl_prev=0,sl_cur=0,sl_next=SLOTB;
  #define ROT() do{sl_prev=sl_cur;sl_cur=sl_next;sl_next=(sl_next==(NSLOT-1)*SLOTB)?0:sl_next+SLOTB;}while(0)
  DMA_K(2,2*SLOTB);
  WAIT_BAR(3);
  qkt(pA0,pA1,Kbase,qr,negm,r32,hi);asm volatile("s_nop 15\n\ts_nop 7":"+v"(pA0),"+v"(pA1));KBIAS(pA0,pA1,0);CMASK(pA0,pA1,0);
  START(pA0,pA1);
  _Pragma("unroll") for(int r=0;r<16;++r)pA1[r]=__builtin_amdgcn_exp2f(pA1[r]);
  WAIT_BAR(0);
  DMA_K(3,0);DMA_V(1,SLOTB);
  ROT();
  kload8(kf,kp0+sl_cur);
  WAIT_BAR(2);
  s16x4 vlo[8],vhi[8]; u32x4 pw0,pw1,pw2,pw3;
  #define PKW(P,B) cvtpk_s(P[B],P[B+1])
  #define PAF(k) __builtin_bit_cast(bf16x8,pw##k)
  #define VFR(i) (bf16x8){vlo[i][0],vlo[i][1],vlo[i][2],vlo[i][3],vhi[i][0],vhi[i][1],vhi[i][2],vhi[i][3]}
  #define PIN(x) asm volatile("":"+v"(x))
  #define MX3(a,b,c) __builtin_fmaxf(__builtin_fmaxf((a),(b)),(c))
  #define GAPA(MF,A0,A1,A2,A3,W0,W1,PW) do{ MF; sacc+=A0; sacc+=A1; sacc+=A2; sacc+=A3; PIN(sacc); W0; W1; PIN(PW); SBAR(); }while(0)
  #define EX(v) __builtin_amdgcn_exp2f(v)
  #define GAPB(MF,X,B) do{ MF; X[B]=EX(X[B]); X[B+1]=EX(X[B+1]); X[B+2]=EX(X[B+2]); X[B+3]=EX(X[B+3]); PIN(X); SBAR(); }while(0)
  #define VRD(i) do{ vlo[i]=vtr(vp_+(((i)>>2)*4096+((i)&3)*1024)); vhi[i]=vtr(vp_+(((i)>>2)*4096+((i)&3)*1024+512)); }while(0)
  #define KRD(G,j) do{ if(G){ kload2(kf,kp0+sl_next,j); SBAR(); } }while(0)
  #define STEP(C0,C1,P0,P1,t,GK,GV,GL) do{ SBAR(); \
    const lds_cptr vp_=vp0+sl_prev; \
    VRD(0); SBAR(); float sacc=(P0[0]+P0[1]); \
    GAPA(C0=__builtin_amdgcn_mfma_f32_32x32x16_bf16(kf[0],qr[0],negm,0,0,0), P0[2],P0[3],P0[4],P0[5],     pw0[0]=PKW(P0,0), pw0[1]=PKW(P0,2), pw0); \
    VRD(4); SBAR(); GAPA(C1=__builtin_amdgcn_mfma_f32_32x32x16_bf16(kf[1],qr[0],negm,0,0,0), P0[6],P0[7],P0[8],P0[9],     pw0[2]=PKW(P0,4), pw0[3]=PKW(P0,6), pw0); \
    VRD(1); SBAR(); GAPA(C0=__builtin_amdgcn_mfma_f32_32x32x16_bf16(kf[2],qr[1],C0,0,0,0),   P0[10],P0[11],P0[12],P0[13], pw1[0]=PKW(P0,8), pw1[1]=PKW(P0,10), pw1); \
    VRD(5); SBAR(); GAPA(C1=__builtin_amdgcn_mfma_f32_32x32x16_bf16(kf[3],qr[1],C1,0,0,0),   P0[14],P0[15],P1[0],P1[1],   pw1[2]=PKW(P0,12),pw1[3]=PKW(P0,14), pw1); \
    VRD(2); SBAR(); GAPA(C0=__builtin_amdgcn_mfma_f32_32x32x16_bf16(kf[4],qr[2],C0,0,0,0),   P1[2],P1[3],P1[4],P1[5],     pw2[0]=PKW(P1,0), pw2[1]=PKW(P1,2), pw2); \
    VRD(6); SBAR(); GAPA(C1=__builtin_amdgcn_mfma_f32_32x32x16_bf16(kf[5],qr[2],C1,0,0,0),   P1[6],P1[7],P1[8],P1[9],     pw2[2]=PKW(P1,4), pw2[3]=PKW(P1,6), pw2); \
    VRD(3); SBAR(); GAPA(C0=__builtin_amdgcn_mfma_f32_32x32x16_bf16(kf[6],qr[3],C0,0,0,0),   P1[10],P1[11],P1[12],P1[13], pw3[0]=PKW(P1,8), pw3[1]=PKW(P1,10), pw3); \
    VRD(7); SBAR(); GAPA(C1=__builtin_amdgcn_mfma_f32_32x32x16_bf16(kf[7],qr[3],C1,0,0,0),   P1[14],P1[15],0.f,0.f,       pw3[2]=PKW(P1,12),pw3[3]=PKW(P1,14), pw3); \
    l_reg+=sacc; \
    if(GK){DMA_K((t)+3,sl_cur);} if(GV){DMA_V((t)+1,sl_next);} \
    KBIAS(C0,C1,t); CMASK(C0,C1,t); \
    { float a=MX3(C0[0],C0[1],C1[0]),b=MX3(C0[2],C0[3],C1[1]); a=MX3(a,C1[2],C1[3]); \
      _Pragma("unroll") for(int r=4;r<16;r+=4){a=MX3(a,C0[r],C0[r+1]);b=MX3(b,C0[r+2],C0[r+3]);a=MX3(a,C1[r],C1[r+1]);b=MX3(b,C1[r+2],C1[r+3]);} \
      float rm=__builtin_fmaxf(a,b); { auto rr=__builtin_amdgcn_permlane32_swap(__float_as_uint(rm),__float_as_uint(rm),false,false); rm=__builtin_fmaxf(__uint_as_float(rr[0]),__uint_as_float(rr[1])); } \
      resc=false; \
      if(__builtin_expect(__any(rm>(float)THRL),0)){ const float dl=__builtin_fmaxf(rm,0.f); mhat+=dl; \
        _Pragma("unroll") for(int r=0;r<16;++r){C0[r]-=dl;C1[r]-=dl;} \
        cqm=cqL-mhat; \
        const float f=__builtin_amdgcn_exp2f(-dl); l_reg*=f; if(hi==0)wsf[r32]=f; resc=true; } } \
    SBAR(); \
    GAPB(o[0]=__builtin_amdgcn_mfma_f32_32x32x16_bf16(PAF(0),VFR(0),o[0],0,0,0), C0,0); \
    GAPB(o[1]=__builtin_amdgcn_mfma_f32_32x32x16_bf16(PAF(0),VFR(4),o[1],0,0,0), C0,4); \
    KRD(GL,0); GAPB(o[0]=__builtin_amdgcn_mfma_f32_32x32x16_bf16(PAF(1),VFR(1),o[0],0,0,0), C0,8); \
    KRD(GL,1); GAPB(o[1]=__builtin_amdgcn_mfma_f32_32x32x16_bf16(PAF(1),VFR(5),o[1],0,0,0), C0,12); \
    KRD(GL,2); GAPB(o[0]=__builtin_amdgcn_mfma_f32_32x32x16_bf16(PAF(2),VFR(2),o[0],0,0,0), C1,0); \
    KRD(GL,3); GAPB(o[1]=__builtin_amdgcn_mfma_f32_32x32x16_bf16(PAF(2),VFR(6),o[1],0,0,0), C1,4); \
    GAPB(o[0]=__builtin_amdgcn_mfma_f32_32x32x16_bf16(PAF(3),VFR(3),o[0],0,0,0), C1,8); \
    GAPB(o[1]=__builtin_amdgcn_mfma_f32_32x32x16_bf16(PAF(3),VFR(7),o[1],0,0,0), C1,12); \
    }while(0)
  int t=1;
  #undef CMASK
  #define CMASK(P0,P1,t) do{}while(0)
  for(;t+5<NT;t+=2){
    STEP(pB0,pB1,pA0,pA1,t,true,true,true);     WAIT_BAR(2); RESC(); ROT();
    STEP(pA0,pA1,pB0,pB1,t+1,true,true,true);   WAIT_BAR(2); RESC(); ROT();
  }
  #undef CMASK
  #define CMASK(P0,P1,t) do{int jb_=(t)-(NT-4); if(jb_>=0)cmask(P0,P1,jb_,qrel,hi);}while(0)
  #define ENDW(tt) do{ if((tt)+3<NT){WAIT_BAR(2);} else if((tt)+2<NT){WAIT_BAR(1);} else {WAIT_BAR(0);} }while(0)
  for(;t+1<NT;t+=2){
    STEP(pB0,pB1,pA0,pA1,t,(t+3<NT),(t+1<NT),(t+1<NT));       ENDW(t);   RESC(); ROT();
    STEP(pA0,pA1,pB0,pB1,t+1,(t+4<NT),(t+2<NT),(t+2<NT));     ENDW(t+1); RESC(); ROT();
  }
  STEP(pB0,pB1,pA0,pA1,NT-1,false,false,false); RESC();
  { float sacc=pB0[0]+pB0[1]; _Pragma("unroll") for(int r=2;r<16;++r)sacc+=pB0[r]; _Pragma("unroll") for(int r=0;r<16;++r)sacc+=pB1[r]; l_reg+=sacc;
    pw0=(u32x4){PKW(pB0,0),PKW(pB0,2),PKW(pB0,4),PKW(pB0,6)};pw1=(u32x4){PKW(pB0,8),PKW(pB0,10),PKW(pB0,12),PKW(pB0,14)};pw2=(u32x4){PKW(pB1,0),PKW(pB1,2),PKW(pB1,4),PKW(pB1,6)};pw3=(u32x4){PKW(pB1,8),PKW(pB1,10),PKW(pB1,12),PKW(pB1,14)};
    SBAR(); pv(o,vb0+sl_cur,PAF(0),PAF(1),PAF(2),PAF(3)); }
  #undef PKW
  #undef PAF
  #undef VFR
  #undef PIN
  #undef MX3
  #undef GAPA
  #undef GAPB
  #undef EX
  #undef VRD
  #undef KRD
  #undef STEP
  #undef ENDW
  {auto rr=__builtin_amdgcn_permlane32_swap(__float_as_uint(l_reg),__float_as_uint(l_reg),false,false);l_reg=__uint_as_float(rr[0])+__uint_as_float(rr[1]);}
  if(hi==0)wsf[32+r32]=l_reg;asm volatile("s_waitcnt lgkmcnt(0)":::"memory");
  float rli[16];
  #pragma unroll
  for(int r=0;r<16;++r)rli[r]=__builtin_amdgcn_rcpf(wsf[32+crow(r,hi)]);
  bf16*Ow=O+(rowbase+q0+wid*QBLK)*DMO+h*D;
  { bf16*stg=(bf16*)(shm+LDS_OST)+wid*2048;
    #pragma unroll
    for(int r=0;r<16;++r){const int orow=crow(r,hi);
      #pragma unroll
      for(int d0=0;d0<2;++d0)stg[orow*64+d0*32+r32]=__float2bfloat16(o[d0][r]*rli[r]);}
    asm volatile("s_waitcnt lgkmcnt(0)":::"memory");
    #pragma unroll
    for(int i=0;i<4;++i){const int row=i*8+(lane>>3),ch=lane&7; const u32x4 v=*(const u32x4*)(stg+row*64+ch*8); ATTN_STORE16(Ow+(long)row*DMO+ch*8,v);} }
  asm volatile("s_waitcnt lgkmcnt(0)\n\ts_barrier":::"memory");
  #undef DMA_K
  #undef DMA_V
  #undef CMASK
  #undef START
  #undef RESC
  #undef ROT
  #undef KBIAS
}
constexpr int ATTN_LDS_BYTES=LDS_BYTES;
struct AttnTensors { const bf16* Q; const bf16* K; const bf16* V; bf16* O; const float* cum; };
struct AttnUnit { int bh; int qb; };
struct StaticOrder {
  int vcu;
  __device__ __forceinline__ explicit StaticOrder(int grid,int block):vcu((block%8)*(grid/8)+block/8){}
  __device__ __forceinline__ bool next(int i,AttnUnit&u)const{ if(i>=2)return false; const int s=vcu&7; u.bh=vcu>>3; u.qb=(i==0)?15-s:s; return true; }
  __device__ __forceinline__ void a_ready(const AttnUnit&)const{}
  __device__ __forceinline__ void done(const AttnUnit&)const{}
};
template<class Sched,int THRL=8> __device__ __forceinline__ void attn_phase(char*lds,const AttnTensors&T,const Sched&S){
  AttnUnit u;
  for(int i=0;S.next(i,u);++i){ S.a_ready(u); attn_unit<THRL>(u.bh/NHEAD,u.bh%NHEAD,u.qb,T.Q,T.K,T.V,T.O,T.cum+(long)u.bh*SEQ,lds); S.done(u); }
}
#undef SBAR
#undef WAIT_BAR
}
namespace cg = cooperative_groups;
#ifndef PH_PRO
#define PH_PRO 1
#endif
#ifndef PH_NORM
#define PH_NORM 1
#endif
#ifndef PH_GIN
#define PH_GIN 1
#endif
#ifndef PH_POOL
#define PH_POOL 1
#endif
#ifndef PH_CONV
#define PH_CONV 1
#endif
#ifndef PH_RKV
#define PH_RKV 1
#endif
#ifndef PH_ATT
#define PH_ATT 1
#endif
#ifndef PH_RET
#define PH_RET 1
#endif
#ifndef PH_GOUT
#define PH_GOUT 1
#endif
#ifndef PH_GUP
#define PH_GUP 1
#endif
#ifndef PH_GDN
#define PH_GDN 1
#endif
#ifndef REP_NORM
#define REP_NORM 1
#endif
#ifndef REP_C1
#define REP_C1 1
#endif
#ifndef REP_ATT
#define REP_ATT 1
#endif
#ifndef REP_RET
#define REP_RET 1
#endif
#define LAS __attribute__((address_space(3)))
typedef unsigned short bf16;
typedef unsigned v4u __attribute__((ext_vector_type(4)));
typedef unsigned v2u __attribute__((ext_vector_type(2)));
typedef float f32x4 __attribute__((ext_vector_type(4)));
typedef float f32x16 __attribute__((ext_vector_type(16)));
typedef short bf16x8 __attribute__((ext_vector_type(8)));

constexpr int NWAVES = 8, NTHR = 512;
constexpr int BATCH = 8, SEQ = 4096, DMODEL = 1024, MROWS = BATCH * SEQ, DEPTH = 4;
constexpr int NU = 2560, NIN = 2564, DFF = 2816, NH2 = 5632, MODW = 6144;
constexpr float EPS = 1e-6f, LOG2E = 1.4426950408889634f;
constexpr int LDS_BYTES = 147456;

constexpr size_t MiB = 1u << 20;
constexpr size_t WS_MOD = 1 * MiB, WS_CUM = 2 * MiB, WS_FF = 3 * MiB, WS_W = 4 * MiB;
constexpr size_t WOFF_IN = 0, WOFF_OUT = (size_t)NU * 1024, WOFF_13 = WOFF_OUT + 1024 * 1024, WOFF_2 = WOFF_13 + (size_t)NH2 * 1024, W_LAYER = WOFF_2 + (size_t)1024 * DFF;
constexpr size_t WS_H = 98 * MiB, WS_U = 162 * MiB, WS_MIX = 322 * MiB, WS_HID = 162 * MiB, WS_KV = 386 * MiB, WS_VT = 402 * MiB, WS_END = 418 * MiB;
static_assert(WS_W + DEPTH * W_LAYER * 2 <= WS_H, "weights fit");
static_assert(WS_HID + (size_t)MROWS * DFF * 2 <= WS_KV, "hid overlay fits");

#define LDS_WAIT() asm volatile("s_waitcnt lgkmcnt(0)" ::: "memory")
__device__ __forceinline__ unsigned f2bf(float f) { unsigned u = __builtin_bit_cast(unsigned, f); return (u + 0x7fffu + ((u >> 16) & 1u)) >> 16; }
__device__ __forceinline__ unsigned pk2(float lo, float hi) { return f2bf(lo) | (f2bf(hi) << 16); }
__device__ __forceinline__ float bf2f(unsigned b) { return __builtin_bit_cast(float, b << 16); }
__device__ __forceinline__ float bfe(const v4u& v, int e) { return bf2f((v[e >> 1] >> (16 * (e & 1))) & 0xffffu); }
__device__ __forceinline__ float bfe2(const v2u& v, int e) { return bf2f((v[e >> 1] >> (16 * (e & 1))) & 0xffffu); }
__device__ __forceinline__ float wave_sum(float v) {
#pragma unroll
    for (int o = 1; o < 64; o <<= 1) v += __shfl_xor(v, o);
    return v;
}
__device__ __forceinline__ float siluf(float v) { return v * __builtin_amdgcn_rcpf(1.0f + __builtin_amdgcn_exp2f(-LOG2E * v)); }
__device__ __forceinline__ int crow(int r, int hi) { return (r & 3) + 8 * (r >> 2) + 4 * hi; }

__device__ __forceinline__ void transpose_item(const float* W, int ld, int k0, int scol0, bf16* WT, int Kd, int drow0, LAS float* scr, int lane) {
#pragma unroll 8
    for (int i = 0; i < 32; ++i) { const int kk = 2 * i + (lane >> 5); scr[kk * 33 + (lane & 31)] = W[(size_t)(k0 + kk) * ld + scol0 + (lane & 31)]; }
    LDS_WAIT(); asm volatile("" ::: "memory");
    const int c = lane & 7;
#pragma unroll
    for (int j = 0; j < 4; ++j) { const int n = (lane >> 3) + 8 * j; const LAS float* s = scr + (8 * c) * 33 + n;
        v4u o; o.x = pk2(s[0 * 33], s[1 * 33]); o.y = pk2(s[2 * 33], s[3 * 33]); o.z = pk2(s[4 * 33], s[5 * 33]); o.w = pk2(s[6 * 33], s[7 * 33]);
        *(v4u*)(WT + (size_t)(drow0 + n) * Kd + k0 + 8 * c) = o; }
    LDS_WAIT(); asm volatile("" ::: "memory");
}

template <bool FF>
__device__ __forceinline__ void norm_phase(LAS unsigned char* lds, const float* xin, const float* g, const float* msc, const float* msh, bf16* hout, const float* wfcols, float* ffout,
                                           int bx, int G, int tid, int lane, int wave) {
    LAS f32x4* gs4 = (LAS f32x4*)lds; LAS f32x4* sh4 = (LAS f32x4*)(lds + 4096); LAS f32x4* wf4 = (LAS f32x4*)(lds + 8192);
    for (int rb = bx; rb < MROWS / 128; rb += G) {
        const int b = rb / (SEQ / 128);
        if (tid < 256) { const f32x4 gv = ((const f32x4*)g)[tid], scv = ((const f32x4*)(msc + (size_t)b * MODW))[tid]; gs4[tid] = gv * (1.0f + scv); sh4[tid] = ((const f32x4*)(msh + (size_t)b * MODW))[tid]; }
        if (FF) for (int k = tid; k < 1024; k += NTHR) wf4[k] = *(const f32x4*)(wfcols + (size_t)k * NIN);
        __syncthreads();
        f32x4 nv[4];
        { const f32x4* xr0 = (const f32x4*)(xin + (size_t)(rb * 128 + wave * 16) * 1024) + lane;
#pragma unroll
          for (int j = 0; j < 4; ++j) nv[j] = xr0[64 * j]; }
        for (int i = 0; i < 16; ++i) {
            const int row = rb * 128 + wave * 16 + i;
            f32x4 v[4]; float ss = 0.f;
#pragma unroll
            for (int j = 0; j < 4; ++j) { v[j] = nv[j]; ss += (v[j].x * v[j].x + v[j].y * v[j].y) + (v[j].z * v[j].z + v[j].w * v[j].w); }
            if (i < 15) { const f32x4* xr = (const f32x4*)(xin + (size_t)(row + 1) * 1024) + lane;
#pragma unroll
                for (int j = 0; j < 4; ++j) nv[j] = xr[64 * j]; }
            ss = wave_sum(ss);
            const float rstd = 1.0f / sqrtf(ss * (1.0f / 1024.0f) + EPS);
            float f0 = 0.f, f1 = 0.f, f2 = 0.f, f3 = 0.f;
            unsigned long long* o8 = (unsigned long long*)(hout + (size_t)row * 1024) + lane;
#pragma unroll
            for (int j = 0; j < 4; ++j) {
                const f32x4 hv = v[j] * rstd * gs4[lane + 64 * j] + sh4[lane + 64 * j];
                o8[64 * j] = (unsigned long long)pk2(hv.x, hv.y) | ((unsigned long long)pk2(hv.z, hv.w) << 32);
                if (FF) { const int k = 4 * lane + 256 * j; const f32x4 w0 = wf4[k], w1 = wf4[k + 1], w2 = wf4[k + 2], w3 = wf4[k + 3];
                    f0 += hv.x * w0.x + hv.y * w1.x + hv.z * w2.x + hv.w * w3.x; f1 += hv.x * w0.y + hv.y * w1.y + hv.z * w2.y + hv.w * w3.y;
                    f2 += hv.x * w0.z + hv.y * w1.z + hv.z * w2.z + hv.w * w3.z; f3 += hv.x * w0.w + hv.y * w1.w + hv.z * w2.w + hv.w * w3.w; }
            }
            if (FF) { f0 = wave_sum(f0); f1 = wave_sum(f1); f2 = wave_sum(f2); f3 = wave_sum(f3); if (lane == 0) *(f32x4*)(ffout + (size_t)row * 4) = (f32x4){f0, f1, f2, f3}; }
        }
        __syncthreads();
    }
}

__device__ __forceinline__ void cum_scan(LAS unsigned char* lds, const float* ff, const float* fb, float* cumL, int bh, int tid, int lane, int wave) {
    const int b = bh >> 2, h = bh & 3; const float fbh = fb[h];
    float v[8]; float run = 0.f;
#pragma unroll
    for (int i = 0; i < 8; ++i) { const int s = tid * 8 + i; const float z = ff[((size_t)b * SEQ + s) * 4 + h] + fbh;
        const float ls = fminf(z, 0.f) - log1pf(expf(-fabsf(z))); run += ls * LOG2E; v[i] = run; }
    float incl = run;
#pragma unroll
    for (int o = 1; o < 64; o <<= 1) { const float t = __shfl_up(incl, o); if (lane >= o) incl += t; }
    LAS float* wt = (LAS float*)lds;
    if (lane == 63) wt[wave] = incl;
    __syncthreads();
    float off = incl - run;
    for (int ww = 0; ww < wave; ++ww) off += wt[ww];
    float* op = cumL + (size_t)bh * SEQ + tid * 8;
    *(f32x4*)op = (f32x4){v[0] + off, v[1] + off, v[2] + off, v[3] + off}; *(f32x4*)(op + 4) = (f32x4){v[4] + off, v[5] + off, v[6] + off, v[7] + off};
    __syncthreads();
}

constexpr int TP = 146;
__device__ __forceinline__ void pool_unit(LAS unsigned char* lds, const bf16* U, const float* pw, const float* psc, bf16* MIX, int u, int tid) {
    const int b = u >> 5, s0 = (u & 31) * 128;
    LAS bf16* tile = (LAS bf16*)lds;
    for (int task = tid; task < 143 * 32; task += NTHR) {
        const int tt = task >> 5, c8 = task & 31, s = s0 - 15 + tt;
        v4u v = (v4u){0u, 0u, 0u, 0u};
        if (s >= 0) v = *(const v4u*)(U + ((size_t)b * SEQ + s) * NU + 768 + 8 * c8);
#pragma unroll
        for (int e = 0; e < 8; ++e) tile[(8 * c8 + e) * TP + tt] = (bf16)((v[e >> 1] >> (16 * (e & 1))) & 0xffffu);
    }
    __syncthreads();
    {
        const int t = tid & 127, gi = __builtin_amdgcn_readfirstlane(tid >> 7), w = 2 << gi, s = s0 + t;
        const float inv = 1.0f / (float)((s + 1 < w) ? (s + 1) : w);
        float acc[64];
#pragma unroll
        for (int d = 0; d < 64; ++d) acc[d] = 0.f;
        const LAS bf16* base = tile + (gi * 64) * TP + t + 15;
        const float* pwg = pw + gi * 4096;
#pragma unroll 1
        for (int c = 0; c < 64; ++c) {
            const LAS bf16* bc = base + c * TP;
            float sum = 0.f;
            for (int j = 0; j < w; ++j) sum += bf2f(bc[-j]);
            const float dv = sum * inv - bf2f(bc[0]);
#pragma unroll
            for (int d = 0; d < 64; ++d) acc[d] += dv * pwg[c * 64 + d];
        }
        bf16* op = MIX + ((size_t)b * SEQ + s) * 1024 + 256 + gi * 64;
        const float* ps = psc + gi * 64;
#pragma unroll
        for (int q = 0; q < 8; ++q) { v4u o; o.x = pk2(acc[8 * q] * ps[8 * q], acc[8 * q + 1] * ps[8 * q + 1]); o.y = pk2(acc[8 * q + 2] * ps[8 * q + 2], acc[8 * q + 3] * ps[8 * q + 3]);
            o.z = pk2(acc[8 * q + 4] * ps[8 * q + 4], acc[8 * q + 5] * ps[8 * q + 5]); o.w = pk2(acc[8 * q + 6] * ps[8 * q + 6], acc[8 * q + 7] * ps[8 * q + 7]); *(v4u*)(op + 8 * q) = o; }
    }
    __syncthreads();
}

__device__ __forceinline__ void conv_unit(LAS unsigned char* lds, const bf16* U, const float* cw, const float* cb, const float* lng, const float* lnb, bf16* MIX, int u, int tid, int lane, int wave) {
    const int b = u >> 6, s0 = (u & 63) * 64;
    LAS float* hg = (LAS float*)lds;
    for (int task = tid; task < 94 * 32; task += NTHR) {
        const int tt = task >> 5, c8 = task & 31, s = s0 - 30 + tt;
        f32x4 h0 = (f32x4){0.f, 0.f, 0.f, 0.f}, h1 = h0;
        if (s >= 0) { const bf16* ur = U + ((size_t)b * SEQ + s) * NU + 2048 + 8 * c8; const v4u av = *(const v4u*)ur, gv = *(const v4u*)(ur + 256);
#pragma unroll
            for (int e = 0; e < 4; ++e) { h0[e] = bfe(av, e) * __builtin_amdgcn_rcpf(1.0f + __builtin_amdgcn_exp2f(-LOG2E * bfe(gv, e)));
                                          h1[e] = bfe(av, e + 4) * __builtin_amdgcn_rcpf(1.0f + __builtin_amdgcn_exp2f(-LOG2E * bfe(gv, e + 4))); } }
        *(LAS f32x4*)(hg + tt * 256 + 8 * c8) = h0; *(LAS f32x4*)(hg + tt * 256 + 8 * c8 + 4) = h1;
    }
    __syncthreads();
    {
        const int ch = tid & 255, half = tid >> 8;
        float w[31], acc[32];
#pragma unroll
        for (int j = 0; j < 31; ++j) w[j] = cw[j * 256 + ch];
        const float bias = cb[ch];
#pragma unroll
        for (int o = 0; o < 32; ++o) acc[o] = bias;
        const LAS float* hp = hg + (32 * half) * 256 + ch;
#pragma unroll
        for (int j = 0; j < 62; ++j) { const float v = hp[j * 256];
#pragma unroll
            for (int o = 0; o < 32; ++o) if (j - o >= 0 && j - o <= 30) acc[o] += v * w[j - o]; }
        __syncthreads();
#pragma unroll
        for (int o = 0; o < 32; ++o) hg[(32 * half + o) * 256 + ch] = acc[o];
    }
    __syncthreads();
    for (int i = 0; i < 8; ++i) {
        const int tok = wave * 8 + i;
        const f32x4 y = *(const LAS f32x4*)(hg + tok * 256 + 4 * lane);
        const float mean = wave_sum((y.x + y.y) + (y.z + y.w)) * (1.0f / 256.0f);
        const f32x4 d = y - mean;
        const float var = wave_sum((d.x * d.x + d.y * d.y) + (d.z * d.z + d.w * d.w)) * (1.0f / 256.0f);
        const float rstd = 1.0f / sqrtf(var + EPS);
        const f32x4 z = d * rstd * *(const f32x4*)(lng + 4 * lane) + *(const f32x4*)(lnb + 4 * lane);
        v2u o; o.x = pk2(siluf(z.x), siluf(z.y)); o.y = pk2(siluf(z.z), siluf(z.w));
        *(v2u*)(MIX + ((size_t)b * SEQ + s0 + tok) * 1024 + 768 + 4 * lane) = o;
    }
    __syncthreads();
}

constexpr int TJ = 136, TS = 72;
__device__ __forceinline__ void retkv_unit(LAS unsigned char* lds, bf16* U, const int* positions, float* KV, bf16* VT, int u, int tid, int lane, int wave) {
    const int b = u >> 7, n = (u >> 2) & 31, h = u & 3;
    LAS bf16* Kt = (LAS bf16*)lds;
    LAS bf16* Vt = (LAS bf16*)(lds + 64 * TJ * 2);
    const float lg = log2f(1.0f - exp2f(-5.0f - (float)h));
    {
        const int j = tid >> 2, p = tid & 3;
        const size_t row = (size_t)b * SEQ + n * 128 + j;
        bf16* ur = U + row * NU;
        const float pos = (float)positions[row];
        const float gq = exp2f(lg * (float)j), gk = 0.125f * exp2f(-lg * (float)j);
        const v4u q1 = *(const v4u*)(ur + 1024 + 64 * h + 8 * p), q2 = *(const v4u*)(ur + 1024 + 64 * h + 32 + 8 * p);
        const v4u k1 = *(const v4u*)(ur + 1280 + 64 * h + 8 * p), k2 = *(const v4u*)(ur + 1280 + 64 * h + 32 + 8 * p);
        const v4u v1 = *(const v4u*)(ur + 1536 + 64 * h + 8 * p), v2 = *(const v4u*)(ur + 1536 + 64 * h + 32 + 8 * p);
        unsigned qa[8], qb[8], ka[8], kb[8];
#pragma unroll
        for (int ii = 0; ii < 8; ++ii) {
            const int i = 8 * p + ii;
            const float inv = exp2f(-(float)i * (13.287712379549449f / 32.0f));
            const float ang = pos * inv;
            float rev = ang * 0.15915494309189535f; rev -= floorf(rev);
            const float sn = __builtin_amdgcn_sinf(rev), cs = __builtin_amdgcn_cosf(rev);
            const float a = bfe(q1, ii), c = bfe(q2, ii), ak = bfe(k1, ii), ck = bfe(k2, ii);
            qa[ii] = f2bf((a * cs - c * sn) * gq); qb[ii] = f2bf((a * sn + c * cs) * gq);
            ka[ii] = f2bf((ak * cs - ck * sn) * gk); kb[ii] = f2bf((ak * sn + ck * cs) * gk);
            Kt[(8 * p + ii) * TJ + j] = (bf16)ka[ii]; Kt[(32 + 8 * p + ii) * TJ + j] = (bf16)kb[ii];
            Vt[(8 * p + ii) * TJ + j] = (bf16)((v1[ii >> 1] >> (16 * (ii & 1))) & 0xffffu); Vt[(32 + 8 * p + ii) * TJ + j] = (bf16)((v2[ii >> 1] >> (16 * (ii & 1))) & 0xffffu);
        }
        *(v4u*)(ur + 1024 + 64 * h + 8 * p) = (v4u){qa[0] | (qa[1] << 16), qa[2] | (qa[3] << 16), qa[4] | (qa[5] << 16), qa[6] | (qa[7] << 16)};
        *(v4u*)(ur + 1024 + 64 * h + 32 + 8 * p) = (v4u){qb[0] | (qb[1] << 16), qb[2] | (qb[3] << 16), qb[4] | (qb[5] << 16), qb[6] | (qb[7] << 16)};
        *(v4u*)(ur + 1280 + 64 * h + 8 * p) = (v4u){ka[0] | (ka[1] << 16), ka[2] | (ka[3] << 16), ka[4] | (ka[5] << 16), ka[6] | (ka[7] << 16)};
        *(v4u*)(ur + 1280 + 64 * h + 32 + 8 * p) = (v4u){kb[0] | (kb[1] << 16), kb[2] | (kb[3] << 16), kb[4] | (kb[5] << 16), kb[6] | (kb[7] << 16)};
    }
    __syncthreads();
    if (wave < 4) {
        const int db = wave >> 1, eb = wave & 1, r32 = lane & 31, hi = lane >> 5;
        f32x16 acc;
#pragma unroll
        for (int r = 0; r < 16; ++r) acc[r] = 0.f;
#pragma unroll
        for (int ks = 0; ks < 8; ++ks) {
            const bf16x8 A = *(const LAS bf16x8*)(Kt + (32 * db + r32) * TJ + 16 * ks + 8 * hi);
            const bf16x8 B = *(const LAS bf16x8*)(Vt + (32 * eb + r32) * TJ + 16 * ks + 8 * hi);
            acc = __builtin_amdgcn_mfma_f32_32x32x16_bf16(A, B, acc, 0, 0, 0);
        }
        const float g127 = exp2f(lg * 127.0f);
        float* kvp = KV + (size_t)u * 4096;
#pragma unroll
        for (int r = 0; r < 16; ++r) kvp[(32 * db + crow(r, hi)) * 64 + 32 * eb + r32] = acc[r] * g127;
    }
    for (int p = tid; p < 1024; p += NTHR) { const int e = p >> 4, jc = p & 15; *(v4u*)(VT + (size_t)u * 8192 + e * 128 + 8 * jc) = *(const LAS v4u*)(Vt + e * TJ + 8 * jc); }
    __syncthreads();
}

__device__ __forceinline__ void retout_pair(LAS unsigned char* lds, const bf16* U, const float* KV, const bf16* VT, const float* gn, bf16* MIX, int up, int tid, int lane, int wave) {
    const int half = wave >> 2, w4 = wave & 3, t256 = tid & 255;
    const int u = up * 2 + half; const int b = u >> 7, n = (u >> 2) & 31, h = u & 3;
    LAS bf16* St = (LAS bf16*)(lds + half * (64 * TS * 2));
    const float lg = log2f(1.0f - exp2f(-5.0f - (float)h));
    {
        const float decay = exp2f(lg * 128.0f), gam = exp2f(lg);
        const int d = t256 >> 2, e0 = (t256 & 3) * 16;
        f32x4 s[4];
#pragma unroll
        for (int q = 0; q < 4; ++q) s[q] = (f32x4){0.f, 0.f, 0.f, 0.f};
        const float* kvb = KV + ((size_t)(b * 32) * 4 + h) * 4096 + d * 64 + e0;
        int m = 0;
        for (; m + 4 <= n; m += 4) { f32x4 t[4][4];
#pragma unroll
            for (int mm = 0; mm < 4; ++mm) { const f32x4* p = (const f32x4*)(kvb + (size_t)(m + mm) * 4 * 4096);
#pragma unroll
                for (int q = 0; q < 4; ++q) t[mm][q] = p[q]; }
#pragma unroll
            for (int mm = 0; mm < 4; ++mm)
#pragma unroll
                for (int q = 0; q < 4; ++q) s[q] = s[q] * decay + t[mm][q]; }
        for (; m < n; ++m) { const f32x4* p = (const f32x4*)(kvb + (size_t)m * 4 * 4096);
#pragma unroll
            for (int q = 0; q < 4; ++q) s[q] = s[q] * decay + p[q]; }
#pragma unroll
        for (int q = 0; q < 4; ++q)
#pragma unroll
            for (int c = 0; c < 4; ++c) St[(e0 + 4 * q + c) * TS + d] = (bf16)f2bf(s[q][c] * gam);
    }
    __syncthreads();
    {
        const int ib = w4, r32 = lane & 31, hi = lane >> 5;
        const size_t row0 = (size_t)b * SEQ + n * 128;
        const bf16* qp = U + (row0 + 32 * ib + r32) * NU + 1024 + 64 * h + 8 * hi;
        bf16x8 qf[4];
#pragma unroll
        for (int d0 = 0; d0 < 4; ++d0) qf[d0] = *(const bf16x8*)(qp + 16 * d0);
        f32x16 o[2];
#pragma unroll
        for (int r = 0; r < 16; ++r) { o[0][r] = 0.f; o[1][r] = 0.f; }
#pragma unroll
        for (int d0 = 0; d0 < 4; ++d0)
#pragma unroll
            for (int eb = 0; eb < 2; ++eb) { const bf16x8 A = *(const LAS bf16x8*)(St + (32 * eb + r32) * TS + 16 * d0 + 8 * hi); o[eb] = __builtin_amdgcn_mfma_f32_32x32x16_bf16(A, qf[d0], o[eb], 0, 0, 0); }
        const bf16* vtb = VT + (size_t)u * 8192;
        for (int jb = 0; jb <= ib; ++jb) {
            const bf16* kp = U + (row0 + 32 * jb + r32) * NU + 1280 + 64 * h + 8 * hi;
            f32x16 st;
#pragma unroll
            for (int r = 0; r < 16; ++r) st[r] = 0.f;
#pragma unroll
            for (int d0 = 0; d0 < 4; ++d0) st = __builtin_amdgcn_mfma_f32_32x32x16_bf16(*(const bf16x8*)(kp + 16 * d0), qf[d0], st, 0, 0, 0);
            if (jb == ib) {
#pragma unroll
                for (int r = 0; r < 16; ++r) if (crow(r, hi) > r32) st[r] = 0.f;
            }
#pragma unroll
            for (int k = 0; k < 2; ++k) {
                v4u pbw; pbw.x = pk2(st[8 * k], st[8 * k + 1]); pbw.y = pk2(st[8 * k + 2], st[8 * k + 3]); pbw.z = pk2(st[8 * k + 4], st[8 * k + 5]); pbw.w = pk2(st[8 * k + 6], st[8 * k + 7]);
                const bf16x8 pb = __builtin_bit_cast(bf16x8, pbw);
#pragma unroll
                for (int eb = 0; eb < 2; ++eb) {
                    const bf16* vp = vtb + (32 * eb + r32) * 128 + 32 * jb + 16 * k + 4 * hi;
                    const v2u lo = *(const v2u*)vp, hh = *(const v2u*)(vp + 8);
                    const bf16x8 A = __builtin_bit_cast(bf16x8, (v4u){lo.x, lo.y, hh.x, hh.y});
                    o[eb] = __builtin_amdgcn_mfma_f32_32x32x16_bf16(A, pb, o[eb], 0, 0, 0);
                }
            }
        }
        float sum = 0.f;
#pragma unroll
        for (int r = 0; r < 16; ++r) sum += o[0][r] + o[1][r];
        sum += __shfl_xor(sum, 32);
        const float mu = sum * (1.0f / 64.0f);
        float var = 0.f;
#pragma unroll
        for (int r = 0; r < 16; ++r) { const float d0 = o[0][r] - mu, d1 = o[1][r] - mu; var += d0 * d0 + d1 * d1; }
        var += __shfl_xor(var, 32);
        const float rstd = 1.0f / sqrtf(var * (1.0f / 64.0f) + EPS);
        const size_t tok = row0 + 32 * ib + r32;
        const bf16* gp = U + tok * NU + 1792 + 64 * h;
        bf16* op = MIX + tok * 1024 + 512 + 64 * h;
#pragma unroll
        for (int eb = 0; eb < 2; ++eb)
#pragma unroll
            for (int g4 = 0; g4 < 4; ++g4) {
                const int e = 32 * eb + 8 * g4 + 4 * hi;
                const v2u gw = *(const v2u*)(gp + e); const f32x4 gg = *(const f32x4*)(gn + 64 * h + e);
                float y[4];
#pragma unroll
                for (int c = 0; c < 4; ++c) y[c] = siluf(bfe2(gw, c)) * ((o[eb][4 * g4 + c] - mu) * rstd * gg[c]);
                v2u ov; ov.x = pk2(y[0], y[1]); ov.y = pk2(y[2], y[3]);
                *(v2u*)(op + e) = ov;
            }
    }
    __syncthreads();
}

struct Args { const void* in[21]; float* out; unsigned char* ws; };
__global__ void __launch_bounds__(NTHR, 2) fwd_kernel(Args a) {
    extern __shared__ __attribute__((aligned(16))) unsigned char lds_raw[];
    cg::grid_group grid = cg::this_grid();
    LAS unsigned char* lds = (LAS unsigned char*)lds_raw;
    int tid = threadIdx.x, lane = tid & 63, wave = __builtin_amdgcn_readfirstlane(tid >> 6);
    const int G = gridDim.x; int bx = blockIdx.x;
    int vcu = (G % 8 == 0) ? (bx % 8) * (G / 8) + bx / 8 : bx;
#define RELAUNDER() do { tid = threadIdx.x; asm volatile("" : "+v"(tid)); lane = tid & 63; wave = __builtin_amdgcn_readfirstlane(tid >> 6); bx = blockIdx.x; asm volatile("" : "+s"(bx)); vcu = (G % 8 == 0) ? (bx % 8) * (G / 8) + bx / 8 : bx; } while (0)
    const float* xin = (const float*)a.in[0]; const float* cin = (const float*)a.in[1]; const int* positions = (const int*)a.in[2];
    const float* ada_w = (const float*)a.in[3]; const float* ada_b = (const float*)a.in[4];
    const float* norm_mix_g = (const float*)a.in[5]; const float* norm_ffn_g = (const float*)a.in[6];
    const float* w_in = (const float*)a.in[7]; const float* fox_fb = (const float*)a.in[8];
    const float* pool_w = (const float*)a.in[9]; const float* pool_scale = (const float*)a.in[10]; const float* ret_gn_g = (const float*)a.in[11];
    const float* conv_w = (const float*)a.in[12]; const float* conv_b = (const float*)a.in[13]; const float* conv_ln_g = (const float*)a.in[14]; const float* conv_ln_b = (const float*)a.in[15];
    const float* w_out = (const float*)a.in[16]; const float* ffn_w1 = (const float*)a.in[17]; const float* ffn_w3 = (const float*)a.in[18]; const float* ffn_w2 = (const float*)a.in[19];
    const float* final_g = (const float*)a.in[20];
    float* out = a.out; unsigned char* ws = a.ws;
    float* mod = (float*)(ws + WS_MOD); float* cumL = (float*)(ws + WS_CUM); float* ffb = (float*)(ws + WS_FF);
    bf16* WB = (bf16*)(ws + WS_W); bf16* H = (bf16*)(ws + WS_H); bf16* U = (bf16*)(ws + WS_U); bf16* MIX = (bf16*)(ws + WS_MIX); bf16* HID = (bf16*)(ws + WS_HID);
    float* KV = (float*)(ws + WS_KV); bf16* VT = (bf16*)(ws + WS_VT);

    if (PH_PRO) {
        LAS float* scr = (LAS float*)(lds + wave * 16384);
        const int gw = bx * NWAVES + wave, NGW = G * NWAVES;
        for (int it = gw; it < DEPTH * 6016; it += NGW) {
            const int l = it / 6016; int r = it - l * 6016;
            bf16* wl = WB + (size_t)l * W_LAYER;
            if (r < 1280) { const int kb = r / 80, n0 = 32 * (r % 80); transpose_item(w_in + (size_t)l * 1024 * NIN, NIN, 64 * kb, n0 + (n0 >= 768 ? 4 : 0), wl + WOFF_IN, 1024, n0, scr, lane); continue; } r -= 1280;
            if (r < 512) { const int kb = r / 32, n0 = 32 * (r % 32); transpose_item(w_out + (size_t)l * 1024 * 1024, 1024, 64 * kb, n0, wl + WOFF_OUT, 1024, n0, scr, lane); continue; } r -= 512;
            if (r < 1408) { const int kb = r / 88, n0 = 32 * (r % 88); transpose_item(ffn_w1 + (size_t)l * 1024 * DFF, DFF, 64 * kb, n0, wl + WOFF_13, 1024, (n0 / 128) * 256 + (n0 % 128), scr, lane); continue; } r -= 1408;
            if (r < 1408) { const int kb = r / 88, n0 = 32 * (r % 88); transpose_item(ffn_w3 + (size_t)l * 1024 * DFF, DFF, 64 * kb, n0, wl + WOFF_13, 1024, (n0 / 128) * 256 + 128 + (n0 % 128), scr, lane); continue; } r -= 1408;
            { const int kb = r / 32, n0 = 32 * (r % 32); transpose_item(ffn_w2 + (size_t)l * DFF * 1024, 1024, 64 * kb, n0, wl + WOFF_2, DFF, n0, scr, lane); }
        }
    }
    __syncthreads();
    if (PH_PRO) {
        LAS float* cact = (LAS float*)lds;
        LAS float* part = (LAS float*)(lds + 32768);
        for (int i = tid; i < BATCH * 1024; i += NTHR) { const float v = cin[i]; cact[i] = v / (1.0f + expf(-v)); }
        __syncthreads();
        for (int ch = bx; ch < DEPTH * 96; ch += G) {
            const int l = ch / 96, n0 = (ch % 96) * 64;
            const float* wp = ada_w + ((size_t)l * 1024 + wave * 128) * MODW + n0 + lane;
            float acc[8];
#pragma unroll
            for (int b = 0; b < 8; ++b) acc[b] = 0.f;
#pragma unroll 4
            for (int k = 0; k < 128; k += 4) {
                const float w0 = wp[(size_t)k * MODW], w1 = wp[(size_t)(k + 1) * MODW], w2 = wp[(size_t)(k + 2) * MODW], w3 = wp[(size_t)(k + 3) * MODW];
#pragma unroll
                for (int b = 0; b < 8; ++b) { const f32x4 cv = *(const LAS f32x4*)(cact + b * 1024 + wave * 128 + k); acc[b] += (cv.x * w0 + cv.y * w1) + (cv.z * w2 + cv.w * w3); }
            }
#pragma unroll
            for (int b = 0; b < 8; ++b) part[(wave * 8 + b) * 64 + lane] = acc[b];
            __syncthreads();
            { float s = ada_b[(size_t)l * MODW + n0 + lane];
#pragma unroll
              for (int ww = 0; ww < 8; ++ww) s += part[(ww * 8 + wave) * 64 + lane];
              mod[((size_t)l * 8 + wave) * MODW + n0 + lane] = s; }
            __syncthreads();
        }
    }
    grid.sync(); RELAUNDER();

    for (int l = 0; l < DEPTH; ++l) {
        const float* modl = mod + (size_t)l * 8 * MODW;
        bf16* wl = WB + (size_t)l * W_LAYER;
        const float* xcur = (l == 0) ? xin : out;
        for (int rp = 0; rp < REP_NORM; ++rp) norm_phase<true>(lds, xcur, norm_mix_g + l * 1024, modl + 1024, modl, H, w_in + (size_t)l * 1024 * NIN + 768, ffb, bx, G, tid, lane, wave);
        grid.sync(); RELAUNDER();
        if (PH_GIN) {
            if (bx < 32) cum_scan(lds, ffb, fox_fb + l * 4, cumL, bx, tid, lane, wave);
            __syncthreads();
            pg8::Gemm g{H, wl + WOFF_IN, MROWS, NU, 1024}; pg8::StaticOrder S; S.init(MROWS, NU, G, bx);
            pg8::EpiU E{U, NU, attn_body::C2};
            pg8::gemm_phase<pg8::EpiU, pg8::StaticOrder, true, true>(lds, g, S, E);
        }
        grid.sync(); RELAUNDER();
        for (int rp = 0; rp < REP_C1; ++rp) for (int u = vcu; u < 256; u += G) pool_unit(lds, U, pool_w + (size_t)l * 4 * 4096, pool_scale + l * 256, MIX, u, tid);
        RELAUNDER();
        for (int rp = 0; rp < REP_C1; ++rp) for (int u = vcu; u < 512; u += G) conv_unit(lds, U, conv_w + (size_t)l * 31 * 256, conv_b + l * 256, conv_ln_g + l * 256, conv_ln_b + l * 256, MIX, u, tid, lane, wave);
        RELAUNDER();
        if (PH_RKV) for (int u = vcu; u < 1024; u += G) retkv_unit(lds, U, positions, KV, VT, u, tid, lane, wave);
        grid.sync(); RELAUNDER();
        for (int rp = 0; rp < REP_ATT; ++rp) {
            const attn_body::AttnTensors AT{(const attn_body::bf16*)U, (const attn_body::bf16*)(U + 256), (const attn_body::bf16*)(U + 512), (attn_body::bf16*)MIX, cumL};
            const attn_body::StaticOrder S(G, bx);
            attn_body::attn_phase<attn_body::StaticOrder>((char*)lds_raw, AT, S);
        }
        __syncthreads(); RELAUNDER();
        for (int rp = 0; rp < REP_RET; ++rp) for (int up = vcu; up < 512; up += G) retout_pair(lds, U, KV, VT, ret_gn_g + l * 256, MIX, up, tid, lane, wave);
        grid.sync(); RELAUNDER();
        if (PH_GOUT) {
            pg8::Gemm g{MIX, wl + WOFF_OUT, MROWS, 1024, 1024}; pg8::StaticOrder S; S.init(MROWS, 1024, G, bx);
            pg8::EpiRes E{xcur, out, modl + 2048};
            pg8::gemm_phase<pg8::EpiRes, pg8::StaticOrder, true, true>(lds, g, S, E);
        }
        grid.sync(); RELAUNDER();
        for (int rp = 0; rp < REP_NORM; ++rp) norm_phase<false>(lds, out, norm_ffn_g + l * 1024, modl + 4096, modl + 3072, H, nullptr, nullptr, bx, G, tid, lane, wave);
        grid.sync(); RELAUNDER();
        if (PH_GUP) {
            pg8::Gemm g{H, wl + WOFF_13, MROWS, NH2, 1024}; pg8::StaticOrder S; S.init(MROWS, NH2, G, bx);
            pg8::EpiSwiGLU E{HID, DFF};
            pg8::gemm_phase<pg8::EpiSwiGLU, pg8::StaticOrder, true, true>(lds, g, S, E);
        }
        grid.sync(); RELAUNDER();
        if (PH_GDN) {
            pg8::Gemm g{HID, wl + WOFF_2, MROWS, 1024, DFF}; pg8::StaticOrder S; S.init(MROWS, 1024, G, bx);
            pg8::EpiRes E{out, out, modl + 5120};
            pg8::gemm_phase<pg8::EpiRes, pg8::StaticOrder, true, true>(lds, g, S, E);
        }
        grid.sync(); RELAUNDER();
    }
    {
        const int gw = bx * NWAVES + wave, NGW = G * NWAVES;
        for (int row = gw; row < MROWS; row += NGW) {
            f32x4* xr = (f32x4*)(out + (size_t)row * 1024) + lane;
            f32x4 v[4]; float ss = 0.f;
#pragma unroll
            for (int j = 0; j < 4; ++j) { v[j] = xr[64 * j]; ss += (v[j].x * v[j].x + v[j].y * v[j].y) + (v[j].z * v[j].z + v[j].w * v[j].w); }
            ss = wave_sum(ss);
            const float rstd = 1.0f / sqrtf(ss * (1.0f / 1024.0f) + EPS);
#pragma unroll
            for (int j = 0; j < 4; ++j) xr[64 * j] = v[j] * rstd * ((const f32x4*)final_g)[lane + 64 * j];
        }
    }
}

extern "C" void kernel_launch(void* const* d_in, const int* in_sizes, int n_in, void* d_out, int out_size, void* d_ws, size_t ws_size, hipStream_t stream) {
    static int grid = 0;
    if (grid == 0) {
        if (n_in != 21 || out_size != MROWS * 1024 || ws_size < WS_END) { fprintf(stderr, "kernel_launch: unexpected shapes: n_in %d out %d ws %zu (need %zu)\n", n_in, out_size, ws_size, (size_t)WS_END); grid = -1; return; }
        int dev = 0, cus = 0, per_cu = 0;
        hipGetDevice(&dev); hipDeviceGetAttribute(&cus, hipDeviceAttributeMultiprocessorCount, dev);
        if (hipFuncSetAttribute((const void*)fwd_kernel, hipFuncAttributeMaxDynamicSharedMemorySize, LDS_BYTES) != hipSuccess) { fprintf(stderr, "kernel_launch: hipFuncSetAttribute failed\n"); grid = -1; return; }
        if (hipOccupancyMaxActiveBlocksPerMultiprocessor(&per_cu, (const void*)fwd_kernel, NTHR, LDS_BYTES) != hipSuccess || per_cu < 1) { fprintf(stderr, "kernel_launch: occupancy query says %d\n", per_cu); per_cu = 1; }
        (void)hipGetLastError();
        grid = cus;
        if (grid != 256) fprintf(stderr, "kernel_launch: %d CUs; the attention deal assumes 256\n", grid);
    }
    if (grid < 0) return;
    Args a{};
    for (int i = 0; i < 21; ++i) a.in[i] = d_in[i];
    a.out = (float*)d_out; a.ws = (unsigned char*)d_ws;
    void* args[] = {&a};
    hipError_t e = hipLaunchCooperativeKernel((const void*)fwd_kernel, dim3(grid), dim3(NTHR), args, LDS_BYTES, stream);
    if (e != hipSuccess) fprintf(stderr, "kernel_launch: cooperative launch failed: %s (grid %d)\n", hipGetErrorString(e), grid);
}
```

```cpp
#include <hip/hip_runtime.h>
#include <hip/hip_cooperative_groups.h>
#include <cstdio>
#include <cstdint>
namespace pg8 {
#define PG8_LAS __attribute__((address_space(3)))
typedef unsigned short bf16_t;
typedef short bf16x8 __attribute__((ext_vector_type(8)));
typedef float f32x4 __attribute__((ext_vector_type(4)));
typedef unsigned u32x4 __attribute__((ext_vector_type(4)));
constexpr int BM = 256, BK = 64, HALF = 128, HTB = HALF * BK * 2  , STAGE_BYTES = 8 * HTB, NXCD = 8, WGM = 8;

__host__ __device__ __forceinline__ int lds_byte(int r, int c) { const int st = (r >> 4) * 2 + (c >> 5), rr = r & 15, cc = c & 31, ob = rr * 64 + cc * 2; return st * 1024 + (ob ^ (((ob >> 9) & 1) << 5)); }
__host__ __device__ __forceinline__ void stage_rc(int b, int& R, int& C) { const int st = b / 1024, sb = b % 1024, swz = sb ^ (((sb >> 9) & 1) << 5); R = (st >> 1) * 16 + swz / 64; C = (st & 1) * 32 + (swz % 64) / 2; }
__host__ __device__ __forceinline__ int perm32(int rho) { const int n = rho >> 4, i = rho & 15; return 8 * (i >> 2) + 4 * n + (i & 3); }

struct Unit { int pm, pn; };
struct Gemm { const bf16_t* A; const bf16_t* Bt; int M, N, K; };

struct StaticOrder {
    int nM, nN, nwg, G, c;
    __host__ __device__ void init(int M, int N, int G_, int c_) { nM = M / BM; nN = N / BM; nwg = nM * nN; G = G_; c = c_; }
    __host__ __device__ bool next(int i, Unit& u) const {
        const long L = (long)i * G + c; if (L >= nwg) return false;
        int wgid = (int)L; { const int q = nwg / NXCD, r = nwg % NXCD, xcd = wgid % NXCD, off = wgid / NXCD; wgid = (xcd < r ? xcd * (q + 1) : r * (q + 1) + (xcd - r) * q) + off; }
        const int nig = WGM * nN, gid = wgid / nig, fm = gid * WGM, gsz = (nM - fm) < WGM ? (nM - fm) : WGM;
        u.pm = fm + ((wgid % nig) % gsz); u.pn = (wgid % nig) / gsz; return true;
    }
    __device__ __forceinline__ void a_ready(const Unit&) const {}
    __device__ __forceinline__ void done(const Unit&) const {}
};

__device__ __forceinline__ unsigned cvt_pk_bf16(float lo, float hi) { unsigned r; asm volatile("v_cvt_pk_bf16_f32 %0, %1, %2" : "=v"(r) : "v"(lo), "v"(hi)); return r; }
typedef float f32x2 __attribute__((ext_vector_type(2)));
__device__ __forceinline__ float silu_f(float v) { return v * __builtin_amdgcn_rcpf(1.0f + __builtin_amdgcn_exp2f(-1.4426950408889634f * v)); }
struct EpiU {
    static constexpr bool PERM = true, AFTER_DRAIN = false;
    bf16_t* O; int ldc; float s0;
    __device__ __forceinline__ void operator()(const f32x4 (&acc)[2][2][4][2], const Unit& u, int wr, int wc, int fr, int fq) const {
        const int row0 = u.pm * BM + wr * 64 + fr, col0 = u.pn * BM + wc * 32 + 8 * fq;
        const float sc = (u.pn == 0) ? s0 : 1.f;
#pragma unroll
        for (int ai = 0; ai < 2; ++ai)
#pragma unroll
            for (int m = 0; m < 4; ++m) { bf16_t* rowp = O + (size_t)(row0 + ai * HALF + m * 16) * ldc + col0;
#pragma unroll
                for (int bj = 0; bj < 2; ++bj) { const f32x4 v0 = acc[ai][bj][m][0] * sc, v1 = acc[ai][bj][m][1] * sc;
                    u32x4 w; w.x = cvt_pk_bf16(v0[0], v0[1]); w.y = cvt_pk_bf16(v0[2], v0[3]); w.z = cvt_pk_bf16(v1[0], v1[1]); w.w = cvt_pk_bf16(v1[2], v1[3]);
                    *(u32x4*)(rowp + bj * HALF) = w; } }
    }
};
struct EpiRes {
    static constexpr bool PERM = false, AFTER_DRAIN = false;
    const float* base; float* out; const float* gate;
    __device__ __forceinline__ void operator()(const f32x4 (&acc)[2][2][4][2], const Unit& u, int wr, int wc, int fr, int fq) const {
        const float* gp = gate + (size_t)(u.pm >> 4) * 6144;
        const int col0 = u.pn * BM + wc * 32 + 4 * fq;
        f32x4 gv[2][2];
#pragma unroll
        for (int bj = 0; bj < 2; ++bj)
#pragma unroll
            for (int n = 0; n < 2; ++n) gv[bj][n] = *(const f32x4*)(gp + col0 + bj * HALF + n * 16);
#pragma unroll
        for (int ai = 0; ai < 2; ++ai)
#pragma unroll
            for (int m = 0; m < 4; ++m) { const size_t off = (size_t)(u.pm * BM + ai * HALF + wr * 64 + m * 16 + fr) * 1024 + col0;
#pragma unroll
                for (int bj = 0; bj < 2; ++bj)
#pragma unroll
                    for (int n = 0; n < 2; ++n) { const f32x4 bs = *(const f32x4*)(base + off + bj * HALF + n * 16);
                        *(f32x4*)(out + off + bj * HALF + n * 16) = bs + gv[bj][n] * acc[ai][bj][m][n]; } }
    }
};
struct EpiSwiGLU {
    static constexpr bool PERM = true, AFTER_DRAIN = false;
    bf16_t* O; int ldc;
    __device__ __forceinline__ void operator()(const f32x4 (&acc)[2][2][4][2], const Unit& u, int wr, int wc, int fr, int fq) const {
        const int row0 = u.pm * BM + wr * 64 + fr, col0 = u.pn * HALF + wc * 32 + 8 * fq;
#pragma unroll
        for (int ai = 0; ai < 2; ++ai)
#pragma unroll
            for (int m = 0; m < 4; ++m) { bf16_t* rowp = O + (size_t)(row0 + ai * HALF + m * 16) * ldc + col0;
                const f32x4 a0 = acc[ai][0][m][0], a1 = acc[ai][0][m][1], b0 = acc[ai][1][m][0], b1 = acc[ai][1][m][1];
                u32x4 w; w.x = cvt_pk_bf16(silu_f(a0[0]) * b0[0], silu_f(a0[1]) * b0[1]); w.y = cvt_pk_bf16(silu_f(a0[2]) * b0[2], silu_f(a0[3]) * b0[3]);
                w.z = cvt_pk_bf16(silu_f(a1[0]) * b1[0], silu_f(a1[1]) * b1[1]); w.w = cvt_pk_bf16(silu_f(a1[2]) * b1[2], silu_f(a1[3]) * b1[3]);
                *(u32x4*)rowp = w; }
    }
};
template <class Epi, class Sched, bool ALIGN_EPI = false, bool SP2 = false>
__device__ __forceinline__ void gemm_phase(PG8_LAS unsigned char* lds, const Gemm g, const Sched& S, const Epi& E) {
    int tid_ = threadIdx.x; asm volatile("" : "+v"(tid_));
    const int tid = tid_, wid = __builtin_amdgcn_readfirstlane(tid >> 6), lane = tid & 63, wr = wid >> 2, wc = wid & 3, fr = lane & 15, fq = lane >> 4;
    const int K = g.K, nt = K / BK;
    unsigned voffA[2], voffB[2];
#pragma unroll
    for (int i = 0; i < 2; ++i) { int R, C; stage_rc(tid * 16 + i * 8192, R, C); const int Rb = Epi::PERM ? ((R & ~31) + perm32(R & 31)) : R;
        voffA[i] = (unsigned)(R * K + C) * 2u; voffB[i] = (unsigned)(Rb * K + C) * 2u; }
    const size_t kstep = (size_t)(BK * 2);
    const size_t hstep = (size_t)HALF * K * 2;
    const size_t tstep = 2 * hstep;
    const unsigned ldsw = (unsigned)wid * 1024u;
    const int aoff = lds_byte(wr * 64 + fr, fq * 8), boff = lds_byte(wc * 32 + fr, fq * 8);
#define PG8_SA(b, h) (((b) * 2 + (h)) * HTB)
#define PG8_SB(b, h) ((4 + (b) * 2 + (h)) * HTB)
#define PG8_STAGE(bufoff, gbase, voff) do { _Pragma("unroll") for (int _i = 0; _i < 2; ++_i) \
        __builtin_amdgcn_global_load_lds((const unsigned*)((const char*)(gbase) + (voff)[_i]), (PG8_LAS unsigned*)(lds + (bufoff) + ldsw + _i * 8192), 16, 0, 0); } while (0)
#define PG8_LDA(dst, b, h) do { _Pragma("unroll") for (int m = 0; m < 4; ++m) _Pragma("unroll") for (int k = 0; k < 2; ++k) dst[m][k] = *(const PG8_LAS bf16x8*)(lds + PG8_SA(b, h) + aoff + m * 2048 + k * 1024); } while (0)
#define PG8_LDB(dst, b, h) do { _Pragma("unroll") for (int n = 0; n < 2; ++n) _Pragma("unroll") for (int k = 0; k < 2; ++k) dst[n][k] = *(const PG8_LAS bf16x8*)(lds + PG8_SB(b, h) + boff + n * 2048 + k * 1024); } while (0)
#define PG8_MMA(ai, bj, At, Bt) do { __builtin_amdgcn_s_setprio(1); _Pragma("unroll") for (int m = 0; m < 4; ++m) _Pragma("unroll") for (int n = 0; n < 2; ++n) _Pragma("unroll") for (int k = 0; k < 2; ++k) \
        acc[ai][bj][m][n] = __builtin_amdgcn_mfma_f32_16x16x32_bf16(Bt[n][k], At[m][k], acc[ai][bj][m][n], 0, 0, 0); __builtin_amdgcn_s_setprio(0); } while (0)
#define PG8_WAIT_V(n) asm volatile("s_waitcnt vmcnt(" #n ")" ::: "memory")
#define PG8_WAIT_L(n) asm volatile("s_waitcnt lgkmcnt(" #n ")" ::: "memory")
#define PG8_BAR __builtin_amdgcn_s_barrier()
#define PG8_SCHED __builtin_amdgcn_sched_barrier(0)
    Unit cur, nxt; int ui = 0;
    if (!S.next(0, cur)) return;
    f32x4 acc[2][2][4][2];
#pragma unroll
    for (int a = 0; a < 2; ++a)
#pragma unroll
        for (int b = 0; b < 2; ++b)
#pragma unroll
            for (int m = 0; m < 4; ++m)
#pragma unroll
                for (int n = 0; n < 2; ++n) acc[a][b][m][n] = (f32x4){0.f, 0.f, 0.f, 0.f};
    bf16x8 At[4][2], B0[2][2], B1[2][2];
    const char* cA = (const char*)g.A + (size_t)cur.pm * tstep; const char* cB = (const char*)g.Bt + (size_t)cur.pn * tstep;
    S.a_ready(cur);
    if constexpr (SP2) {
        PG8_STAGE(PG8_SB(0, 0), cB, voffB); PG8_STAGE(PG8_SB(0, 1), cB + hstep, voffB); PG8_STAGE(PG8_SA(0, 0), cA, voffA); PG8_STAGE(PG8_SA(0, 1), cA + hstep, voffA);
        if (wr == 1) PG8_BAR;
        PG8_WAIT_V(2); PG8_BAR;
        PG8_STAGE(PG8_SB(1, 0), cB + kstep, voffB); PG8_STAGE(PG8_SA(1, 0), cA + kstep, voffA); PG8_STAGE(PG8_SB(1, 1), cB + hstep + kstep, voffB);
        PG8_WAIT_V(6); PG8_BAR;
    } else {
        PG8_STAGE(PG8_SB(0, 0), cB, voffB); PG8_STAGE(PG8_SA(0, 0), cA, voffA); PG8_STAGE(PG8_SB(0, 1), cB + hstep, voffB); PG8_STAGE(PG8_SA(0, 1), cA + hstep, voffA);
        if (wr == 1) PG8_BAR;
        PG8_WAIT_V(4); PG8_BAR;
        PG8_STAGE(PG8_SB(1, 0), cB + kstep, voffB); PG8_STAGE(PG8_SA(1, 0), cA + kstep, voffA); PG8_STAGE(PG8_SB(1, 1), cB + hstep + kstep, voffB);
        PG8_WAIT_V(6); PG8_BAR;
    }
    for (;;) {
        const bool has_next = S.next(ui + 1, nxt);
        const char* nA = has_next ? (const char*)g.A + (size_t)nxt.pm * tstep : cA; const char* nB = has_next ? (const char*)g.Bt + (size_t)nxt.pn * tstep : cB;
        for (int t = 0; t < nt; t += 2) {
            const bool last = (t == nt - 2);
            const char* a1 = cA + (size_t)(t + 1) * kstep;
            const char* a2 = last ? nA : cA + (size_t)(t + 2) * kstep; const char* b2 = last ? nB : cB + (size_t)(t + 2) * kstep;
            const char* a3 = a2 + kstep; const char* b3 = b2 + kstep;
            if (last && has_next) S.a_ready(nxt);
            if constexpr (SP2) {
            PG8_LDB(B0, 0, 0); PG8_LDB(B1, 0, 1); PG8_SCHED; PG8_LDA(At, 0, 0); PG8_STAGE(PG8_SA(1, 1), a1 + hstep, voffA);
            PG8_WAIT_V(8); PG8_WAIT_L(0); PG8_BAR; PG8_MMA(0, 0, At, B0); PG8_MMA(0, 1, At, B1); PG8_BAR; PG8_SCHED;
            PG8_LDA(At, 0, 1); PG8_STAGE(PG8_SB(0, 0), b2, voffB); PG8_STAGE(PG8_SB(0, 1), b2 + hstep, voffB); PG8_STAGE(PG8_SA(0, 0), a2, voffA);
            PG8_WAIT_V(8); PG8_WAIT_L(0); PG8_BAR; PG8_MMA(1, 0, At, B0); PG8_MMA(1, 1, At, B1); PG8_BAR; PG8_SCHED;
            PG8_LDB(B0, 1, 0); PG8_LDB(B1, 1, 1); PG8_SCHED; PG8_LDA(At, 1, 0); PG8_STAGE(PG8_SA(0, 1), a2 + hstep, voffA);
            PG8_WAIT_V(8); PG8_WAIT_L(0); PG8_BAR; PG8_MMA(0, 0, At, B0); PG8_MMA(0, 1, At, B1); PG8_BAR; PG8_SCHED;
            PG8_LDA(At, 1, 1); PG8_STAGE(PG8_SB(1, 0), b3, voffB); PG8_STAGE(PG8_SB(1, 1), b3 + hstep, voffB); PG8_STAGE(PG8_SA(1, 0), a3, voffA);
            PG8_WAIT_V(8); PG8_WAIT_L(0); PG8_BAR; PG8_MMA(1, 0, At, B0); PG8_MMA(1, 1, At, B1); PG8_BAR; PG8_SCHED;
            } else {
            PG8_LDB(B0, 0, 0); PG8_SCHED; PG8_LDA(At, 0, 0); PG8_STAGE(PG8_SA(1, 1), a1 + hstep, voffA);
            PG8_WAIT_L(8); PG8_BAR; PG8_WAIT_L(0); PG8_MMA(0, 0, At, B0); PG8_BAR; PG8_SCHED;
            PG8_LDB(B1, 0, 1); PG8_STAGE(PG8_SB(0, 0), b2, voffB);
            PG8_BAR; PG8_WAIT_L(0); PG8_MMA(0, 1, At, B1); PG8_BAR;
            PG8_LDA(At, 0, 1); PG8_STAGE(PG8_SA(0, 0), a2, voffA);
            PG8_BAR; PG8_WAIT_L(0); PG8_MMA(1, 0, At, B0); PG8_BAR; PG8_SCHED;
            PG8_STAGE(PG8_SB(0, 1), b2 + hstep, voffB);
            PG8_WAIT_V(6); PG8_BAR; PG8_MMA(1, 1, At, B1); PG8_BAR;
            PG8_LDB(B0, 1, 0); PG8_SCHED; PG8_LDA(At, 1, 0); PG8_STAGE(PG8_SA(0, 1), a2 + hstep, voffA);
            PG8_WAIT_L(8); PG8_BAR; PG8_WAIT_L(0); PG8_MMA(0, 0, At, B0); PG8_BAR; PG8_SCHED;
            PG8_LDB(B1, 1, 1); PG8_STAGE(PG8_SB(1, 0), b3, voffB);
            PG8_BAR; PG8_WAIT_L(0); PG8_MMA(0, 1, At, B1); PG8_BAR;
            PG8_LDA(At, 1, 1); PG8_STAGE(PG8_SA(1, 0), a3, voffA);
            PG8_BAR; PG8_WAIT_L(0); PG8_MMA(1, 0, At, B0); PG8_BAR; PG8_SCHED;
            PG8_STAGE(PG8_SB(1, 1), b3 + hstep, voffB);
            PG8_WAIT_V(6); PG8_BAR; PG8_MMA(1, 1, At, B1); PG8_BAR;
            }
        }
        if constexpr (ALIGN_EPI) { if (wr == 0) PG8_BAR; }
        if constexpr (!Epi::AFTER_DRAIN) { E(acc, cur, wr, wc, fr, fq); S.done(cur); }
        if (!has_next) break;
#pragma unroll
        for (int a = 0; a < 2; ++a)
#pragma unroll
            for (int b = 0; b < 2; ++b)
#pragma unroll
                for (int m = 0; m < 4; ++m)
#pragma unroll
                    for (int n = 0; n < 2; ++n) acc[a][b][m][n] = (f32x4){0.f, 0.f, 0.f, 0.f};
        cur = nxt; cA = nA; cB = nB; ++ui;
        if constexpr (ALIGN_EPI) { if (wr == 1) PG8_BAR; }
    }
    PG8_WAIT_V(0);
    if constexpr (!ALIGN_EPI) { if (wr == 0) PG8_BAR; }
    PG8_BAR;
    if constexpr (Epi::AFTER_DRAIN) { E.fused(acc, cur, wr, wc, fr, fq, lds, wid, lane); S.done(cur); }
#undef PG8_SA
#undef PG8_SB
#undef PG8_STAGE
#undef PG8_LDA
#undef PG8_LDB
#undef PG8_MMA
#undef PG8_WAIT_V
#undef PG8_WAIT_L
#undef PG8_BAR
#undef PG8_SCHED
}
}
#include <hip/hip_bf16.h>
#include <cmath>
namespace attn_body {
using bf16=__hip_bfloat16;
using bf16x8=__attribute__((ext_vector_type(8)))short;
using s16x4=__attribute__((ext_vector_type(4)))short;
using f32x16=__attribute__((ext_vector_type(16)))float;
using u32x4=__attribute__((ext_vector_type(4)))unsigned;
constexpr int BATCH=8,NHEAD=4,SEQ=4096,D=64,DM=2560,DMO=1024;
constexpr int NW=8,QBLK=32,QB=QBLK*NW,KVBLK=64,NQB=SEQ/QB;
constexpr int ATTN_PITCH=DM, ATTN_UNIT_ROWS=QB;
__device__ __forceinline__ int crow(int r,int hi){return (r&3)+8*(r>>2)+4*hi;}
#define SBAR() __builtin_amdgcn_sched_barrier(0)
__device__ __forceinline__ void cmask(f32x16&p0,f32x16&p1,int jb,int qrel,int hi){
  const float NEG=-INFINITY; int kb=64*jb+4*hi;
  #pragma unroll
  for(int r=0;r<16;++r){int kv=kb+(r&3)+8*(r>>2); if(kv>qrel)p0[r]=NEG; if(kv+32>qrel)p1[r]=NEG;}
}

constexpr int NSLOT=3, SLOTB=8192;
constexpr int LDS_K=0, LDS_V=NSLOT*SLOTB, LDS_WS=2*NSLOT*SLOTB, LDS_OST=LDS_WS+NW*64*4, LDS_CUM=LDS_OST+NW*4096, LDS_BYTES=LDS_CUM+SEQ*4;
constexpr float C2=0.125f*1.4426950408889634f;
__device__ __forceinline__ void glds16(const void*gsrc,unsigned lds_dst){unsigned keep;
  asm volatile("s_mov_b32 %0, m0\n\ts_mov_b32 m0, %2\n\ts_nop 0\n\tglobal_load_lds_dwordx4 %1, off\n\ts_mov_b32 m0, %0":"=&s"(keep):"v"(gsrc),"s"(lds_dst):"memory");}
__device__ __forceinline__ float max3f(float a,float b,float c){float r;asm("v_max3_f32 %0, %1, %2, %3":"=v"(r):"v"(a),"v"(b),"v"(c));return r;}
__device__ __forceinline__ float max2f(float a,float b){float r;asm("v_max_f32_e32 %0, %1, %2":"=v"(r):"v"(a),"v"(b));return r;}
__device__ __forceinline__ float fadd_s(float a,float b){float r;asm("v_add_f32_e32 %0, %1, %2":"=v"(r):"v"(a),"v"(b));return r;}
__device__ __forceinline__ float fsub_s(float a,float b){float r;asm("v_sub_f32_e32 %0, %1, %2":"=v"(r):"v"(a),"v"(b));return r;}
typedef float f32x2_t __attribute__((ext_vector_type(2))); typedef __bf16 bf16x2_t __attribute__((ext_vector_type(2)));
__device__ __forceinline__ unsigned cvtpk_s(float lo,float hi){f32x2_t v={lo,hi};bf16x2_t b=__builtin_convertvector(v,bf16x2_t);return __builtin_bit_cast(unsigned,b);}
#define WAIT_BAR(N) asm volatile("s_waitcnt vmcnt(" #N ") lgkmcnt(0)\n\ts_barrier":::"memory")

__device__ __forceinline__ void qkt(f32x16&p0,f32x16&p1,const char*Kslot,const bf16x8*qr,const f32x16&negm,int r32,int hi){
  const char*kb=Kslot+hi*1024+r32*16;
  #pragma unroll
  for(int d0=0;d0<4;++d0){
    const bf16x8 b0=*reinterpret_cast<const bf16x8*>(kb+d0*2048);
    const bf16x8 b1=*reinterpret_cast<const bf16x8*>(kb+d0*2048+512);
    if(d0==0){p0=__builtin_amdgcn_mfma_f32_32x32x16_bf16(b0,qr[0],negm,0,0,0);p1=__builtin_amdgcn_mfma_f32_32x32x16_bf16(b1,qr[0],negm,0,0,0);}
    else{p0=__builtin_amdgcn_mfma_f32_32x32x16_bf16(b0,qr[d0],p0,0,0,0);p1=__builtin_amdgcn_mfma_f32_32x32x16_bf16(b1,qr[d0],p1,0,0,0);}}
}
typedef __attribute__((address_space(3))) const char* lds_cptr;
typedef short v4i16_t __attribute__((ext_vector_type(4)));
__device__ __forceinline__ void kload8(bf16x8*kf,lds_cptr kp){
  kf[0]=*(const __attribute__((address_space(3))) bf16x8*)(kp);      kf[1]=*(const __attribute__((address_space(3))) bf16x8*)(kp+512);
  kf[2]=*(const __attribute__((address_space(3))) bf16x8*)(kp+2048); kf[3]=*(const __attribute__((address_space(3))) bf16x8*)(kp+2560);
  kf[4]=*(const __attribute__((address_space(3))) bf16x8*)(kp+4096); kf[5]=*(const __attribute__((address_space(3))) bf16x8*)(kp+4608);
  kf[6]=*(const __attribute__((address_space(3))) bf16x8*)(kp+6144); kf[7]=*(const __attribute__((address_space(3))) bf16x8*)(kp+6656);
}
__device__ __forceinline__ void kload2(bf16x8*kf,lds_cptr kp,int j){ kf[2*j]=*(const __attribute__((address_space(3))) bf16x8*)(kp+j*2048); kf[2*j+1]=*(const __attribute__((address_space(3))) bf16x8*)(kp+j*2048+512); }
__device__ __forceinline__ s16x4 vtr(lds_cptr p){ return __builtin_bit_cast(s16x4,__builtin_amdgcn_ds_read_tr16_b64_v4i16((__attribute__((address_space(3))) v4i16_t*)p)); }
__device__ __forceinline__ float rowmax(const f32x16&p0,const f32x16&p1){
  float a=max3f(p0[0],p0[1],p1[0]),b=max3f(p0[2],p0[3],p1[1]);a=max3f(a,p1[2],p1[3]);
  #pragma unroll
  for(int r=4;r<16;r+=4){a=max3f(a,p0[r],p0[r+1]);b=max3f(b,p0[r+2],p0[r+3]);a=max3f(a,p1[r],p1[r+1]);b=max3f(b,p1[r+2],p1[r+3]);}
  const float m=max2f(a,b);
  auto rr=__builtin_amdgcn_permlane32_swap(__float_as_uint(m),__float_as_uint(m),false,false);
  return max2f(__uint_as_float(rr[0]),__uint_as_float(rr[1]));
}
__device__ __forceinline__ void pv(f32x16*o,int vb,bf16x8 pa0,bf16x8 pa1,bf16x8 pa2,bf16x8 pa3){
  #pragma unroll
  for(int d0=0;d0<2;++d0){s16x4 lo[4],hi[4];
    #pragma unroll
    for(int ks=0;ks<4;++ks){
      asm volatile("ds_read_b64_tr_b16 %0,%1 offset:%c2":"=&v"(lo[ks]):"v"(vb),"i"(d0*4096+ks*1024):"memory");
      asm volatile("ds_read_b64_tr_b16 %0,%1 offset:%c2":"=&v"(hi[ks]):"v"(vb),"i"(d0*4096+ks*1024+512):"memory");}
    asm volatile("s_waitcnt lgkmcnt(0)":::"memory");SBAR();
    #define PK(k) (bf16x8){lo[k][0],lo[k][1],lo[k][2],lo[k][3],hi[k][0],hi[k][1],hi[k][2],hi[k][3]}
    o[d0]=__builtin_amdgcn_mfma_f32_32x32x16_bf16(pa0,PK(0),o[d0],0,0,0);
    o[d0]=__builtin_amdgcn_mfma_f32_32x32x16_bf16(pa1,PK(1),o[d0],0,0,0);
    o[d0]=__builtin_amdgcn_mfma_f32_32x32x16_bf16(pa2,PK(2),o[d0],0,0,0);
    o[d0]=__builtin_amdgcn_mfma_f32_32x32x16_bf16(pa3,PK(3),o[d0],0,0,0);
    #undef PK
  }
}

#ifndef ATTN_STORE16
#define ATTN_STORE16(p,v) (*(u32x4*)(p)=(v))
#endif
template<int THRL> __device__ __forceinline__ void attn_unit(int b,int h,int qb,const bf16*Q,const bf16*__restrict__ K,const bf16*__restrict__ V,bf16*O,const float*__restrict__ cumg,char*shm){
  int tid_=threadIdx.x; asm volatile("":"+v"(tid_)); const int tid=tid_,lane=tid&63,r32=lane&31,hi=lane>>5; const int wid=__builtin_amdgcn_readfirstlane(tid>>6);
  const long rowbase=(long)b*SEQ; const int q0=qb*QB;
  typedef float f32x4_t __attribute__((ext_vector_type(4)));
  { __attribute__((address_space(3))) f32x4_t* cl=(__attribute__((address_space(3))) f32x4_t*)((__attribute__((address_space(3))) char*)shm+LDS_CUM);
    const f32x4_t* cgp=(const f32x4_t*)cumg; for(int i=tid;i<(q0+QB)/4;i+=NW*64)cl[i]=cgp[i]; }
  const float cqL=cumg[q0+wid*QBLK+r32];
  const __attribute__((address_space(3))) f32x4_t* cumq=(const __attribute__((address_space(3))) f32x4_t*)((__attribute__((address_space(3))) char*)shm+LDS_CUM)+hi;
  #define KBIAS(P0,P1,t) do{ const __attribute__((address_space(3))) f32x4_t* cb_=cumq+16*(t); _Pragma("unroll") for(int g_=0;g_<4;++g_){ const f32x4_t a_=cb_[2*g_], b_=cb_[8+2*g_]; \
      P0[4*g_]+=cqm-a_[0];P0[4*g_+1]+=cqm-a_[1];P0[4*g_+2]+=cqm-a_[2];P0[4*g_+3]+=cqm-a_[3]; P1[4*g_]+=cqm-b_[0];P1[4*g_+1]+=cqm-b_[1];P1[4*g_+2]+=cqm-b_[2];P1[4*g_+3]+=cqm-b_[3]; } }while(0)
  const bf16*Qw=Q+(rowbase+q0+wid*QBLK)*DM+h*D;
  const bf16*Kh=K+rowbase*DM+h*D,*Vh=V+rowbase*DM+h*D;
  const unsigned lds0=(unsigned)(uintptr_t)shm;
  float*wsf=(float*)(shm+LDS_WS)+wid*64;
  const bf16*ksrc=Kh+(long)lane*DM+wid*8;
  const bf16*vsrc=Vh+(long)(16*(wid&3)+(lane>>2))*DM+(wid>>2)*32+(lane&3)*8;
  const unsigned kdst=lds0+LDS_K+wid*1024, vdst=lds0+LDS_V+wid*1024;
  #define DMA_K(t,slot) glds16(ksrc+(long)(t)*KVBLK*DM,(unsigned)__builtin_amdgcn_readfirstlane(kdst+(slot)))
  #define DMA_V(t,slot) glds16(vsrc+(long)(t)*KVBLK*DM,(unsigned)__builtin_amdgcn_readfirstlane(vdst+(slot)))
  const int vb0=(int)(lds0+LDS_V)+((lane>>4)&1)*32+(lane&3)*8+(4*hi+((lane&15)>>2))*64;
  const char*Kbase=shm+LDS_K; bf16x8 kf[8];
  const lds_cptr shm3=(lds_cptr)shm; const lds_cptr kp0=shm3+LDS_K+hi*1024+r32*16; const lds_cptr vp0=shm3+LDS_V+((lane>>4)&1)*32+(lane&3)*8+(4*hi+((lane&15)>>2))*64;
  const int NT=(q0+QB)/KVBLK;
  DMA_K(0,0);DMA_V(0,0);DMA_K(1,SLOTB);
  bf16x8 qr[4];
  #pragma unroll
  for(int d0=0;d0<4;++d0)qr[d0]=*reinterpret_cast<const bf16x8*>(&Qw[(long)r32*DM+d0*16+hi*8]);
  float mhat=0.f,l_reg=0.f;f32x16 o[2];o[0]=f32x16{};o[1]=f32x16{};float cqm=cqL; const f32x16 negm=f32x16{};
  const int qrel=wid*QBLK+r32;
  #define CMASK(P0,P1,t) do{int jb_=(t)-(NT-4); if(jb_>=0)cmask(P0,P1,jb_,qrel,hi);}while(0)
  bool resc=false;
  #define START(P0,P1) do{ const float rm=rowmax(P0,P1); resc=false; \
    { const float dl=rm; mhat=fadd_s(mhat,dl); \
      _Pragma("unroll") for(int r=0;r<16;++r){P0[r]=fsub_s(P0[r],dl);P1[r]=fsub_s(P1[r],dl);} \
      cqm=cqL-mhat; } \
    _Pragma("unroll") for(int r=0;r<16;++r)P0[r]=__builtin_amdgcn_exp2f(P0[r]); }while(0)
  #define RESC() do{ if(resc){ asm volatile("s_waitcnt lgkmcnt(0)":::"memory"); \
      _Pragma("unroll") for(int d_=0;d_<2;++d_) _Pragma("unroll") for(int r=0;r<16;++r)o[d_][r]*=wsf[crow(r,hi)]; } }while(0)
  f32x16 pA0,pA1,pB0,pB1;
  int sl_prev=0,sl_cur=0,sl_next=SLOTB;
  #define ROT() do{sl_prev=sl_cur;sl_cur=sl_next;sl_next=(sl_next==(NSLOT-1)*SLOTB)?0:sl_next+SLOTB;}while(0)
  DMA_K(2,2*SLOTB);
  WAIT_BAR(3);
  qkt(pA0,pA1,Kbase,qr,negm,r32,hi);asm volatile("s_nop 15\n\ts_nop 7":"+v"(pA0),"+v"(pA1));KBIAS(pA0,pA1,0);CMASK(pA0,pA1,0);
  START(pA0,pA1);
  _Pragma("unroll") for(int r=0;r<16;++r)pA1[r]=__builtin_amdgcn_exp2f(pA1[r]);
  WAIT_BAR(0);
  DMA_K(3,0);DMA_V(1,SLOTB);
  ROT();
  kload8(kf,kp0+sl_cur);
  WAIT_BAR(2);
  s16x4 vlo[8],vhi[8]; u32x4 pw0,pw1,pw2,pw3;
  #define PKW(P,B) cvtpk_s(P[B],P[B+1])
  #define PAF(k) __builtin_bit_cast(bf16x8,pw##k)
  #define VFR(i) (bf16x8){vlo[i][0],vlo[i][1],vlo[i][2],vlo[i][3],vhi[i][0],vhi[i][1],vhi[i][2],vhi[i][3]}
  #define PIN(x) asm volatile("":"+v"(x))
  #define MX3(a,b,c) __builtin_fmaxf(__builtin_fmaxf((a),(b)),(c))
  #define GAPA(MF,A0,A1,A2,A3,W0,W1,PW) do{ MF; sacc+=A0; sacc+=A1; sacc+=A2; sacc+=A3; PIN(sacc); W0; W1; PIN(PW); SBAR(); }while(0)
  #define EX(v) __builtin_amdgcn_exp2f(v)
  #define GAPB(MF,X,B) do{ MF; X[B]=EX(X[B]); X[B+1]=EX(X[B+1]); X[B+2]=EX(X[B+2]); X[B+3]=EX(X[B+3]); PIN(X); SBAR(); }while(0)
  #define VRD(i) do{ vlo[i]=vtr(vp_+(((i)>>2)*4096+((i)&3)*1024)); vhi[i]=vtr(vp_+(((i)>>2)*4096+((i)&3)*1024+512)); }while(0)
  #define KRD(G,j) do{ if(G){ kload2(kf,kp0+sl_next,j); SBAR(); } }while(0)
  #define STEP(C0,C1,P0,P1,t,GK,GV,GL) do{ SBAR(); \
    const lds_cptr vp_=vp0+sl_prev; \
    VRD(0); SBAR(); float sacc=(P0[0]+P0[1]); \
    GAPA(C0=__builtin_amdgcn_mfma_f32_32x32x16_bf16(kf[0],qr[0],negm,0,0,0), P0[2],P0[3],P0[4],P0[5],     pw0[0]=PKW(P0,0), pw0[1]=PKW(P0,2), pw0); \
    VRD(4); SBAR(); GAPA(C1=__builtin_amdgcn_mfma_f32_32x32x16_bf16(kf[1],qr[0],negm,0,0,0), P0[6],P0[7],P0[8],P0[9],     pw0[2]=PKW(P0,4), pw0[3]=PKW(P0,6), pw0); \
    VRD(1); SBAR(); GAPA(C0=__builtin_amdgcn_mfma_f32_32x32x16_bf16(kf[2],qr[1],C0,0,0,0),   P0[10],P0[11],P0[12],P0[13], pw1[0]=PKW(P0,8), pw1[1]=PKW(P0,10), pw1); \
    VRD(5); SBAR(); GAPA(C1=__builtin_amdgcn_mfma_f32_32x32x16_bf16(kf[3],qr[1],C1,0,0,0),   P0[14],P0[15],P1[0],P1[1],   pw1[2]=PKW(P0,12),pw1[3]=PKW(P0,14), pw1); \
    VRD(2); SBAR(); GAPA(C0=__builtin_amdgcn_mfma_f32_32x32x16_bf16(kf[4],qr[2],C0,0,0,0),   P1[2],P1[3],P1[4],P1[5],     pw2[0]=PKW(P1,0), pw2[1]=PKW(P1,2), pw2); \
    VRD(6); SBAR(); GAPA(C1=__builtin_amdgcn_mfma_f32_32x32x16_bf16(kf[5],qr[2],C1,0,0,0),   P1[6],P1[7],P1[8],P1[9],     pw2[2]=PKW(P1,4), pw2[3]=PKW(P1,6), pw2); \
    VRD(3); SBAR(); GAPA(C0=__builtin_amdgcn_mfma_f32_32x32x16_bf16(kf[6],qr[3],C0,0,0,0),   P1[10],P1[11],P1[12],P1[13], pw3[0]=PKW(P1,8), pw3[1]=PKW(P1,10), pw3); \
    VRD(7); SBAR(); GAPA(C1=__builtin_amdgcn_mfma_f32_32x32x16_bf16(kf[7],qr[3],C1,0,0,0),   P1[14],P1[15],0.f,0.f,       pw3[2]=PKW(P1,12),pw3[3]=PKW(P1,14), pw3); \
    l_reg+=sacc; \
    if(GK){DMA_K((t)+3,sl_cur);} if(GV){DMA_V((t)+1,sl_next);} \
    KBIAS(C0,C1,t); CMASK(C0,C1,t); \
    { float a=MX3(C0[0],C0[1],C1[0]),b=MX3(C0[2],C0[3],C1[1]); a=MX3(a,C1[2],C1[3]); \
      _Pragma("unroll") for(int r=4;r<16;r+=4){a=MX3(a,C0[r],C0[r+1]);b=MX3(b,C0[r+2],C0[r+3]);a=MX3(a,C1[r],C1[r+1]);b=MX3(b,C1[r+2],C1[r+3]);} \
      float rm=__builtin_fmaxf(a,b); { auto rr=__builtin_amdgcn_permlane32_swap(__float_as_uint(rm),__float_as_uint(rm),false,false); rm=__builtin_fmaxf(__uint_as_float(rr[0]),__uint_as_float(rr[1])); } \
      resc=false; \
      if(__builtin_expect(__any(rm>(float)THRL),0)){ const float dl=__builtin_fmaxf(rm,0.f); mhat+=dl; \
        _Pragma("unroll") for(int r=0;r<16;++r){C0[r]-=dl;C1[r]-=dl;} \
        cqm=cqL-mhat; \
        const float f=__builtin_amdgcn_exp2f(-dl); l_reg*=f; if(hi==0)wsf[r32]=f; resc=true; } } \
    SBAR(); \
    GAPB(o[0]=__builtin_amdgcn_mfma_f32_32x32x16_bf16(PAF(0),VFR(0),o[0],0,0,0), C0,0); \
    GAPB(o[1]=__builtin_amdgcn_mfma_f32_32x32x16_bf16(PAF(0),VFR(4),o[1],0,0,0), C0,4); \
    KRD(GL,0); GAPB(o[0]=__builtin_amdgcn_mfma_f32_32x32x16_bf16(PAF(1),VFR(1),o[0],0,0,0), C0,8); \
    KRD(GL,1); GAPB(o[1]=__builtin_amdgcn_mfma_f32_32x32x16_bf16(PAF(1),VFR(5),o[1],0,0,0), C0,12); \
    KRD(GL,2); GAPB(o[0]=__builtin_amdgcn_mfma_f32_32x32x16_bf16(PAF(2),VFR(2),o[0],0,0,0), C1,0); \
    KRD(GL,3); GAPB(o[1]=__builtin_amdgcn_mfma_f32_32x32x16_bf16(PAF(2),VFR(6),o[1],0,0,0), C1,4); \
    GAPB(o[0]=__builtin_amdgcn_mfma_f32_32x32x16_bf16(PAF(3),VFR(3),o[0],0,0,0), C1,8); \
    GAPB(o[1]=__builtin_amdgcn_mfma_f32_32x32x16_bf16(PAF(3),VFR(7),o[1],0,0,0), C1,12); \
    }while(0)
  int t=1;
  #undef CMASK
  #define CMASK(P0,P1,t) do{}while(0)
  for(;t+5<NT;t+=2){
    STEP(pB0,pB1,pA0,pA1,t,true,true,true);     WAIT_BAR(2); RESC(); ROT();
    STEP(pA0,pA1,pB0,pB1,t+1,true,true,true);   WAIT_BAR(2); RESC(); ROT();
  }
  #undef CMASK
  #define CMASK(P0,P1,t) do{int jb_=(t)-(NT-4); if(jb_>=0)cmask(P0,P1,jb_,qrel,hi);}while(0)
  #define ENDW(tt) do{ if((tt)+3<NT){WAIT_BAR(2);} else if((tt)+2<NT){WAIT_BAR(1);} else {WAIT_BAR(0);} }while(0)
  for(;t+1<NT;t+=2){
    STEP(pB0,pB1,pA0,pA1,t,(t+3<NT),(t+1<NT),(t+1<NT));       ENDW(t);   RESC(); ROT();
    STEP(pA0,pA1,pB0,pB1,t+1,(t+4<NT),(t+2<NT),(t+2<NT));     ENDW(t+1); RESC(); ROT();
  }
  STEP(pB0,pB1,pA0,pA1,NT-1,false,false,false); RESC();
  { float sacc=pB0[0]+pB0[1]; _Pragma("unroll") for(int r=2;r<16;++r)sacc+=pB0[r]; _Pragma("unroll") for(int r=0;r<16;++r)sacc+=pB1[r]; l_reg+=sacc;
    pw0=(u32x4){PKW(pB0,0),PKW(pB0,2),PKW(pB0,4),PKW(pB0,6)};pw1=(u32x4){PKW(pB0,8),PKW(pB0,10),PKW(pB0,12),PKW(pB0,14)};pw2=(u32x4){PKW(pB1,0),PKW(pB1,2),PKW(pB1,4),PKW(pB1,6)};pw3=(u32x4){PKW(pB1,8),PKW(pB1,10),PKW(pB1,12),PKW(pB1,14)};
    SBAR(); pv(o,vb0+sl_cur,PAF(0),PAF(1),PAF(2),PAF(3)); }
  #undef PKW
  #undef PAF
  #undef VFR
  #undef PIN
  #undef MX3
  #undef GAPA
  #undef GAPB
  #undef EX
  #undef VRD
  #undef KRD
  #undef STEP
  #undef ENDW
  {auto rr=__builtin_amdgcn_permlane32_swap(__float_as_uint(l_reg),__float_as_uint(l_reg),false,false);l_reg=__uint_as_float(rr[0])+__uint_as_float(rr[1]);}
  if(hi==0)wsf[32+r32]=l_reg;asm volatile("s_waitcnt lgkmcnt(0)":::"memory");
  float rli[16];
  #pragma unroll
  for(int r=0;r<16;++r)rli[r]=__builtin_amdgcn_rcpf(wsf[32+crow(r,hi)]);
  bf16*Ow=O+(rowbase+q0+wid*QBLK)*DMO+h*D;
  { bf16*stg=(bf16*)(shm+LDS_OST)+wid*2048;
    #pragma unroll
    for(int r=0;r<16;++r){const int orow=crow(r,hi);
      #pragma unroll
      for(int d0=0;d0<2;++d0)stg[orow*64+d0*32+r32]=__float2bfloat16(o[d0][r]*rli[r]);}
    asm volatile("s_waitcnt lgkmcnt(0)":::"memory");
    #pragma unroll
    for(int i=0;i<4;++i){const int row=i*8+(lane>>3),ch=lane&7; const u32x4 v=*(const u32x4*)(stg+row*64+ch*8); ATTN_STORE16(Ow+(long)row*DMO+ch*8,v);} }
  asm volatile("s_waitcnt lgkmcnt(0)\n\ts_barrier":::"memory");
  #undef DMA_K
  #undef DMA_V
  #undef CMASK
  #undef START
  #undef RESC
  #undef ROT
  #undef KBIAS
}
constexpr int ATTN_LDS_BYTES=LDS_BYTES;
struct AttnTensors { const bf16* Q; const bf16* K; const bf16* V; bf16* O; const float* cum; };
struct AttnUnit { int bh; int qb; };
struct StaticOrder {
  int vcu;
  __device__ __forceinline__ explicit StaticOrder(int grid,int block):vcu((block%8)*(grid/8)+block/8){}
  __device__ __forceinline__ bool next(int i,AttnUnit&u)const{ if(i>=2)return false; const int s=vcu&7; u.bh=vcu>>3; u.qb=(i==0)?15-s:s; return true; }
  __device__ __forceinline__ void a_ready(const AttnUnit&)const{}
  __device__ __forceinline__ void done(const AttnUnit&)const{}
};
template<class Sched,int THRL=8> __device__ __forceinline__ void attn_phase(char*lds,const AttnTensors&T,const Sched&S){
  AttnUnit u;
  for(int i=0;S.next(i,u);++i){ S.a_ready(u); attn_unit<THRL>(u.bh/NHEAD,u.bh%NHEAD,u.qb,T.Q,T.K,T.V,T.O,T.cum+(long)u.bh*SEQ,lds); S.done(u); }
}
#undef SBAR
#undef WAIT_BAR
}
namespace cg = cooperative_groups;
#ifndef PH_PRO
#define PH_PRO 1
#endif
#ifndef PH_NORM
#define PH_NORM 1
#endif
#ifndef PH_GIN
#define PH_GIN 1
#endif
#ifndef PH_POOL
#define PH_POOL 1
#endif
#ifndef PH_CONV
#define PH_CONV 1
#endif
#ifndef PH_RKV
#define PH_RKV 1
#endif
#ifndef PH_ATT
#define PH_ATT 1
#endif
#ifndef PH_RET
#define PH_RET 1
#endif
#ifndef PH_GOUT
#define PH_GOUT 1
#endif
#ifndef PH_GUP
#define PH_GUP 1
#endif
#ifndef PH_GDN
#define PH_GDN 1
#endif
#ifndef REP_NORM
#define REP_NORM 1
#endif
#ifndef REP_C1
#define REP_C1 1
#endif
#ifndef REP_ATT
#define REP_ATT 1
#endif
#ifndef REP_RET
#define REP_RET 1
#endif
#define LAS __attribute__((address_space(3)))
typedef unsigned short bf16;
typedef unsigned v4u __attribute__((ext_vector_type(4)));
typedef unsigned v2u __attribute__((ext_vector_type(2)));
typedef float f32x4 __attribute__((ext_vector_type(4)));
typedef float f32x16 __attribute__((ext_vector_type(16)));
typedef short bf16x8 __attribute__((ext_vector_type(8)));

constexpr int NWAVES = 8, NTHR = 512;
constexpr int BATCH = 8, SEQ = 4096, DMODEL = 1024, MROWS = BATCH * SEQ, DEPTH = 4;
constexpr int NU = 2560, NIN = 2564, DFF = 2816, NH2 = 5632, MODW = 6144;
constexpr float EPS = 1e-6f, LOG2E = 1.4426950408889634f;
constexpr int LDS_BYTES = 147456;

constexpr size_t MiB = 1u << 20;
constexpr size_t WS_MOD = 1 * MiB, WS_CUM = 2 * MiB, WS_FF = 3 * MiB, WS_W = 4 * MiB;
constexpr size_t WOFF_IN = 0, WOFF_OUT = (size_t)NU * 1024, WOFF_13 = WOFF_OUT + 1024 * 1024, WOFF_2 = WOFF_13 + (size_t)NH2 * 1024, W_LAYER = WOFF_2 + (size_t)1024 * DFF;
constexpr size_t WS_H = 98 * MiB, WS_U = 162 * MiB, WS_MIX = 322 * MiB, WS_HID = 162 * MiB, WS_KV = 386 * MiB, WS_VT = 402 * MiB, WS_END = 418 * MiB;
static_assert(WS_W + DEPTH * W_LAYER * 2 <= WS_H, "weights fit");
static_assert(WS_HID + (size_t)MROWS * DFF * 2 <= WS_KV, "hid overlay fits");

#define LDS_WAIT() asm volatile("s_waitcnt lgkmcnt(0)" ::: "memory")
__device__ __forceinline__ unsigned f2bf(float f) { unsigned u = __builtin_bit_cast(unsigned, f); return (u + 0x7fffu + ((u >> 16) & 1u)) >> 16; }
__device__ __forceinline__ unsigned pk2(float lo, float hi) { return f2bf(lo) | (f2bf(hi) << 16); }
__device__ __forceinline__ float bf2f(unsigned b) { return __builtin_bit_cast(float, b << 16); }
__device__ __forceinline__ float bfe(const v4u& v, int e) { return bf2f((v[e >> 1] >> (16 * (e & 1))) & 0xffffu); }
__device__ __forceinline__ float bfe2(const v2u& v, int e) { return bf2f((v[e >> 1] >> (16 * (e & 1))) & 0xffffu); }
template <int CTRL> __device__ __forceinline__ float dppf(float v) { return __builtin_bit_cast(float, __builtin_amdgcn_update_dpp(0, __builtin_bit_cast(int, v), CTRL, 0xF, 0xF, false)); }
__device__ __forceinline__ float wave_sum(float v) {
    v += dppf<0xB1>(v); v += dppf<0x4E>(v); v += dppf<0x141>(v); v += dppf<0x140>(v);
    const int iv = __builtin_bit_cast(int, v);
    return (__builtin_bit_cast(float, __builtin_amdgcn_readlane(iv, 0)) + __builtin_bit_cast(float, __builtin_amdgcn_readlane(iv, 16))) +
           (__builtin_bit_cast(float, __builtin_amdgcn_readlane(iv, 32)) + __builtin_bit_cast(float, __builtin_amdgcn_readlane(iv, 48)));
}
__device__ __forceinline__ float siluf(float v) { return v * __builtin_amdgcn_rcpf(1.0f + __builtin_amdgcn_exp2f(-LOG2E * v)); }
__device__ __forceinline__ int crow(int r, int hi) { return (r & 3) + 8 * (r >> 2) + 4 * hi; }

__device__ __forceinline__ void transpose_item(const float* W, int ld, int k0, int scol0, bf16* WT, int Kd, int drow0, LAS float* scr, int lane) {
#pragma unroll 8
    for (int i = 0; i < 32; ++i) { const int kk = 2 * i + (lane >> 5); scr[kk * 33 + (lane & 31)] = W[(size_t)(k0 + kk) * ld + scol0 + (lane & 31)]; }
    LDS_WAIT(); asm volatile("" ::: "memory");
    const int c = lane & 7;
#pragma unroll
    for (int j = 0; j < 4; ++j) { const int n = (lane >> 3) + 8 * j; const LAS float* s = scr + (8 * c) * 33 + n;
        v4u o; o.x = pk2(s[0 * 33], s[1 * 33]); o.y = pk2(s[2 * 33], s[3 * 33]); o.z = pk2(s[4 * 33], s[5 * 33]); o.w = pk2(s[6 * 33], s[7 * 33]);
        *(v4u*)(WT + (size_t)(drow0 + n) * Kd + k0 + 8 * c) = o; }
    LDS_WAIT(); asm volatile("" ::: "memory");
}

template <bool FF>
__device__ __forceinline__ void norm_phase(LAS unsigned char* lds, const float* xin, const float* g, const float* msc, const float* msh, bf16* hout, const float* wfcols, float* ffout,
                                           int bx, int G, int tid, int lane, int wave) {
    LAS f32x4* gs4 = (LAS f32x4*)lds; LAS f32x4* sh4 = (LAS f32x4*)(lds + 4096); LAS f32x4* wf4 = (LAS f32x4*)(lds + 8192);
    for (int rb = bx; rb < MROWS / 128; rb += G) {
        const int b = rb / (SEQ / 128);
        if (tid < 256) { const f32x4 gv = ((const f32x4*)g)[tid], scv = ((const f32x4*)(msc + (size_t)b * MODW))[tid]; gs4[tid] = gv * (1.0f + scv); sh4[tid] = ((const f32x4*)(msh + (size_t)b * MODW))[tid]; }
        if (FF) for (int k = tid; k < 1024; k += NTHR) wf4[k] = *(const f32x4*)(wfcols + (size_t)k * NIN);
        __syncthreads();
        f32x4 nv[4];
        { const f32x4* xr0 = (const f32x4*)(xin + (size_t)(rb * 128 + wave * 16) * 1024) + lane;
#pragma unroll
          for (int j = 0; j < 4; ++j) nv[j] = xr0[64 * j]; }
        for (int i = 0; i < 16; ++i) {
            const int row = rb * 128 + wave * 16 + i;
            f32x4 v[4]; float ss = 0.f;
#pragma unroll
            for (int j = 0; j < 4; ++j) { v[j] = nv[j]; ss += (v[j].x * v[j].x + v[j].y * v[j].y) + (v[j].z * v[j].z + v[j].w * v[j].w); }
            if (i < 15) { const f32x4* xr = (const f32x4*)(xin + (size_t)(row + 1) * 1024) + lane;
#pragma unroll
                for (int j = 0; j < 4; ++j) nv[j] = xr[64 * j]; }
            ss = wave_sum(ss);
            const float rstd = 1.0f / sqrtf(ss * (1.0f / 1024.0f) + EPS);
            float f0 = 0.f, f1 = 0.f, f2 = 0.f, f3 = 0.f;
            unsigned long long* o8 = (unsigned long long*)(hout + (size_t)row * 1024) + lane;
#pragma unroll
            for (int j = 0; j < 4; ++j) {
                const f32x4 hv = v[j] * rstd * gs4[lane + 64 * j] + sh4[lane + 64 * j];
                o8[64 * j] = (unsigned long long)pk2(hv.x, hv.y) | ((unsigned long long)pk2(hv.z, hv.w) << 32);
                if (FF) { const int k = 4 * lane + 256 * j; const f32x4 w0 = wf4[k], w1 = wf4[k + 1], w2 = wf4[k + 2], w3 = wf4[k + 3];
                    f0 += hv.x * w0.x + hv.y * w1.x + hv.z * w2.x + hv.w * w3.x; f1 += hv.x * w0.y + hv.y * w1.y + hv.z * w2.y + hv.w * w3.y;
                    f2 += hv.x * w0.z + hv.y * w1.z + hv.z * w2.z + hv.w * w3.z; f3 += hv.x * w0.w + hv.y * w1.w + hv.z * w2.w + hv.w * w3.w; }
            }
            if (FF) { f0 = wave_sum(f0); f1 = wave_sum(f1); f2 = wave_sum(f2); f3 = wave_sum(f3); if (lane == 0) *(f32x4*)(ffout + (size_t)row * 4) = (f32x4){f0, f1, f2, f3}; }
        }
        __syncthreads();
    }
}

__device__ __forceinline__ void cum_scan(LAS unsigned char* lds, const float* ff, const float* fb, float* cumL, int bh, int tid, int lane, int wave) {
    const int b = bh >> 2, h = bh & 3; const float fbh = fb[h];
    float v[8]; float run = 0.f;
#pragma unroll
    for (int i = 0; i < 8; ++i) { const int s = tid * 8 + i; const float z = ff[((size_t)b * SEQ + s) * 4 + h] + fbh;
        const float ls = fminf(z, 0.f) - log1pf(expf(-fabsf(z))); run += ls * LOG2E; v[i] = run; }
    float incl = run;
#pragma unroll
    for (int o = 1; o < 64; o <<= 1) { const float t = __shfl_up(incl, o); if (lane >= o) incl += t; }
    LAS float* wt = (LAS float*)lds;
    if (lane == 63) wt[wave] = incl;
    __syncthreads();
    float off = incl - run;
    for (int ww = 0; ww < wave; ++ww) off += wt[ww];
    float* op = cumL + (size_t)bh * SEQ + tid * 8;
    *(f32x4*)op = (f32x4){v[0] + off, v[1] + off, v[2] + off, v[3] + off}; *(f32x4*)(op + 4) = (f32x4){v[4] + off, v[5] + off, v[6] + off, v[7] + off};
    __syncthreads();
}

template <int W>
__device__ __forceinline__ void pool_body(const bf16* yb, bf16* ob, int sfirst) {
    float ring[W];
#pragma unroll
    for (int j = 0; j < W - 1; ++j) { const int s = sfirst - (W - 1) + j; ring[j] = (s >= 0) ? bf2f(yb[(long)(j - (W - 1)) * NU]) : 0.f; }
    ring[W - 1] = 0.f;
#pragma unroll
    for (int t = 0; t < 64; ++t) {
        const float v = bf2f(yb[(long)t * NU]);
        ring[(t + W - 1) % W] = v;
        float sum = ring[0];
#pragma unroll
        for (int j = 1; j < W; ++j) sum += ring[j];
        const int s = sfirst + t;
        const float inv = (s + 1 < W) ? 1.0f / (float)(s + 1) : 1.0f / (float)W;
        ob[(long)t * 1024] = (bf16)f2bf(sum * inv - v);
    }
}
__device__ __forceinline__ void pool_unit(const bf16* U, bf16* MIX, int u, int tid) {
    const int b = u >> 5, s0 = (u & 31) * 128 + 64 * (tid >> 8), ch = tid & 255;
    const int gi = __builtin_amdgcn_readfirstlane((tid >> 6) & 3);
    const bf16* yb = U + ((size_t)b * SEQ + s0) * NU + 768 + ch;
    bf16* ob = MIX + ((size_t)b * SEQ + s0) * 1024 + 256 + ch;
    if (gi == 0) pool_body<2>(yb, ob, s0); else if (gi == 1) pool_body<4>(yb, ob, s0); else if (gi == 2) pool_body<8>(yb, ob, s0); else pool_body<16>(yb, ob, s0);
}
__device__ __forceinline__ void poolfold_item(const float* Win, const float* pw, const float* psc, int k0, int n0, bf16* WT, LAS float* scr, int lane) {
    const int gi = (n0 - 768) >> 6, d = ((n0 - 768) & 63) + (lane & 31);
    float pc[64];
    { const float sc = psc[gi * 64 + d];
#pragma unroll
      for (int c = 0; c < 64; ++c) pc[c] = pw[(gi * 64 + c) * 64 + d] * sc; }
    for (int i = 0; i < 32; ++i) { const int kk = 2 * i + (lane >> 5);
        const f32x4* wr = (const f32x4*)(Win + (size_t)(k0 + kk) * NIN + 772 + 64 * gi);
        float acc = 0.f;
#pragma unroll
        for (int c4 = 0; c4 < 16; ++c4) { const f32x4 wv = wr[c4]; acc += (wv.x * pc[4 * c4] + wv.y * pc[4 * c4 + 1]) + (wv.z * pc[4 * c4 + 2] + wv.w * pc[4 * c4 + 3]); }
        scr[kk * 33 + (lane & 31)] = acc; }
    LDS_WAIT(); asm volatile("" ::: "memory");
    const int c = lane & 7;
#pragma unroll
    for (int j = 0; j < 4; ++j) { const int n = (lane >> 3) + 8 * j; const LAS float* sp = scr + (8 * c) * 33 + n;
        v4u o; o.x = pk2(sp[0 * 33], sp[1 * 33]); o.y = pk2(sp[2 * 33], sp[3 * 33]); o.z = pk2(sp[4 * 33], sp[5 * 33]); o.w = pk2(sp[6 * 33], sp[7 * 33]);
        *(v4u*)(WT + (size_t)(n0 + n) * 1024 + k0 + 8 * c) = o; }
    LDS_WAIT(); asm volatile("" ::: "memory");
}

__device__ __forceinline__ void conv_unit(LAS unsigned char* lds, const bf16* U, const float* cw, const float* cb, const float* lng, const float* lnb, bf16* MIX, int u, int tid, int lane, int wave) {
    const int b = u >> 6, s0 = (u & 63) * 64;
    LAS float* hg = (LAS float*)lds;
    for (int task = tid; task < 94 * 32; task += NTHR) {
        const int tt = task >> 5, c8 = task & 31, s = s0 - 30 + tt;
        f32x4 h0 = (f32x4){0.f, 0.f, 0.f, 0.f}, h1 = h0;
        if (s >= 0) { const bf16* ur = U + ((size_t)b * SEQ + s) * NU + 2048 + 8 * c8; const v4u av = *(const v4u*)ur, gv = *(const v4u*)(ur + 256);
#pragma unroll
            for (int e = 0; e < 4; ++e) { h0[e] = bfe(av, e) * __builtin_amdgcn_rcpf(1.0f + __builtin_amdgcn_exp2f(-LOG2E * bfe(gv, e)));
                                          h1[e] = bfe(av, e + 4) * __builtin_amdgcn_rcpf(1.0f + __builtin_amdgcn_exp2f(-LOG2E * bfe(gv, e + 4))); } }
        *(LAS f32x4*)(hg + tt * 256 + 8 * c8) = h0; *(LAS f32x4*)(hg + tt * 256 + 8 * c8 + 4) = h1;
    }
    __syncthreads();
    {
        const int ch = tid & 255, half = tid >> 8;
        float w[31], acc[32];
#pragma unroll
        for (int j = 0; j < 31; ++j) w[j] = cw[j * 256 + ch];
        const float bias = cb[ch];
#pragma unroll
        for (int o = 0; o < 32; ++o) acc[o] = bias;
        const LAS float* hp = hg + (32 * half) * 256 + ch;
#pragma unroll
        for (int j = 0; j < 62; ++j) { const float v = hp[j * 256];
#pragma unroll
            for (int o = 0; o < 32; ++o) if (j - o >= 0 && j - o <= 30) acc[o] += v * w[j - o]; }
        __syncthreads();
#pragma unroll
        for (int o = 0; o < 32; ++o) hg[(32 * half + o) * 256 + ch] = acc[o];
    }
    __syncthreads();
    for (int i = 0; i < 8; ++i) {
        const int tok = wave * 8 + i;
        const f32x4 y = *(const LAS f32x4*)(hg + tok * 256 + 4 * lane);
        const float mean = wave_sum((y.x + y.y) + (y.z + y.w)) * (1.0f / 256.0f);
        const f32x4 d = y - mean;
        const float var = wave_sum((d.x * d.x + d.y * d.y) + (d.z * d.z + d.w * d.w)) * (1.0f / 256.0f);
        const float rstd = 1.0f / sqrtf(var + EPS);
        const f32x4 z = d * rstd * *(const f32x4*)(lng + 4 * lane) + *(const f32x4*)(lnb + 4 * lane);
        v2u o; o.x = pk2(siluf(z.x), siluf(z.y)); o.y = pk2(siluf(z.z), siluf(z.w));
        *(v2u*)(MIX + ((size_t)b * SEQ + s0 + tok) * 1024 + 768 + 4 * lane) = o;
    }
    __syncthreads();
}

constexpr int TJ = 136, TS = 72;
__device__ __forceinline__ void retkv_unit(LAS unsigned char* lds, bf16* U, const int* positions, float* KV, bf16* VT, int u, int tid, int lane, int wave) {
    const int b = u >> 7, n = (u >> 2) & 31, h = u & 3;
    LAS bf16* Kt = (LAS bf16*)lds;
    LAS bf16* Vt = (LAS bf16*)(lds + 64 * TJ * 2);
    const float lg = log2f(1.0f - exp2f(-5.0f - (float)h));
    {
        const int j = tid >> 2, p = tid & 3;
        const size_t row = (size_t)b * SEQ + n * 128 + j;
        bf16* ur = U + row * NU;
        const float pos = (float)positions[row];
        const float gq = exp2f(lg * (float)j), gk = 0.125f * exp2f(-lg * (float)j);
        const v4u q1 = *(const v4u*)(ur + 1024 + 64 * h + 8 * p), q2 = *(const v4u*)(ur + 1024 + 64 * h + 32 + 8 * p);
        const v4u k1 = *(const v4u*)(ur + 1280 + 64 * h + 8 * p), k2 = *(const v4u*)(ur + 1280 + 64 * h + 32 + 8 * p);
        const v4u v1 = *(const v4u*)(ur + 1536 + 64 * h + 8 * p), v2 = *(const v4u*)(ur + 1536 + 64 * h + 32 + 8 * p);
        unsigned qa[8], qb[8], ka[8], kb[8];
#pragma unroll
        for (int ii = 0; ii < 8; ++ii) {
            const int i = 8 * p + ii;
            const float inv = exp2f(-(float)i * (13.287712379549449f / 32.0f));
            const float ang = pos * inv;
            float rev = ang * 0.15915494309189535f; rev -= floorf(rev);
            const float sn = __builtin_amdgcn_sinf(rev), cs = __builtin_amdgcn_cosf(rev);
            const float a = bfe(q1, ii), c = bfe(q2, ii), ak = bfe(k1, ii), ck = bfe(k2, ii);
            qa[ii] = f2bf((a * cs - c * sn) * gq); qb[ii] = f2bf((a * sn + c * cs) * gq);
            ka[ii] = f2bf((ak * cs - ck * sn) * gk); kb[ii] = f2bf((ak * sn + ck * cs) * gk);
            Kt[(8 * p + ii) * TJ + j] = (bf16)ka[ii]; Kt[(32 + 8 * p + ii) * TJ + j] = (bf16)kb[ii];
            Vt[(8 * p + ii) * TJ + j] = (bf16)((v1[ii >> 1] >> (16 * (ii & 1))) & 0xffffu); Vt[(32 + 8 * p + ii) * TJ + j] = (bf16)((v2[ii >> 1] >> (16 * (ii & 1))) & 0xffffu);
        }
        *(v4u*)(ur + 1024 + 64 * h + 8 * p) = (v4u){qa[0] | (qa[1] << 16), qa[2] | (qa[3] << 16), qa[4] | (qa[5] << 16), qa[6] | (qa[7] << 16)};
        *(v4u*)(ur + 1024 + 64 * h + 32 + 8 * p) = (v4u){qb[0] | (qb[1] << 16), qb[2] | (qb[3] << 16), qb[4] | (qb[5] << 16), qb[6] | (qb[7] << 16)};
        *(v4u*)(ur + 1280 + 64 * h + 8 * p) = (v4u){ka[0] | (ka[1] << 16), ka[2] | (ka[3] << 16), ka[4] | (ka[5] << 16), ka[6] | (ka[7] << 16)};
        *(v4u*)(ur + 1280 + 64 * h + 32 + 8 * p) = (v4u){kb[0] | (kb[1] << 16), kb[2] | (kb[3] << 16), kb[4] | (kb[5] << 16), kb[6] | (kb[7] << 16)};
    }
    __syncthreads();
    if (wave < 4) {
        const int db = wave >> 1, eb = wave & 1, r32 = lane & 31, hi = lane >> 5;
        f32x16 acc;
#pragma unroll
        for (int r = 0; r < 16; ++r) acc[r] = 0.f;
#pragma unroll
        for (int ks = 0; ks < 8; ++ks) {
            const bf16x8 A = *(const LAS bf16x8*)(Kt + (32 * db + r32) * TJ + 16 * ks + 8 * hi);
            const bf16x8 B = *(const LAS bf16x8*)(Vt + (32 * eb + r32) * TJ + 16 * ks + 8 * hi);
            acc = __builtin_amdgcn_mfma_f32_32x32x16_bf16(A, B, acc, 0, 0, 0);
        }
        const float g127 = exp2f(lg * 127.0f);
        float* kvp = KV + (size_t)u * 4096;
#pragma unroll
        for (int r = 0; r < 16; ++r) kvp[(32 * db + crow(r, hi)) * 64 + 32 * eb + r32] = acc[r] * g127;
    }
    for (int p = tid; p < 1024; p += NTHR) { const int e = p >> 4, jc = p & 15; *(v4u*)(VT + (size_t)u * 8192 + e * 128 + 8 * jc) = *(const LAS v4u*)(Vt + e * TJ + 8 * jc); }
    __syncthreads();
}

__device__ __forceinline__ void retout_seg(LAS unsigned char* lds, const bf16* U, const float* KV, const bf16* VT, const float* gn, bf16* MIX, int wg, int tid, int lane, int wave) {
    const int b = wg >> 5, h = (wg >> 3) & 3, seg = wg & 7, n0 = 4 * seg;
    const float lg = log2f(1.0f - exp2f(-5.0f - (float)h));
    {
        const float decay = exp2f(lg * 128.0f), gam = exp2f(lg);
        const int d = tid >> 3, e0 = (tid & 7) * 8;
        f32x4 s0 = (f32x4){0.f, 0.f, 0.f, 0.f}, s1 = s0;
        const float* kvb = KV + ((size_t)(b * 32) * 4 + h) * 4096 + d * 64 + e0;
        for (int m = 0; m < n0; m += 4) { f32x4 t[4][2];
#pragma unroll
            for (int mm = 0; mm < 4; ++mm) { const f32x4* p = (const f32x4*)(kvb + (size_t)(m + mm) * 4 * 4096); t[mm][0] = p[0]; t[mm][1] = p[1]; }
#pragma unroll
            for (int mm = 0; mm < 4; ++mm) { s0 = s0 * decay + t[mm][0]; s1 = s1 * decay + t[mm][1]; } }
        f32x4 t[3][2];
#pragma unroll
        for (int c = 0; c < 3; ++c) { const f32x4* p = (const f32x4*)(kvb + (size_t)(n0 + c) * 4 * 4096); t[c][0] = p[0]; t[c][1] = p[1]; }
#pragma unroll
        for (int c = 0; c < 4; ++c) {
            LAS bf16* St = (LAS bf16*)(lds + c * (64 * TS * 2));
#pragma unroll
            for (int q = 0; q < 4; ++q) { St[(e0 + q) * TS + d] = (bf16)f2bf(s0[q] * gam); St[(e0 + 4 + q) * TS + d] = (bf16)f2bf(s1[q] * gam); }
            if (c < 3) { s0 = s0 * decay + t[c][0]; s1 = s1 * decay + t[c][1]; }
        }
    }
    __syncthreads();
    const int half = wave >> 2, ib = wave & 3, r32 = lane & 31, hi = lane >> 5;
#pragma unroll 1
    for (int pr = 0; pr < 2; ++pr) {
        const int n = n0 + 2 * pr + half, u = (b * 32 + n) * 4 + h;
        const LAS bf16* St = (const LAS bf16*)(lds + (2 * pr + half) * (64 * TS * 2));
        const size_t row0 = (size_t)b * SEQ + n * 128;
        const bf16* qp = U + (row0 + 32 * ib + r32) * NU + 1024 + 64 * h + 8 * hi;
        bf16x8 qf[4];
#pragma unroll
        for (int d0 = 0; d0 < 4; ++d0) qf[d0] = *(const bf16x8*)(qp + 16 * d0);
        f32x16 o[2];
#pragma unroll
        for (int r = 0; r < 16; ++r) { o[0][r] = 0.f; o[1][r] = 0.f; }
#pragma unroll
        for (int d0 = 0; d0 < 4; ++d0)
#pragma unroll
            for (int eb = 0; eb < 2; ++eb) { const bf16x8 A = *(const LAS bf16x8*)(St + (32 * eb + r32) * TS + 16 * d0 + 8 * hi); o[eb] = __builtin_amdgcn_mfma_f32_32x32x16_bf16(A, qf[d0], o[eb], 0, 0, 0); }
        const bf16* vtb = VT + (size_t)u * 8192;
        for (int jb = 0; jb <= ib; ++jb) {
            const bf16* kp = U + (row0 + 32 * jb + r32) * NU + 1280 + 64 * h + 8 * hi;
            f32x16 st;
#pragma unroll
            for (int r = 0; r < 16; ++r) st[r] = 0.f;
#pragma unroll
            for (int d0 = 0; d0 < 4; ++d0) st = __builtin_amdgcn_mfma_f32_32x32x16_bf16(*(const bf16x8*)(kp + 16 * d0), qf[d0], st, 0, 0, 0);
            if (jb == ib) {
#pragma unroll
                for (int r = 0; r < 16; ++r) if (crow(r, hi) > r32) st[r] = 0.f;
            }
#pragma unroll
            for (int k = 0; k < 2; ++k) {
                v4u pbw; pbw.x = pk2(st[8 * k], st[8 * k + 1]); pbw.y = pk2(st[8 * k + 2], st[8 * k + 3]); pbw.z = pk2(st[8 * k + 4], st[8 * k + 5]); pbw.w = pk2(st[8 * k + 6], st[8 * k + 7]);
                const bf16x8 pb = __builtin_bit_cast(bf16x8, pbw);
#pragma unroll
                for (int eb = 0; eb < 2; ++eb) {
                    const bf16* vp = vtb + (32 * eb + r32) * 128 + 32 * jb + 16 * k + 4 * hi;
                    const v2u lo = *(const v2u*)vp, hh = *(const v2u*)(vp + 8);
                    const bf16x8 A = __builtin_bit_cast(bf16x8, (v4u){lo.x, lo.y, hh.x, hh.y});
                    o[eb] = __builtin_amdgcn_mfma_f32_32x32x16_bf16(A, pb, o[eb], 0, 0, 0);
                }
            }
        }
        float sum = 0.f;
#pragma unroll
        for (int r = 0; r < 16; ++r) sum += o[0][r] + o[1][r];
        sum += __shfl_xor(sum, 32);
        const float mu = sum * (1.0f / 64.0f);
        float var = 0.f;
#pragma unroll
        for (int r = 0; r < 16; ++r) { const float d0 = o[0][r] - mu, d1 = o[1][r] - mu; var += d0 * d0 + d1 * d1; }
        var += __shfl_xor(var, 32);
        const float rstd = 1.0f / sqrtf(var * (1.0f / 64.0f) + EPS);
        const size_t tok = row0 + 32 * ib + r32;
        const bf16* gp = U + tok * NU + 1792 + 64 * h;
        bf16* op = MIX + tok * 1024 + 512 + 64 * h;
#pragma unroll
        for (int eb = 0; eb < 2; ++eb)
#pragma unroll
            for (int g4 = 0; g4 < 4; ++g4) {
                const int e = 32 * eb + 8 * g4 + 4 * hi;
                const v2u gw = *(const v2u*)(gp + e); const f32x4 gg = *(const f32x4*)(gn + 64 * h + e);
                float y[4];
#pragma unroll
                for (int c = 0; c < 4; ++c) y[c] = siluf(bfe2(gw, c)) * ((o[eb][4 * g4 + c] - mu) * rstd * gg[c]);
                v2u ov; ov.x = pk2(y[0], y[1]); ov.y = pk2(y[2], y[3]);
                *(v2u*)(op + e) = ov;
            }
    }
    __syncthreads();
}

struct Args { const void* in[21]; float* out; unsigned char* ws; };
__global__ void __launch_bounds__(NTHR, 2) fwd_kernel(Args a) {
    extern __shared__ __attribute__((aligned(16))) unsigned char lds_raw[];
    cg::grid_group grid = cg::this_grid();
    LAS unsigned char* lds = (LAS unsigned char*)lds_raw;
    int tid = threadIdx.x, lane = tid & 63, wave = __builtin_amdgcn_readfirstlane(tid >> 6);
    const int G = gridDim.x; int bx = blockIdx.x;
    int vcu = (G % 8 == 0) ? (bx % 8) * (G / 8) + bx / 8 : bx;
#define RELAUNDER() do { tid = threadIdx.x; asm volatile("" : "+v"(tid)); lane = tid & 63; wave = __builtin_amdgcn_readfirstlane(tid >> 6); bx = blockIdx.x; asm volatile("" : "+s"(bx)); vcu = (G % 8 == 0) ? (bx % 8) * (G / 8) + bx / 8 : bx; } while (0)
    const float* xin = (const float*)a.in[0]; const float* cin = (const float*)a.in[1]; const int* positions = (const int*)a.in[2];
    const float* ada_w = (const float*)a.in[3]; const float* ada_b = (const float*)a.in[4];
    const float* norm_mix_g = (const float*)a.in[5]; const float* norm_ffn_g = (const float*)a.in[6];
    const float* w_in = (const float*)a.in[7]; const float* fox_fb = (const float*)a.in[8];
    const float* pool_w = (const float*)a.in[9]; const float* pool_scale = (const float*)a.in[10]; const float* ret_gn_g = (const float*)a.in[11];
    const float* conv_w = (const float*)a.in[12]; const float* conv_b = (const float*)a.in[13]; const float* conv_ln_g = (const float*)a.in[14]; const float* conv_ln_b = (const float*)a.in[15];
    const float* w_out = (const float*)a.in[16]; const float* ffn_w1 = (const float*)a.in[17]; const float* ffn_w3 = (const float*)a.in[18]; const float* ffn_w2 = (const float*)a.in[19];
    const float* final_g = (const float*)a.in[20];
    float* out = a.out; unsigned char* ws = a.ws;
    float* mod = (float*)(ws + WS_MOD); float* cumL = (float*)(ws + WS_CUM); float* ffb = (float*)(ws + WS_FF);
    bf16* WB = (bf16*)(ws + WS_W); bf16* H = (bf16*)(ws + WS_H); bf16* U = (bf16*)(ws + WS_U); bf16* MIX = (bf16*)(ws + WS_MIX); bf16* HID = (bf16*)(ws + WS_HID);
    float* KV = (float*)(ws + WS_KV); bf16* VT = (bf16*)(ws + WS_VT);

    if (PH_PRO) {
        LAS float* scr = (LAS float*)(lds + wave * 16384);
        const int gw = bx * NWAVES + wave, NGW = G * NWAVES;
        for (int it = gw; it < DEPTH * 6016; it += NGW) {
            const int l = it / 6016; int r = it - l * 6016;
            bf16* wl = WB + (size_t)l * W_LAYER;
            if (r < 1280) { const int kb = r / 80, n0 = 32 * (r % 80);
                if (n0 >= 768 && n0 < 1024) { poolfold_item(w_in + (size_t)l * 1024 * NIN, pool_w + (size_t)l * 4 * 4096, pool_scale + l * 256, 64 * kb, n0, wl + WOFF_IN, scr, lane); continue; }
                transpose_item(w_in + (size_t)l * 1024 * NIN, NIN, 64 * kb, n0 + (n0 >= 768 ? 4 : 0), wl + WOFF_IN, 1024, n0, scr, lane); continue; } r -= 1280;
            if (r < 512) { const int kb = r / 32, n0 = 32 * (r % 32); transpose_item(w_out + (size_t)l * 1024 * 1024, 1024, 64 * kb, n0, wl + WOFF_OUT, 1024, n0, scr, lane); continue; } r -= 512;
            if (r < 1408) { const int kb = r / 88, n0 = 32 * (r % 88); transpose_item(ffn_w1 + (size_t)l * 1024 * DFF, DFF, 64 * kb, n0, wl + WOFF_13, 1024, (n0 / 128) * 256 + (n0 % 128), scr, lane); continue; } r -= 1408;
            if (r < 1408) { const int kb = r / 88, n0 = 32 * (r % 88); transpose_item(ffn_w3 + (size_t)l * 1024 * DFF, DFF, 64 * kb, n0, wl + WOFF_13, 1024, (n0 / 128) * 256 + 128 + (n0 % 128), scr, lane); continue; } r -= 1408;
            { const int kb = r / 32, n0 = 32 * (r % 32); transpose_item(ffn_w2 + (size_t)l * DFF * 1024, 1024, 64 * kb, n0, wl + WOFF_2, DFF, n0, scr, lane); }
        }
    }
    __syncthreads();
    if (PH_PRO) {
        LAS float* cact = (LAS float*)lds;
        LAS float* part = (LAS float*)(lds + 32768);
        for (int i = tid; i < BATCH * 1024; i += NTHR) { const float v = cin[i]; cact[i] = v / (1.0f + expf(-v)); }
        __syncthreads();
        for (int ch = bx; ch < DEPTH * 96; ch += G) {
            const int l = ch / 96, n0 = (ch % 96) * 64;
            const float* wp = ada_w + ((size_t)l * 1024 + wave * 128) * MODW + n0 + lane;
            float acc[8];
#pragma unroll
            for (int b = 0; b < 8; ++b) acc[b] = 0.f;
#pragma unroll 4
            for (int k = 0; k < 128; k += 4) {
                const float w0 = wp[(size_t)k * MODW], w1 = wp[(size_t)(k + 1) * MODW], w2 = wp[(size_t)(k + 2) * MODW], w3 = wp[(size_t)(k + 3) * MODW];
#pragma unroll
                for (int b = 0; b < 8; ++b) { const f32x4 cv = *(const LAS f32x4*)(cact + b * 1024 + wave * 128 + k); acc[b] += (cv.x * w0 + cv.y * w1) + (cv.z * w2 + cv.w * w3); }
            }
#pragma unroll
            for (int b = 0; b < 8; ++b) part[(wave * 8 + b) * 64 + lane] = acc[b];
            __syncthreads();
            { float s = ada_b[(size_t)l * MODW + n0 + lane];
#pragma unroll
              for (int ww = 0; ww < 8; ++ww) s += part[(ww * 8 + wave) * 64 + lane];
              mod[((size_t)l * 8 + wave) * MODW + n0 + lane] = s; }
            __syncthreads();
        }
    }
    grid.sync(); RELAUNDER();

    for (int l = 0; l < DEPTH; ++l) {
        const float* modl = mod + (size_t)l * 8 * MODW;
        bf16* wl = WB + (size_t)l * W_LAYER;
        const float* xcur = (l == 0) ? xin : out;
        for (int rp = 0; rp < REP_NORM; ++rp) norm_phase<true>(lds, xcur, norm_mix_g + l * 1024, modl + 1024, modl, H, w_in + (size_t)l * 1024 * NIN + 768, ffb, bx, G, tid, lane, wave);
        grid.sync(); RELAUNDER();
        if (PH_GIN) {
            if (bx < 32) cum_scan(lds, ffb, fox_fb + l * 4, cumL, bx, tid, lane, wave);
            __syncthreads();
            pg8::Gemm g{H, wl + WOFF_IN, MROWS, NU, 1024}; pg8::StaticOrder S; S.init(MROWS, NU, G, bx);
            pg8::EpiU E{U, NU, attn_body::C2};
            pg8::gemm_phase<pg8::EpiU, pg8::StaticOrder, true, true>(lds, g, S, E);
        }
        grid.sync(); RELAUNDER();
        for (int rp = 0; rp < REP_C1; ++rp) for (int u = vcu; u < 256; u += G) pool_unit(U, MIX, u, tid);
        RELAUNDER();
        for (int rp = 0; rp < REP_C1; ++rp) for (int u = vcu; u < 512; u += G) conv_unit(lds, U, conv_w + (size_t)l * 31 * 256, conv_b + l * 256, conv_ln_g + l * 256, conv_ln_b + l * 256, MIX, u, tid, lane, wave);
        RELAUNDER();
        if (PH_RKV) for (int u = vcu; u < 1024; u += G) retkv_unit(lds, U, positions, KV, VT, u, tid, lane, wave);
        grid.sync(); RELAUNDER();
        for (int rp = 0; rp < REP_ATT; ++rp) {
            const attn_body::AttnTensors AT{(const attn_body::bf16*)U, (const attn_body::bf16*)(U + 256), (const attn_body::bf16*)(U + 512), (attn_body::bf16*)MIX, cumL};
            const attn_body::StaticOrder S(G, bx);
            attn_body::attn_phase<attn_body::StaticOrder>((char*)lds_raw, AT, S);
        }
        __syncthreads(); RELAUNDER();
        for (int rp = 0; rp < REP_RET; ++rp) for (int wg = vcu; wg < 256; wg += G) retout_seg(lds, U, KV, VT, ret_gn_g + l * 256, MIX, wg, tid, lane, wave);
        grid.sync(); RELAUNDER();
        if (PH_GOUT) {
            pg8::Gemm g{MIX, wl + WOFF_OUT, MROWS, 1024, 1024}; pg8::StaticOrder S; S.init(MROWS, 1024, G, bx);
            pg8::EpiRes E{xcur, out, modl + 2048};
            pg8::gemm_phase<pg8::EpiRes, pg8::StaticOrder, true, true>(lds, g, S, E);
        }
        grid.sync(); RELAUNDER();
        for (int rp = 0; rp < REP_NORM; ++rp) norm_phase<false>(lds, out, norm_ffn_g + l * 1024, modl + 4096, modl + 3072, H, nullptr, nullptr, bx, G, tid, lane, wave);
        grid.sync(); RELAUNDER();
        if (PH_GUP) {
            pg8::Gemm g{H, wl + WOFF_13, MROWS, NH2, 1024}; pg8::StaticOrder S; S.init(MROWS, NH2, G, bx);
            pg8::EpiSwiGLU E{HID, DFF};
            pg8::gemm_phase<pg8::EpiSwiGLU, pg8::StaticOrder, true, true>(lds, g, S, E);
        }
        grid.sync(); RELAUNDER();
        if (PH_GDN) {
            pg8::Gemm g{HID, wl + WOFF_2, MROWS, 1024, DFF}; pg8::StaticOrder S; S.init(MROWS, 1024, G, bx);
            pg8::EpiRes E{out, out, modl + 5120};
            pg8::gemm_phase<pg8::EpiRes, pg8::StaticOrder, true, true>(lds, g, S, E);
        }
        grid.sync(); RELAUNDER();
    }
    {
        const int gw = bx * NWAVES + wave, NGW = G * NWAVES;
        for (int row = gw; row < MROWS; row += NGW) {
            f32x4* xr = (f32x4*)(out + (size_t)row * 1024) + lane;
            f32x4 v[4]; float ss = 0.f;
#pragma unroll
            for (int j = 0; j < 4; ++j) { v[j] = xr[64 * j]; ss += (v[j].x * v[j].x + v[j].y * v[j].y) + (v[j].z * v[j].z + v[j].w * v[j].w); }
            ss = wave_sum(ss);
            const float rstd = 1.0f / sqrtf(ss * (1.0f / 1024.0f) + EPS);
#pragma unroll
            for (int j = 0; j < 4; ++j) xr[64 * j] = v[j] * rstd * ((const f32x4*)final_g)[lane + 64 * j];
        }
    }
}

extern "C" void kernel_launch(void* const* d_in, const int* in_sizes, int n_in, void* d_out, int out_size, void* d_ws, size_t ws_size, hipStream_t stream) {
    static int grid = 0;
    if (grid == 0) {
        if (n_in != 21 || out_size != MROWS * 1024 || ws_size < WS_END) { fprintf(stderr, "kernel_launch: unexpected shapes: n_in %d out %d ws %zu (need %zu)\n", n_in, out_size, ws_size, (size_t)WS_END); grid = -1; return; }
        int dev = 0, cus = 0, per_cu = 0;
        hipGetDevice(&dev); hipDeviceGetAttribute(&cus, hipDeviceAttributeMultiprocessorCount, dev);
        if (hipFuncSetAttribute((const void*)fwd_kernel, hipFuncAttributeMaxDynamicSharedMemorySize, LDS_BYTES) != hipSuccess) { fprintf(stderr, "kernel_launch: hipFuncSetAttribute failed\n"); grid = -1; return; }
        if (hipOccupancyMaxActiveBlocksPerMultiprocessor(&per_cu, (const void*)fwd_kernel, NTHR, LDS_BYTES) != hipSuccess || per_cu < 1) { fprintf(stderr, "kernel_launch: occupancy query says %d\n", per_cu); per_cu = 1; }
        (void)hipGetLastError();
        grid = cus;
        if (grid != 256) fprintf(stderr, "kernel_launch: %d CUs; the attention deal assumes 256\n", grid);
    }
    if (grid < 0) return;
    Args a{};
    for (int i = 0; i < 21; ++i) a.in[i] = d_in[i];
    a.out = (float*)d_out; a.ws = (unsigned char*)d_ws;
    void* args[] = {&a};
    hipError_t e = hipLaunchCooperativeKernel((const void*)fwd_kernel, dim3(grid), dim3(NTHR), args, LDS_BYTES, stream);
    if (e != hipSuccess) fprintf(stderr, "kernel_launch: cooperative launch failed: %s (grid %d)\n", hipGetErrorString(e), grid);
}
```

```cpp
#include <hip/hip_runtime.h>
#include <hip/hip_cooperative_groups.h>
#include <cstdio>
#include <cstdint>
namespace pg8 {
#define PG8_LAS __attribute__((address_space(3)))
typedef unsigned short bf16_t;
typedef short bf16x8 __attribute__((ext_vector_type(8)));
typedef float f32x4 __attribute__((ext_vector_type(4)));
typedef unsigned u32x4 __attribute__((ext_vector_type(4)));
constexpr int BM = 256, BK = 64, HALF = 128, HTB = HALF * BK * 2  , STAGE_BYTES = 8 * HTB, NXCD = 8, WGM = 8;

__host__ __device__ __forceinline__ int lds_byte(int r, int c) { const int st = (r >> 4) * 2 + (c >> 5), rr = r & 15, cc = c & 31, ob = rr * 64 + cc * 2; return st * 1024 + (ob ^ (((ob >> 9) & 1) << 5)); }
__host__ __device__ __forceinline__ void stage_rc(int b, int& R, int& C) { const int st = b / 1024, sb = b % 1024, swz = sb ^ (((sb >> 9) & 1) << 5); R = (st >> 1) * 16 + swz / 64; C = (st & 1) * 32 + (swz % 64) / 2; }
__host__ __device__ __forceinline__ int perm32(int rho) { const int n = rho >> 4, i = rho & 15; return 8 * (i >> 2) + 4 * n + (i & 3); }

struct Unit { int pm, pn; };
struct Gemm { const bf16_t* A; const bf16_t* Bt; int M, N, K; };

struct StaticOrder {
    int nM, nN, nwg, G, c;
    __host__ __device__ void init(int M, int N, int G_, int c_) { nM = M / BM; nN = N / BM; nwg = nM * nN; G = G_; c = c_; }
    __host__ __device__ bool next(int i, Unit& u) const {
        const long L = (long)i * G + c; if (L >= nwg) return false;
        int wgid = (int)L; { const int q = nwg / NXCD, r = nwg % NXCD, xcd = wgid % NXCD, off = wgid / NXCD; wgid = (xcd < r ? xcd * (q + 1) : r * (q + 1) + (xcd - r) * q) + off; }
        const int nig = WGM * nN, gid = wgid / nig, fm = gid * WGM, gsz = (nM - fm) < WGM ? (nM - fm) : WGM;
        u.pm = fm + ((wgid % nig) % gsz); u.pn = (wgid % nig) / gsz; return true;
    }
    __device__ __forceinline__ void a_ready(const Unit&) const {}
    __device__ __forceinline__ void done(const Unit&) const {}
};

__device__ __forceinline__ unsigned cvt_pk_bf16(float lo, float hi) { unsigned r; asm volatile("v_cvt_pk_bf16_f32 %0, %1, %2" : "=v"(r) : "v"(lo), "v"(hi)); return r; }
typedef float f32x2 __attribute__((ext_vector_type(2)));
__device__ __forceinline__ float silu_f(float v) { return v * __builtin_amdgcn_rcpf(1.0f + __builtin_amdgcn_exp2f(-1.4426950408889634f * v)); }
struct EpiU {
    static constexpr bool PERM = true, AFTER_DRAIN = false;
    bf16_t* O; int ldc; float s0;
    __device__ __forceinline__ void operator()(const f32x4 (&acc)[2][2][4][2], const Unit& u, int wr, int wc, int fr, int fq) const {
        const int row0 = u.pm * BM + wr * 64 + fr, col0 = u.pn * BM + wc * 32 + 8 * fq;
        const float sc = (u.pn == 0) ? s0 : 1.f;
#pragma unroll
        for (int ai = 0; ai < 2; ++ai)
#pragma unroll
            for (int m = 0; m < 4; ++m) { bf16_t* rowp = O + (size_t)(row0 + ai * HALF + m * 16) * ldc + col0;
#pragma unroll
                for (int bj = 0; bj < 2; ++bj) { const f32x4 v0 = acc[ai][bj][m][0] * sc, v1 = acc[ai][bj][m][1] * sc;
                    u32x4 w; w.x = cvt_pk_bf16(v0[0], v0[1]); w.y = cvt_pk_bf16(v0[2], v0[3]); w.z = cvt_pk_bf16(v1[0], v1[1]); w.w = cvt_pk_bf16(v1[2], v1[3]);
                    *(u32x4*)(rowp + bj * HALF) = w; } }
    }
};
struct EpiRes {
    static constexpr bool PERM = false, AFTER_DRAIN = false;
    const float* base; float* out; const float* gate; float gscale;
    __device__ __forceinline__ void operator()(const f32x4 (&acc)[2][2][4][2], const Unit& u, int wr, int wc, int fr, int fq) const {
        const float* gp = gate + (size_t)(u.pm >> 4) * 6144;
        const int col0 = u.pn * BM + wc * 32 + 4 * fq;
        f32x4 gv[2][2];
#pragma unroll
        for (int bj = 0; bj < 2; ++bj)
#pragma unroll
            for (int n = 0; n < 2; ++n) gv[bj][n] = *(const f32x4*)(gp + col0 + bj * HALF + n * 16) * gscale;
#pragma unroll
        for (int ai = 0; ai < 2; ++ai) {
            f32x4 pre[4][2][2];
#pragma unroll
            for (int m = 0; m < 4; ++m) { const size_t off = (size_t)(u.pm * BM + ai * HALF + wr * 64 + m * 16 + fr) * 1024 + col0;
#pragma unroll
                for (int bj = 0; bj < 2; ++bj)
#pragma unroll
                    for (int n = 0; n < 2; ++n) pre[m][bj][n] = *(const f32x4*)(base + off + bj * HALF + n * 16); }
            asm volatile("" ::: "memory");
#pragma unroll
            for (int m = 0; m < 4; ++m) { const size_t off = (size_t)(u.pm * BM + ai * HALF + wr * 64 + m * 16 + fr) * 1024 + col0;
#pragma unroll
                for (int bj = 0; bj < 2; ++bj)
#pragma unroll
                    for (int n = 0; n < 2; ++n) *(f32x4*)(out + off + bj * HALF + n * 16) = pre[m][bj][n] + gv[bj][n] * acc[ai][bj][m][n]; }
            asm volatile("" ::: "memory");
        }
    }
};
struct EpiSwiGLU {
    static constexpr bool PERM = true, AFTER_DRAIN = false;
    bf16_t* O; int ldc;
    __device__ __forceinline__ void operator()(const f32x4 (&acc)[2][2][4][2], const Unit& u, int wr, int wc, int fr, int fq) const {
        const int row0 = u.pm * BM + wr * 64 + fr, col0 = u.pn * HALF + wc * 32 + 8 * fq;
#pragma unroll
        for (int ai = 0; ai < 2; ++ai)
#pragma unroll
            for (int m = 0; m < 4; ++m) { bf16_t* rowp = O + (size_t)(row0 + ai * HALF + m * 16) * ldc + col0;
                const f32x4 a0 = acc[ai][0][m][0], a1 = acc[ai][0][m][1], b0 = acc[ai][1][m][0], b1 = acc[ai][1][m][1];
                u32x4 w; w.x = cvt_pk_bf16(silu_f(a0[0]) * b0[0], silu_f(a0[1]) * b0[1]); w.y = cvt_pk_bf16(silu_f(a0[2]) * b0[2], silu_f(a0[3]) * b0[3]);
                w.z = cvt_pk_bf16(silu_f(a1[0]) * b1[0], silu_f(a1[1]) * b1[1]); w.w = cvt_pk_bf16(silu_f(a1[2]) * b1[2], silu_f(a1[3]) * b1[3]);
                *(u32x4*)rowp = w; }
    }
};
template <class Epi, class Sched, bool ALIGN_EPI = false, bool SP2 = false>
__device__ __forceinline__ void gemm_phase(PG8_LAS unsigned char* lds, const Gemm g, const Sched& S, const Epi& E) {
    int tid_ = threadIdx.x; asm volatile("" : "+v"(tid_));
    const int tid = tid_, wid = __builtin_amdgcn_readfirstlane(tid >> 6), lane = tid & 63, wr = wid >> 2, wc = wid & 3, fr = lane & 15, fq = lane >> 4;
    const int K = g.K, nt = K / BK;
    unsigned voffA[2], voffB[2];
#pragma unroll
    for (int i = 0; i < 2; ++i) { int R, C; stage_rc(tid * 16 + i * 8192, R, C); const int Rb = Epi::PERM ? ((R & ~31) + perm32(R & 31)) : R;
        voffA[i] = (unsigned)(R * K + C) * 2u; voffB[i] = (unsigned)(Rb * K + C) * 2u; }
    const size_t kstep = (size_t)(BK * 2);
    const size_t hstep = (size_t)HALF * K * 2;
    const size_t tstep = 2 * hstep;
    const unsigned ldsw = (unsigned)wid * 1024u;
    const int aoff = lds_byte(wr * 64 + fr, fq * 8), boff = lds_byte(wc * 32 + fr, fq * 8);
#define PG8_SA(b, h) (((b) * 2 + (h)) * HTB)
#define PG8_SB(b, h) ((4 + (b) * 2 + (h)) * HTB)
#define PG8_STAGE(bufoff, gbase, voff) do { _Pragma("unroll") for (int _i = 0; _i < 2; ++_i) \
        __builtin_amdgcn_global_load_lds((const unsigned*)((const char*)(gbase) + (voff)[_i]), (PG8_LAS unsigned*)(lds + (bufoff) + ldsw + _i * 8192), 16, 0, 0); } while (0)
#define PG8_LDA(dst, b, h) do { _Pragma("unroll") for (int m = 0; m < 4; ++m) _Pragma("unroll") for (int k = 0; k < 2; ++k) dst[m][k] = *(const PG8_LAS bf16x8*)(lds + PG8_SA(b, h) + aoff + m * 2048 + k * 1024); } while (0)
#define PG8_LDB(dst, b, h) do { _Pragma("unroll") for (int n = 0; n < 2; ++n) _Pragma("unroll") for (int k = 0; k < 2; ++k) dst[n][k] = *(const PG8_LAS bf16x8*)(lds + PG8_SB(b, h) + boff + n * 2048 + k * 1024); } while (0)
#define PG8_MMA(ai, bj, At, Bt) do { __builtin_amdgcn_s_setprio(1); _Pragma("unroll") for (int m = 0; m < 4; ++m) _Pragma("unroll") for (int n = 0; n < 2; ++n) _Pragma("unroll") for (int k = 0; k < 2; ++k) \
        acc[ai][bj][m][n] = __builtin_amdgcn_mfma_f32_16x16x32_bf16(Bt[n][k], At[m][k], acc[ai][bj][m][n], 0, 0, 0); __builtin_amdgcn_s_setprio(0); } while (0)
#define PG8_WAIT_V(n) asm volatile("s_waitcnt vmcnt(" #n ")" ::: "memory")
#define PG8_WAIT_L(n) asm volatile("s_waitcnt lgkmcnt(" #n ")" ::: "memory")
#define PG8_BAR __builtin_amdgcn_s_barrier()
#define PG8_SCHED __builtin_amdgcn_sched_barrier(0)
    Unit cur, nxt; int ui = 0;
    if (!S.next(0, cur)) return;
    f32x4 acc[2][2][4][2];
#pragma unroll
    for (int a = 0; a < 2; ++a)
#pragma unroll
        for (int b = 0; b < 2; ++b)
#pragma unroll
            for (int m = 0; m < 4; ++m)
#pragma unroll
                for (int n = 0; n < 2; ++n) acc[a][b][m][n] = (f32x4){0.f, 0.f, 0.f, 0.f};
    bf16x8 At[4][2], B0[2][2], B1[2][2];
    const char* cA = (const char*)g.A + (size_t)cur.pm * tstep; const char* cB = (const char*)g.Bt + (size_t)cur.pn * tstep;
    S.a_ready(cur);
    if constexpr (SP2) {
        PG8_STAGE(PG8_SB(0, 0), cB, voffB); PG8_STAGE(PG8_SB(0, 1), cB + hstep, voffB); PG8_STAGE(PG8_SA(0, 0), cA, voffA); PG8_STAGE(PG8_SA(0, 1), cA + hstep, voffA);
        if (wr == 1) PG8_BAR;
        PG8_WAIT_V(2); PG8_BAR;
        PG8_STAGE(PG8_SB(1, 0), cB + kstep, voffB); PG8_STAGE(PG8_SA(1, 0), cA + kstep, voffA); PG8_STAGE(PG8_SB(1, 1), cB + hstep + kstep, voffB);
        PG8_WAIT_V(6); PG8_BAR;
    } else {
        PG8_STAGE(PG8_SB(0, 0), cB, voffB); PG8_STAGE(PG8_SA(0, 0), cA, voffA); PG8_STAGE(PG8_SB(0, 1), cB + hstep, voffB); PG8_STAGE(PG8_SA(0, 1), cA + hstep, voffA);
        if (wr == 1) PG8_BAR;
        PG8_WAIT_V(4); PG8_BAR;
        PG8_STAGE(PG8_SB(1, 0), cB + kstep, voffB); PG8_STAGE(PG8_SA(1, 0), cA + kstep, voffA); PG8_STAGE(PG8_SB(1, 1), cB + hstep + kstep, voffB);
        PG8_WAIT_V(6); PG8_BAR;
    }
    for (;;) {
        const bool has_next = S.next(ui + 1, nxt);
        const char* nA = has_next ? (const char*)g.A + (size_t)nxt.pm * tstep : cA; const char* nB = has_next ? (const char*)g.Bt + (size_t)nxt.pn * tstep : cB;
        for (int t = 0; t < nt; t += 2) {
            const bool last = (t == nt - 2);
            const char* a1 = cA + (size_t)(t + 1) * kstep;
            const char* a2 = last ? nA : cA + (size_t)(t + 2) * kstep; const char* b2 = last ? nB : cB + (size_t)(t + 2) * kstep;
            const char* a3 = a2 + kstep; const char* b3 = b2 + kstep;
            if (last && has_next) S.a_ready(nxt);
            if constexpr (SP2) {
            PG8_LDB(B0, 0, 0); PG8_LDB(B1, 0, 1); PG8_SCHED; PG8_LDA(At, 0, 0); PG8_STAGE(PG8_SA(1, 1), a1 + hstep, voffA);
            PG8_WAIT_V(8); PG8_WAIT_L(0); PG8_BAR; PG8_MMA(0, 0, At, B0); PG8_MMA(0, 1, At, B1); PG8_BAR; PG8_SCHED;
            PG8_LDA(At, 0, 1); PG8_STAGE(PG8_SB(0, 0), b2, voffB); PG8_STAGE(PG8_SB(0, 1), b2 + hstep, voffB); PG8_STAGE(PG8_SA(0, 0), a2, voffA);
            PG8_WAIT_V(8); PG8_WAIT_L(0); PG8_BAR; PG8_MMA(1, 0, At, B0); PG8_MMA(1, 1, At, B1); PG8_BAR; PG8_SCHED;
            PG8_LDB(B0, 1, 0); PG8_LDB(B1, 1, 1); PG8_SCHED; PG8_LDA(At, 1, 0); PG8_STAGE(PG8_SA(0, 1), a2 + hstep, voffA);
            PG8_WAIT_V(8); PG8_WAIT_L(0); PG8_BAR; PG8_MMA(0, 0, At, B0); PG8_MMA(0, 1, At, B1); PG8_BAR; PG8_SCHED;
            PG8_LDA(At, 1, 1); PG8_STAGE(PG8_SB(1, 0), b3, voffB); PG8_STAGE(PG8_SB(1, 1), b3 + hstep, voffB); PG8_STAGE(PG8_SA(1, 0), a3, voffA);
            PG8_WAIT_V(8); PG8_WAIT_L(0); PG8_BAR; PG8_MMA(1, 0, At, B0); PG8_MMA(1, 1, At, B1); PG8_BAR; PG8_SCHED;
            } else {
            PG8_LDB(B0, 0, 0); PG8_SCHED; PG8_LDA(At, 0, 0); PG8_STAGE(PG8_SA(1, 1), a1 + hstep, voffA);
            PG8_WAIT_L(8); PG8_BAR; PG8_WAIT_L(0); PG8_MMA(0, 0, At, B0); PG8_BAR; PG8_SCHED;
            PG8_LDB(B1, 0, 1); PG8_STAGE(PG8_SB(0, 0), b2, voffB);
            PG8_BAR; PG8_WAIT_L(0); PG8_MMA(0, 1, At, B1); PG8_BAR;
            PG8_LDA(At, 0, 1); PG8_STAGE(PG8_SA(0, 0), a2, voffA);
            PG8_BAR; PG8_WAIT_L(0); PG8_MMA(1, 0, At, B0); PG8_BAR; PG8_SCHED;
            PG8_STAGE(PG8_SB(0, 1), b2 + hstep, voffB);
            PG8_WAIT_V(6); PG8_BAR; PG8_MMA(1, 1, At, B1); PG8_BAR;
            PG8_LDB(B0, 1, 0); PG8_SCHED; PG8_LDA(At, 1, 0); PG8_STAGE(PG8_SA(0, 1), a2 + hstep, voffA);
            PG8_WAIT_L(8); PG8_BAR; PG8_WAIT_L(0); PG8_MMA(0, 0, At, B0); PG8_BAR; PG8_SCHED;
            PG8_LDB(B1, 1, 1); PG8_STAGE(PG8_SB(1, 0), b3, voffB);
            PG8_BAR; PG8_WAIT_L(0); PG8_MMA(0, 1, At, B1); PG8_BAR;
            PG8_LDA(At, 1, 1); PG8_STAGE(PG8_SA(1, 0), a3, voffA);
            PG8_BAR; PG8_WAIT_L(0); PG8_MMA(1, 0, At, B0); PG8_BAR; PG8_SCHED;
            PG8_STAGE(PG8_SB(1, 1), b3 + hstep, voffB);
            PG8_WAIT_V(6); PG8_BAR; PG8_MMA(1, 1, At, B1); PG8_BAR;
            }
        }
        if constexpr (ALIGN_EPI) { if (wr == 0) PG8_BAR; }
        if constexpr (!Epi::AFTER_DRAIN) { E(acc, cur, wr, wc, fr, fq); S.done(cur); }
        if (!has_next) break;
#pragma unroll
        for (int a = 0; a < 2; ++a)
#pragma unroll
            for (int b = 0; b < 2; ++b)
#pragma unroll
                for (int m = 0; m < 4; ++m)
#pragma unroll
                    for (int n = 0; n < 2; ++n) acc[a][b][m][n] = (f32x4){0.f, 0.f, 0.f, 0.f};
        cur = nxt; cA = nA; cB = nB; ++ui;
        if constexpr (ALIGN_EPI) { if (wr == 1) PG8_BAR; }
    }
    PG8_WAIT_V(0);
    if constexpr (!ALIGN_EPI) { if (wr == 0) PG8_BAR; }
    PG8_BAR;
    if constexpr (Epi::AFTER_DRAIN) { E.fused(acc, cur, wr, wc, fr, fq, lds, wid, lane); S.done(cur); }
#undef PG8_SA
#undef PG8_SB
#undef PG8_STAGE
#undef PG8_LDA
#undef PG8_LDB
#undef PG8_MMA
#undef PG8_WAIT_V
#undef PG8_WAIT_L
#undef PG8_BAR
#undef PG8_SCHED
}
}
#include <hip/hip_bf16.h>
#include <cmath>
namespace attn_body {
using bf16=__hip_bfloat16;
using bf16x8=__attribute__((ext_vector_type(8)))short;
using s16x4=__attribute__((ext_vector_type(4)))short;
using f32x16=__attribute__((ext_vector_type(16)))float;
using u32x4=__attribute__((ext_vector_type(4)))unsigned;
constexpr int BATCH=8,NHEAD=4,SEQ=4096,D=64,DM=2560,DMO=1024;
constexpr int NW=8,QBLK=32,QB=QBLK*NW,KVBLK=64,NQB=SEQ/QB;
constexpr int ATTN_PITCH=DM, ATTN_UNIT_ROWS=QB;
__device__ __forceinline__ int crow(int r,int hi){return (r&3)+8*(r>>2)+4*hi;}
#define SBAR() __builtin_amdgcn_sched_barrier(0)
__device__ __forceinline__ void cmask(f32x16&p0,f32x16&p1,int jb,int qrel,int hi){
  const float NEG=-INFINITY; int kb=64*jb+4*hi;
  #pragma unroll
  for(int r=0;r<16;++r){int kv=kb+(r&3)+8*(r>>2); if(kv>qrel)p0[r]=NEG; if(kv+32>qrel)p1[r]=NEG;}
}

constexpr int NSLOT=3, SLOTB=8192;
constexpr int LDS_K=0, LDS_V=NSLOT*SLOTB, LDS_WS=2*NSLOT*SLOTB, LDS_OST=LDS_WS+NW*64*4, LDS_CUM=LDS_OST+NW*4096, LDS_BYTES=LDS_CUM+SEQ*4;
constexpr float C2=0.125f*1.4426950408889634f;
__device__ __forceinline__ void glds16(const void*gsrc,unsigned lds_dst){unsigned keep;
  asm volatile("s_mov_b32 %0, m0\n\ts_mov_b32 m0, %2\n\ts_nop 0\n\tglobal_load_lds_dwordx4 %1, off\n\ts_mov_b32 m0, %0":"=&s"(keep):"v"(gsrc),"s"(lds_dst):"memory");}
__device__ __forceinline__ float max3f(float a,float b,float c){float r;asm("v_max3_f32 %0, %1, %2, %3":"=v"(r):"v"(a),"v"(b),"v"(c));return r;}
__device__ __forceinline__ float max2f(float a,float b){float r;asm("v_max_f32_e32 %0, %1, %2":"=v"(r):"v"(a),"v"(b));return r;}
__device__ __forceinline__ float fadd_s(float a,float b){float r;asm("v_add_f32_e32 %0, %1, %2":"=v"(r):"v"(a),"v"(b));return r;}
__device__ __forceinline__ float fsub_s(float a,float b){float r;asm("v_sub_f32_e32 %0, %1, %2":"=v"(r):"v"(a),"v"(b));return r;}
typedef float f32x2_t __attribute__((ext_vector_type(2))); typedef __bf16 bf16x2_t __attribute__((ext_vector_type(2)));
__device__ __forceinline__ unsigned cvtpk_s(float lo,float hi){f32x2_t v={lo,hi};bf16x2_t b=__builtin_convertvector(v,bf16x2_t);return __builtin_bit_cast(unsigned,b);}
#define WAIT_BAR(N) asm volatile("s_waitcnt vmcnt(" #N ") lgkmcnt(0)\n\ts_barrier":::"memory")

__device__ __forceinline__ void qkt(f32x16&p0,f32x16&p1,const char*Kslot,const bf16x8*qr,const f32x16&negm,int r32,int hi){
  const char*kb=Kslot+hi*1024+r32*16;
  #pragma unroll
  for(int d0=0;d0<4;++d0){
    const bf16x8 b0=*reinterpret_cast<const bf16x8*>(kb+d0*2048);
    const bf16x8 b1=*reinterpret_cast<const bf16x8*>(kb+d0*2048+512);
    if(d0==0){p0=__builtin_amdgcn_mfma_f32_32x32x16_bf16(b0,qr[0],negm,0,0,0);p1=__builtin_amdgcn_mfma_f32_32x32x16_bf16(b1,qr[0],negm,0,0,0);}
    else{p0=__builtin_amdgcn_mfma_f32_32x32x16_bf16(b0,qr[d0],p0,0,0,0);p1=__builtin_amdgcn_mfma_f32_32x32x16_bf16(b1,qr[d0],p1,0,0,0);}}
}
typedef __attribute__((address_space(3))) const char* lds_cptr;
typedef short v4i16_t __attribute__((ext_vector_type(4)));
__device__ __forceinline__ void kload8(bf16x8*kf,lds_cptr kp){
  kf[0]=*(const __attribute__((address_space(3))) bf16x8*)(kp);      kf[1]=*(const __attribute__((address_space(3))) bf16x8*)(kp+512);
  kf[2]=*(const __attribute__((address_space(3))) bf16x8*)(kp+2048); kf[3]=*(const __attribute__((address_space(3))) bf16x8*)(kp+2560);
  kf[4]=*(const __attribute__((address_space(3))) bf16x8*)(kp+4096); kf[5]=*(const __attribute__((address_space(3))) bf16x8*)(kp+4608);
  kf[6]=*(const __attribute__((address_space(3))) bf16x8*)(kp+6144); kf[7]=*(const __attribute__((address_space(3))) bf16x8*)(kp+6656);
}
__device__ __forceinline__ void kload2(bf16x8*kf,lds_cptr kp,int j){ kf[2*j]=*(const __attribute__((address_space(3))) bf16x8*)(kp+j*2048); kf[2*j+1]=*(const __attribute__((address_space(3))) bf16x8*)(kp+j*2048+512); }
__device__ __forceinline__ s16x4 vtr(lds_cptr p){ return __builtin_bit_cast(s16x4,__builtin_amdgcn_ds_read_tr16_b64_v4i16((__attribute__((address_space(3))) v4i16_t*)p)); }
__device__ __forceinline__ float rowmax(const f32x16&p0,const f32x16&p1){
  float a=max3f(p0[0],p0[1],p1[0]),b=max3f(p0[2],p0[3],p1[1]);a=max3f(a,p1[2],p1[3]);
  #pragma unroll
  for(int r=4;r<16;r+=4){a=max3f(a,p0[r],p0[r+1]);b=max3f(b,p0[r+2],p0[r+3]);a=max3f(a,p1[r],p1[r+1]);b=max3f(b,p1[r+2],p1[r+3]);}
  const float m=max2f(a,b);
  auto rr=__builtin_amdgcn_permlane32_swap(__float_as_uint(m),__float_as_uint(m),false,false);
  return max2f(__uint_as_float(rr[0]),__uint_as_float(rr[1]));
}
__device__ __forceinline__ void pv(f32x16*o,int vb,bf16x8 pa0,bf16x8 pa1,bf16x8 pa2,bf16x8 pa3){
  #pragma unroll
  for(int d0=0;d0<2;++d0){s16x4 lo[4],hi[4];
    #pragma unroll
    for(int ks=0;ks<4;++ks){
      asm volatile("ds_read_b64_tr_b16 %0,%1 offset:%c2":"=&v"(lo[ks]):"v"(vb),"i"(d0*4096+ks*1024):"memory");
      asm volatile("ds_read_b64_tr_b16 %0,%1 offset:%c2":"=&v"(hi[ks]):"v"(vb),"i"(d0*4096+ks*1024+512):"memory");}
    asm volatile("s_waitcnt lgkmcnt(0)":::"memory");SBAR();
    #define PK(k) (bf16x8){lo[k][0],lo[k][1],lo[k][2],lo[k][3],hi[k][0],hi[k][1],hi[k][2],hi[k][3]}
    o[d0]=__builtin_amdgcn_mfma_f32_32x32x16_bf16(pa0,PK(0),o[d0],0,0,0);
    o[d0]=__builtin_amdgcn_mfma_f32_32x32x16_bf16(pa1,PK(1),o[d0],0,0,0);
    o[d0]=__builtin_amdgcn_mfma_f32_32x32x16_bf16(pa2,PK(2),o[d0],0,0,0);
    o[d0]=__builtin_amdgcn_mfma_f32_32x32x16_bf16(pa3,PK(3),o[d0],0,0,0);
    #undef PK
  }
}

#ifndef ATTN_STORE16
#define ATTN_STORE16(p,v) (*(u32x4*)(p)=(v))
#endif
template<int THRL> __device__ __forceinline__ void attn_unit(int b,int h,int qb,const bf16*Q,const bf16*__restrict__ K,const bf16*__restrict__ V,bf16*O,const float*__restrict__ cumg,char*shm){
  int tid_=threadIdx.x; asm volatile("":"+v"(tid_)); const int tid=tid_,lane=tid&63,r32=lane&31,hi=lane>>5; const int wid=__builtin_amdgcn_readfirstlane(tid>>6);
  const long rowbase=(long)b*SEQ; const int q0=qb*QB;
  typedef float f32x4_t __attribute__((ext_vector_type(4)));
  { __attribute__((address_space(3))) f32x4_t* cl=(__attribute__((address_space(3))) f32x4_t*)((__attribute__((address_space(3))) char*)shm+LDS_CUM);
    const f32x4_t* cgp=(const f32x4_t*)cumg; for(int i=tid;i<(q0+QB)/4;i+=NW*64)cl[i]=cgp[i]; }
  const float cqL=cumg[q0+wid*QBLK+r32];
  const __attribute__((address_space(3))) f32x4_t* cumq=(const __attribute__((address_space(3))) f32x4_t*)((__attribute__((address_space(3))) char*)shm+LDS_CUM)+hi;
  #define KBIAS(P0,P1,t) do{ const __attribute__((address_space(3))) f32x4_t* cb_=cumq+16*(t); _Pragma("unroll") for(int g_=0;g_<4;++g_){ const f32x4_t a_=cb_[2*g_], b_=cb_[8+2*g_]; \
      P0[4*g_]+=cqm-a_[0];P0[4*g_+1]+=cqm-a_[1];P0[4*g_+2]+=cqm-a_[2];P0[4*g_+3]+=cqm-a_[3]; P1[4*g_]+=cqm-b_[0];P1[4*g_+1]+=cqm-b_[1];P1[4*g_+2]+=cqm-b_[2];P1[4*g_+3]+=cqm-b_[3]; } }while(0)
  const bf16*Qw=Q+(rowbase+q0+wid*QBLK)*DM+h*D;
  const bf16*Kh=K+rowbase*DM+h*D,*Vh=V+rowbase*DM+h*D;
  const unsigned lds0=(unsigned)(uintptr_t)shm;
  float*wsf=(float*)(shm+LDS_WS)+wid*64;
  const bf16*ksrc=Kh+(long)lane*DM+wid*8;
  const bf16*vsrc=Vh+(long)(16*(wid&3)+(lane>>2))*DM+(wid>>2)*32+(lane&3)*8;
  const unsigned kdst=lds0+LDS_K+wid*1024, vdst=lds0+LDS_V+wid*1024;
  #define DMA_K(t,slot) glds16(ksrc+(long)(t)*KVBLK*DM,(unsigned)__builtin_amdgcn_readfirstlane(kdst+(slot)))
  #define DMA_V(t,slot) glds16(vsrc+(long)(t)*KVBLK*DM,(unsigned)__builtin_amdgcn_readfirstlane(vdst+(slot)))
  const int vb0=(int)(lds0+LDS_V)+((lane>>4)&1)*32+(lane&3)*8+(4*hi+((lane&15)>>2))*64;
  const char*Kbase=shm+LDS_K; bf16x8 kf[8];
  const lds_cptr shm3=(lds_cptr)shm; const lds_cptr kp0=shm3+LDS_K+hi*1024+r32*16; const lds_cptr vp0=shm3+LDS_V+((lane>>4)&1)*32+(lane&3)*8+(4*hi+((lane&15)>>2))*64;
  const int NT=(q0+QB)/KVBLK;
  DMA_K(0,0);DMA_V(0,0);DMA_K(1,SLOTB);
  bf16x8 qr[4];
  #pragma unroll
  for(int d0=0;d0<4;++d0)qr[d0]=*reinterpret_cast<const bf16x8*>(&Qw[(long)r32*DM+d0*16+hi*8]);
  float diagL=0.f;
  { const bf16*Kd=Kh+(long)(q0+wid*QBLK+r32)*DM+hi*8;
    #pragma unroll
    for(int d0=0;d0<4;++d0){ const bf16x8 kk=*reinterpret_cast<const bf16x8*>(&Kd[d0*16]);
      #pragma unroll
      for(int e=0;e<8;++e)diagL+=__builtin_bit_cast(float,(unsigned)(unsigned short)qr[d0][e]<<16)*__builtin_bit_cast(float,(unsigned)(unsigned short)kk[e]<<16); }
    auto rr=__builtin_amdgcn_permlane32_swap(__float_as_uint(diagL),__float_as_uint(diagL),false,false); diagL=__uint_as_float(rr[0])+__uint_as_float(rr[1]); }
  float mhat=0.f,l_reg=0.f;f32x16 o[2];o[0]=f32x16{};o[1]=f32x16{};float cqm=cqL; const f32x16 negm=f32x16{};
  const int qrel=wid*QBLK+r32;
  #define CMASK(P0,P1,t) do{int jb_=(t)-(NT-4); if(jb_>=0)cmask(P0,P1,jb_,qrel,hi);}while(0)
  bool resc=false;
  #define START(P0,P1) do{ const float rm=rowmax(P0,P1); resc=false; \
    { const float dl=__builtin_fmaxf(rm,diagL); mhat=fadd_s(mhat,dl); \
      _Pragma("unroll") for(int r=0;r<16;++r){P0[r]=fsub_s(P0[r],dl);P1[r]=fsub_s(P1[r],dl);} \
      cqm=cqL-mhat; } \
    _Pragma("unroll") for(int r=0;r<16;++r)P0[r]=__builtin_amdgcn_exp2f(P0[r]); }while(0)
  #define RESC() do{ if(resc){ asm volatile("s_waitcnt lgkmcnt(0)":::"memory"); \
      _Pragma("unroll") for(int d_=0;d_<2;++d_) _Pragma("unroll") for(int r=0;r<16;++r)o[d_][r]*=wsf[crow(r,hi)]; } }while(0)
  f32x16 pA0,pA1,pB0,pB1;
  int sl_prev=0,sl_cur=0,sl_next=SLOTB;
  #define ROT() do{sl_prev=sl_cur;sl_cur=sl_next;sl_next=(sl_next==(NSLOT-1)*SLOTB)?0:sl_next+SLOTB;}while(0)
  DMA_K(2,2*SLOTB);
  WAIT_BAR(3);
  qkt(pA0,pA1,Kbase,qr,negm,r32,hi);asm volatile("s_nop 15\n\ts_nop 7":"+v"(pA0),"+v"(pA1));KBIAS(pA0,pA1,0);CMASK(pA0,pA1,0);
  START(pA0,pA1);
  _Pragma("unroll") for(int r=0;r<16;++r)pA1[r]=__builtin_amdgcn_exp2f(pA1[r]);
  WAIT_BAR(0);
  DMA_K(3,0);DMA_V(1,SLOTB);
  ROT();
  kload8(kf,kp0+sl_cur);
  WAIT_BAR(2);
  s16x4 vlo[8],vhi[8]; u32x4 pw0,pw1,pw2,pw3;
  #define PKW(P,B) cvtpk_s(P[B],P[B+1])
  #define PAF(k) __builtin_bit_cast(bf16x8,pw##k)
  #define VFR(i) (bf16x8){vlo[i][0],vlo[i][1],vlo[i][2],vlo[i][3],vhi[i][0],vhi[i][1],vhi[i][2],vhi[i][3]}
  #define PIN(x) asm volatile("":"+v"(x))
  #define MX3(a,b,c) __builtin_fmaxf(__builtin_fmaxf((a),(b)),(c))
  #define GAPA(MF,A0,A1,A2,A3,W0,W1,PW) do{ MF; sacc+=A0; sacc+=A1; sacc+=A2; sacc+=A3; PIN(sacc); W0; W1; PIN(PW); SBAR(); }while(0)
  #define EX(v) __builtin_amdgcn_exp2f(v)
  #define GAPB(MF,X,B) do{ MF; X[B]=EX(X[B]); X[B+1]=EX(X[B+1]); X[B+2]=EX(X[B+2]); X[B+3]=EX(X[B+3]); PIN(X); SBAR(); }while(0)
  #define VRD(i) do{ vlo[i]=vtr(vp_+(((i)>>2)*4096+((i)&3)*1024)); vhi[i]=vtr(vp_+(((i)>>2)*4096+((i)&3)*1024+512)); }while(0)
  #define KRD(G,j) do{ if(G){ kload2(kf,kp0+sl_next,j); SBAR(); } }while(0)
  #define STEP(C0,C1,P0,P1,t,GK,GV,GL) do{ SBAR(); \
    const lds_cptr vp_=vp0+sl_prev; \
    VRD(0); SBAR(); float sacc=(P0[0]+P0[1]); \
    GAPA(C0=__builtin_amdgcn_mfma_f32_32x32x16_bf16(kf[0],qr[0],negm,0,0,0), P0[2],P0[3],P0[4],P0[5],     pw0[0]=PKW(P0,0), pw0[1]=PKW(P0,2), pw0); \
    VRD(4); SBAR(); GAPA(C1=__builtin_amdgcn_mfma_f32_32x32x16_bf16(kf[1],qr[0],negm,0,0,0), P0[6],P0[7],P0[8],P0[9],     pw0[2]=PKW(P0,4), pw0[3]=PKW(P0,6), pw0); \
    VRD(1); SBAR(); GAPA(C0=__builtin_amdgcn_mfma_f32_32x32x16_bf16(kf[2],qr[1],C0,0,0,0),   P0[10],P0[11],P0[12],P0[13], pw1[0]=PKW(P0,8), pw1[1]=PKW(P0,10), pw1); \
    VRD(5); SBAR(); GAPA(C1=__builtin_amdgcn_mfma_f32_32x32x16_bf16(kf[3],qr[1],C1,0,0,0),   P0[14],P0[15],P1[0],P1[1],   pw1[2]=PKW(P0,12),pw1[3]=PKW(P0,14), pw1); \
    VRD(2); SBAR(); GAPA(C0=__builtin_amdgcn_mfma_f32_32x32x16_bf16(kf[4],qr[2],C0,0,0,0),   P1[2],P1[3],P1[4],P1[5],     pw2[0]=PKW(P1,0), pw2[1]=PKW(P1,2), pw2); \
    VRD(6); SBAR(); GAPA(C1=__builtin_amdgcn_mfma_f32_32x32x16_bf16(kf[5],qr[2],C1,0,0,0),   P1[6],P1[7],P1[8],P1[9],     pw2[2]=PKW(P1,4), pw2[3]=PKW(P1,6), pw2); \
    VRD(3); SBAR(); GAPA(C0=__builtin_amdgcn_mfma_f32_32x32x16_bf16(kf[6],qr[3],C0,0,0,0),   P1[10],P1[11],P1[12],P1[13], pw3[0]=PKW(P1,8), pw3[1]=PKW(P1,10), pw3); \
    VRD(7); SBAR(); GAPA(C1=__builtin_amdgcn_mfma_f32_32x32x16_bf16(kf[7],qr[3],C1,0,0,0),   P1[14],P1[15],0.f,0.f,       pw3[2]=PKW(P1,12),pw3[3]=PKW(P1,14), pw3); \
    l_reg+=sacc; \
    if(GK){DMA_K((t)+3,sl_cur);} if(GV){DMA_V((t)+1,sl_next);} \
    KBIAS(C0,C1,t); CMASK(C0,C1,t); \
    { float a=MX3(C0[0],C0[1],C1[0]),b=MX3(C0[2],C0[3],C1[1]); a=MX3(a,C1[2],C1[3]); \
      _Pragma("unroll") for(int r=4;r<16;r+=4){a=MX3(a,C0[r],C0[r+1]);b=MX3(b,C0[r+2],C0[r+3]);a=MX3(a,C1[r],C1[r+1]);b=MX3(b,C1[r+2],C1[r+3]);} \
      float rm=__builtin_fmaxf(a,b); { auto rr=__builtin_amdgcn_permlane32_swap(__float_as_uint(rm),__float_as_uint(rm),false,false); rm=__builtin_fmaxf(__uint_as_float(rr[0]),__uint_as_float(rr[1])); } \
      resc=false; \
      if(__builtin_expect(__any(rm>(float)THRL),0)){ const float dl=__builtin_fmaxf(rm,0.f); mhat+=dl; \
        _Pragma("unroll") for(int r=0;r<16;++r){C0[r]-=dl;C1[r]-=dl;} \
        cqm=cqL-mhat; \
        const float f=__builtin_amdgcn_exp2f(-dl); l_reg*=f; if(hi==0)wsf[r32]=f; resc=true; } } \
    SBAR(); \
    GAPB(o[0]=__builtin_amdgcn_mfma_f32_32x32x16_bf16(PAF(0),VFR(0),o[0],0,0,0), C0,0); \
    GAPB(o[1]=__builtin_amdgcn_mfma_f32_32x32x16_bf16(PAF(0),VFR(4),o[1],0,0,0), C0,4); \
    KRD(GL,0); GAPB(o[0]=__builtin_amdgcn_mfma_f32_32x32x16_bf16(PAF(1),VFR(1),o[0],0,0,0), C0,8); \
    KRD(GL,1); GAPB(o[1]=__builtin_amdgcn_mfma_f32_32x32x16_bf16(PAF(1),VFR(5),o[1],0,0,0), C0,12); \
    KRD(GL,2); GAPB(o[0]=__builtin_amdgcn_mfma_f32_32x32x16_bf16(PAF(2),VFR(2),o[0],0,0,0), C1,0); \
    KRD(GL,3); GAPB(o[1]=__builtin_amdgcn_mfma_f32_32x32x16_bf16(PAF(2),VFR(6),o[1],0,0,0), C1,4); \
    GAPB(o[0]=__builtin_amdgcn_mfma_f32_32x32x16_bf16(PAF(3),VFR(3),o[0],0,0,0), C1,8); \
    GAPB(o[1]=__builtin_amdgcn_mfma_f32_32x32x16_bf16(PAF(3),VFR(7),o[1],0,0,0), C1,12); \
    }while(0)
  int t=1;
  #undef CMASK
  #define CMASK(P0,P1,t) do{}while(0)
  for(;t+5<NT;t+=2){
    STEP(pB0,pB1,pA0,pA1,t,true,true,true);     WAIT_BAR(2); RESC(); ROT();
    STEP(pA0,pA1,pB0,pB1,t+1,true,true,true);   WAIT_BAR(2); RESC(); ROT();
  }
  #undef CMASK
  #define CMASK(P0,P1,t) do{int jb_=(t)-(NT-4); if(jb_>=0)cmask(P0,P1,jb_,qrel,hi);}while(0)
  #define ENDW(tt) do{ if((tt)+3<NT){WAIT_BAR(2);} else if((tt)+2<NT){WAIT_BAR(1);} else {WAIT_BAR(0);} }while(0)
  for(;t+1<NT;t+=2){
    STEP(pB0,pB1,pA0,pA1,t,(t+3<NT),(t+1<NT),(t+1<NT));       ENDW(t);   RESC(); ROT();
    STEP(pA0,pA1,pB0,pB1,t+1,(t+4<NT),(t+2<NT),(t+2<NT));     ENDW(t+1); RESC(); ROT();
  }
  STEP(pB0,pB1,pA0,pA1,NT-1,false,false,false); RESC();
  { float sacc=pB0[0]+pB0[1]; _Pragma("unroll") for(int r=2;r<16;++r)sacc+=pB0[r]; _Pragma("unroll") for(int r=0;r<16;++r)sacc+=pB1[r]; l_reg+=sacc;
    pw0=(u32x4){PKW(pB0,0),PKW(pB0,2),PKW(pB0,4),PKW(pB0,6)};pw1=(u32x4){PKW(pB0,8),PKW(pB0,10),PKW(pB0,12),PKW(pB0,14)};pw2=(u32x4){PKW(pB1,0),PKW(pB1,2),PKW(pB1,4),PKW(pB1,6)};pw3=(u32x4){PKW(pB1,8),PKW(pB1,10),PKW(pB1,12),PKW(pB1,14)};
    SBAR(); pv(o,vb0+sl_cur,PAF(0),PAF(1),PAF(2),PAF(3)); }
  #undef PKW
  #undef PAF
  #undef VFR
  #undef PIN
  #undef MX3
  #undef GAPA
  #undef GAPB
  #undef EX
  #undef VRD
  #undef KRD
  #undef STEP
  #undef ENDW
  {auto rr=__builtin_amdgcn_permlane32_swap(__float_as_uint(l_reg),__float_as_uint(l_reg),false,false);l_reg=__uint_as_float(rr[0])+__uint_as_float(rr[1]);}
  if(hi==0)wsf[32+r32]=l_reg;asm volatile("s_waitcnt lgkmcnt(0)":::"memory");
  float rli[16];
  #pragma unroll
  for(int r=0;r<16;++r)rli[r]=__builtin_amdgcn_rcpf(wsf[32+crow(r,hi)]);
  bf16*Ow=O+(rowbase+q0+wid*QBLK)*DMO+h*D;
  { bf16*stg=(bf16*)(shm+LDS_OST)+wid*2048;
    #pragma unroll
    for(int r=0;r<16;++r){const int orow=crow(r,hi);
      #pragma unroll
      for(int d0=0;d0<2;++d0)stg[orow*64+d0*32+r32]=__float2bfloat16(o[d0][r]*rli[r]);}
    asm volatile("s_waitcnt lgkmcnt(0)":::"memory");
    #pragma unroll
    for(int i=0;i<4;++i){const int row=i*8+(lane>>3),ch=lane&7; const u32x4 v=*(const u32x4*)(stg+row*64+ch*8); ATTN_STORE16(Ow+(long)row*DMO+ch*8,v);} }
  asm volatile("s_waitcnt lgkmcnt(0)\n\ts_barrier":::"memory");
  #undef DMA_K
  #undef DMA_V
  #undef CMASK
  #undef START
  #undef RESC
  #undef ROT
  #undef KBIAS
}
constexpr int ATTN_LDS_BYTES=LDS_BYTES;
struct AttnTensors { const bf16* Q; const bf16* K; const bf16* V; bf16* O; const float* cum; };
struct AttnUnit { int bh; int qb; };
struct StaticOrder {
  int vcu;
  __device__ __forceinline__ explicit StaticOrder(int grid,int block):vcu((block%8)*(grid/8)+block/8){}
  __device__ __forceinline__ bool next(int i,AttnUnit&u)const{ if(i>=2)return false; const int s=vcu&7; u.bh=vcu>>3; u.qb=(i==0)?15-s:s; return true; }
  __device__ __forceinline__ void a_ready(const AttnUnit&)const{}
  __device__ __forceinline__ void done(const AttnUnit&)const{}
};
template<class Sched,int THRL=8> __device__ __forceinline__ void attn_phase(char*lds,const AttnTensors&T,const Sched&S){
  AttnUnit u;
  for(int i=0;S.next(i,u);++i){ S.a_ready(u); attn_unit<THRL>(u.bh/NHEAD,u.bh%NHEAD,u.qb,T.Q,T.K,T.V,T.O,T.cum+(long)u.bh*SEQ,lds); S.done(u); }
}
#undef SBAR
#undef WAIT_BAR
}
#define LAS __attribute__((address_space(3)))
#define RLX_AGENT __ATOMIC_RELAXED, __HIP_MEMORY_SCOPE_AGENT
#define VM_WAIT() asm volatile("s_waitcnt vmcnt(0)" ::: "memory")
__device__ __forceinline__ unsigned long long rt() { return __builtin_amdgcn_s_memrealtime(); }
#define XB_TMO      128
#define XB_XCNT(j)  (256  + 64 * (j))
#define XB_XSUB(j)  (1280 + 64 * (j))
#define XB_XGEN(j)  (2304 + 64 * (j))
#define XB_TOP      3328
#define XB_TOPGEN   3392
#define XCD_BAR_WORDS 3456
#define XB_SPIN_CAP (1u << 18)

__device__ __forceinline__ unsigned xb_ld(unsigned* p)              { return __hip_atomic_load(p, __ATOMIC_RELAXED, __HIP_MEMORY_SCOPE_AGENT); }
__device__ __forceinline__ unsigned xb_add(unsigned* p, unsigned v) { return __hip_atomic_fetch_add(p, v, __ATOMIC_RELAXED, __HIP_MEMORY_SCOPE_AGENT); }
__device__ __forceinline__ unsigned xb_xcc_id() { return (unsigned)__builtin_amdgcn_s_getreg((3 << 11) | 20) & 0xFu; }
#define XB_SPIN(cond, bar) do { unsigned _sp = 0; while (cond) { __builtin_amdgcn_s_sleep(1); \
    if ((++_sp & 255u) == 0u) { if (xb_ld(&(bar)[XB_TMO])) break; if (_sp > XB_SPIN_CAP) { atomicAdd(&(bar)[XB_TMO], 1u); break; } } } } while (0)

struct XcdBarrier {
    unsigned* bar; unsigned x;
    volatile LAS unsigned* st;
};

__device__ __forceinline__ XcdBarrier xcd_barrier_post(unsigned* bar, volatile LAS unsigned* st) {
    XcdBarrier b; b.bar = bar; b.x = xb_xcc_id(); b.st = st;
    if (threadIdx.x == 0) (void)xb_add(&bar[XB_XCNT(b.x)], 1u);
    return b;
}
__device__ __forceinline__ void xcd_barrier_complete(unsigned* bar, unsigned x, unsigned& nloc, unsigned& nx) {
    const unsigned G = gridDim.x * gridDim.y * gridDim.z;
    unsigned sum, cnt, mine, sp = 0u;
    for (;;) {
        sum = 0u; cnt = 0u; mine = 0u;
#pragma unroll
        for (unsigned j = 0; j < 16; ++j) { const unsigned c = xb_ld(&bar[XB_XCNT(j)]); sum += c; cnt += (c > 0u) ? 1u : 0u; mine = (j == x) ? c : mine; }
        if (sum == G) break;
        __builtin_amdgcn_s_sleep(1);
        if ((++sp & 255u) == 0u) { if (xb_ld(&bar[XB_TMO])) break; if (sp > XB_SPIN_CAP) { atomicAdd(&bar[XB_TMO], 1u); break; } }
    }
    nloc = mine > 0u ? mine : 1u; nx = cnt > 0u ? cnt : 1u;
}

__device__ __forceinline__ void xcd_barrier(const XcdBarrier& b) {
    asm volatile("s_waitcnt vmcnt(0)" ::: "memory");
    __syncthreads();
    if (threadIdx.x == 0) {
        unsigned* bar = b.bar;
        __builtin_amdgcn_s_waitcnt(0);
        unsigned nloc = b.st[0], nx = b.st[1];
        if (nloc == 0u) { xcd_barrier_complete(bar, b.x, nloc, nx); b.st[0] = nloc; b.st[1] = nx; }
        const unsigned old = xb_add(&bar[XB_XSUB(b.x)], 1u);
        const unsigned gen = old / nloc;
        if (old + 1u == (gen + 1u) * nloc) {
            __builtin_amdgcn_fence(__ATOMIC_RELEASE, "agent");
            asm volatile("s_waitcnt vmcnt(0)" ::: "memory");
            const unsigned og = xb_add(&bar[XB_TOP], 1u);
            const unsigned tg = og / nx;
            if (og + 1u == (tg + 1u) * nx) xb_add(&bar[XB_TOPGEN], 1u);
            else XB_SPIN(xb_ld(&bar[XB_TOPGEN]) == tg, bar);
            __builtin_amdgcn_fence(__ATOMIC_ACQUIRE, "agent");
            xb_add(&bar[XB_XGEN(b.x)], 1u);
            asm volatile("s_waitcnt vmcnt(0)" ::: "memory");
        } else {
            XB_SPIN(xb_ld(&bar[XB_XGEN(b.x)]) == gen, bar);
            __builtin_amdgcn_fence(__ATOMIC_ACQUIRE, "agent");
            asm volatile("s_waitcnt vmcnt(0)" ::: "memory");
        }
    }
    __syncthreads();
}
namespace cg = cooperative_groups;
#ifndef PH_PRO
#define PH_PRO 1
#endif
#ifndef PH_NORM
#define PH_NORM 1
#endif
#ifndef PH_GIN
#define PH_GIN 1
#endif
#ifndef PH_POOL
#define PH_POOL 1
#endif
#ifndef PH_CONV
#define PH_CONV 1
#endif
#ifndef PH_RKV
#define PH_RKV 1
#endif
#ifndef PH_ATT
#define PH_ATT 1
#endif
#ifndef PH_RET
#define PH_RET 1
#endif
#ifndef PH_GOUT
#define PH_GOUT 1
#endif
#ifndef PH_GUP
#define PH_GUP 1
#endif
#ifndef PH_GDN
#define PH_GDN 1
#endif
#ifndef REP_GIN
#define REP_GIN 1
#endif
#ifndef REP_GUP
#define REP_GUP 1
#endif
#ifndef REP_RKV
#define REP_RKV 1
#endif
#ifndef REP_GRES
#define REP_GRES 1
#endif
#ifndef REP_NORM
#define REP_NORM 1
#endif
#ifndef REP_C1
#define REP_C1 1
#endif
#ifndef REP_ATT
#define REP_ATT 1
#endif
#ifndef REP_RET
#define REP_RET 1
#endif
typedef unsigned short bf16;
typedef unsigned v4u __attribute__((ext_vector_type(4)));
typedef unsigned v2u __attribute__((ext_vector_type(2)));
typedef float f32x4 __attribute__((ext_vector_type(4)));
typedef float f32x16 __attribute__((ext_vector_type(16)));
typedef short bf16x8 __attribute__((ext_vector_type(8)));

constexpr int NWAVES = 8, NTHR = 512;
constexpr int BATCH = 8, SEQ = 4096, DMODEL = 1024, MROWS = BATCH * SEQ, DEPTH = 4;
constexpr int NU = 2560, NIN = 2564, DFF = 2816, NH2 = 5632, MODW = 6144;
constexpr float EPS = 1e-6f, LOG2E = 1.4426950408889634f;
constexpr int LDS_BYTES = 147456;

constexpr size_t MiB = 1u << 20;
constexpr size_t WS_MOD = 1 * MiB, WS_CUM = 2 * MiB, WS_FF = 3 * MiB, WS_W = 4 * MiB;
constexpr size_t WOFF_IN = 0, WOFF_OUT = (size_t)NU * 1024, WOFF_13 = WOFF_OUT + 1024 * 1024, WOFF_2 = WOFF_13 + (size_t)NH2 * 1024, W_LAYER = WOFF_2 + (size_t)1024 * DFF;
constexpr size_t WS_H = 98 * MiB, WS_U = 162 * MiB, WS_MIX = 322 * MiB, WS_HID = 162 * MiB, WS_KV = 386 * MiB, WS_VT = 402 * MiB, WS_END = 418 * MiB;
static_assert(WS_W + DEPTH * W_LAYER * 2 <= WS_H, "weights fit");
static_assert(WS_HID + (size_t)MROWS * DFF * 2 <= WS_KV, "hid overlay fits");

#define LDS_WAIT() asm volatile("s_waitcnt lgkmcnt(0)" ::: "memory")
__device__ __forceinline__ unsigned f2bf(float f) { unsigned u = __builtin_bit_cast(unsigned, f); return (u + 0x7fffu + ((u >> 16) & 1u)) >> 16; }
__device__ __forceinline__ unsigned pk2(float lo, float hi) { return f2bf(lo) | (f2bf(hi) << 16); }
__device__ __forceinline__ float bf2f(unsigned b) { return __builtin_bit_cast(float, b << 16); }
__device__ __forceinline__ float bfe(const v4u& v, int e) { return bf2f((v[e >> 1] >> (16 * (e & 1))) & 0xffffu); }
__device__ __forceinline__ float bfe2(const v2u& v, int e) { return bf2f((v[e >> 1] >> (16 * (e & 1))) & 0xffffu); }
template <int CTRL> __device__ __forceinline__ float dppf(float v) { return __builtin_bit_cast(float, __builtin_amdgcn_update_dpp(0, __builtin_bit_cast(int, v), CTRL, 0xF, 0xF, false)); }
__device__ __forceinline__ float wave_sum(float v) {
    v += dppf<0xB1>(v); v += dppf<0x4E>(v); v += dppf<0x141>(v); v += dppf<0x140>(v);
    const int iv = __builtin_bit_cast(int, v);
    return (__builtin_bit_cast(float, __builtin_amdgcn_readlane(iv, 0)) + __builtin_bit_cast(float, __builtin_amdgcn_readlane(iv, 16))) +
           (__builtin_bit_cast(float, __builtin_amdgcn_readlane(iv, 32)) + __builtin_bit_cast(float, __builtin_amdgcn_readlane(iv, 48)));
}
__device__ __forceinline__ float siluf(float v) { return v * __builtin_amdgcn_rcpf(1.0f + __builtin_amdgcn_exp2f(-LOG2E * v)); }
__device__ __forceinline__ int crow(int r, int hi) { return (r & 3) + 8 * (r >> 2) + 4 * hi; }

__device__ __forceinline__ void transpose_item(const float* W, int ld, int k0, int scol0, bf16* WT, int Kd, int drow0, LAS float* scr, int lane) {
#pragma unroll 8
    for (int i = 0; i < 32; ++i) { const int kk = 2 * i + (lane >> 5); scr[kk * 33 + (lane & 31)] = W[(size_t)(k0 + kk) * ld + scol0 + (lane & 31)]; }
    LDS_WAIT(); asm volatile("" ::: "memory");
    const int c = lane & 7;
#pragma unroll
    for (int j = 0; j < 4; ++j) { const int n = (lane >> 3) + 8 * j; const LAS float* s = scr + (8 * c) * 33 + n;
        v4u o; o.x = pk2(s[0 * 33], s[1 * 33]); o.y = pk2(s[2 * 33], s[3 * 33]); o.z = pk2(s[4 * 33], s[5 * 33]); o.w = pk2(s[6 * 33], s[7 * 33]);
        *(v4u*)(WT + (size_t)(drow0 + n) * Kd + k0 + 8 * c) = o; }
    LDS_WAIT(); asm volatile("" ::: "memory");
}

template <bool FF>
__device__ __forceinline__ void norm_phase(LAS unsigned char* lds, const float* xin, const float* g, const float* msc, const float* msh, bf16* hout, const float* wfcols, float* ffout,
                                           int bx, int G, int tid, int lane, int wave) {
    LAS f32x4* gs4 = (LAS f32x4*)lds; LAS f32x4* sh4 = (LAS f32x4*)(lds + 4096); LAS f32x4* wf4 = (LAS f32x4*)(lds + 8192);
    for (int rb = bx; rb < MROWS / 128; rb += G) {
        const int b = rb / (SEQ / 128);
        if (tid < 256) { const f32x4 gv = ((const f32x4*)g)[tid], scv = ((const f32x4*)(msc + (size_t)b * MODW))[tid]; gs4[tid] = gv * (1.0f + scv); sh4[tid] = ((const f32x4*)(msh + (size_t)b * MODW))[tid]; }
        if (FF) for (int k = tid; k < 1024; k += NTHR) wf4[k] = *(const f32x4*)(wfcols + (size_t)k * NIN);
        __syncthreads();
        f32x4 nv[4];
        { const f32x4* xr0 = (const f32x4*)(xin + (size_t)(rb * 128 + wave * 16) * 1024) + lane;
#pragma unroll
          for (int j = 0; j < 4; ++j) nv[j] = xr0[64 * j]; }
        for (int i = 0; i < 16; ++i) {
            const int row = rb * 128 + wave * 16 + i;
            f32x4 v[4]; float ss = 0.f;
#pragma unroll
            for (int j = 0; j < 4; ++j) { v[j] = nv[j]; ss += (v[j].x * v[j].x + v[j].y * v[j].y) + (v[j].z * v[j].z + v[j].w * v[j].w); }
            if (i < 15) { const f32x4* xr = (const f32x4*)(xin + (size_t)(row + 1) * 1024) + lane;
#pragma unroll
                for (int j = 0; j < 4; ++j) nv[j] = xr[64 * j]; }
            ss = wave_sum(ss);
            const float rstd = 1.0f / sqrtf(ss * (1.0f / 1024.0f) + EPS);
            float f0 = 0.f, f1 = 0.f, f2 = 0.f, f3 = 0.f;
            unsigned long long* o8 = (unsigned long long*)(hout + (size_t)row * 1024) + lane;
#pragma unroll
            for (int j = 0; j < 4; ++j) {
                const f32x4 hv = v[j] * rstd * gs4[lane + 64 * j] + sh4[lane + 64 * j];
                o8[64 * j] = (unsigned long long)pk2(hv.x, hv.y) | ((unsigned long long)pk2(hv.z, hv.w) << 32);
                if (FF) { const int k = 4 * lane + 256 * j; const f32x4 w0 = wf4[k], w1 = wf4[k + 1], w2 = wf4[k + 2], w3 = wf4[k + 3];
                    f0 += hv.x * w0.x + hv.y * w1.x + hv.z * w2.x + hv.w * w3.x; f1 += hv.x * w0.y + hv.y * w1.y + hv.z * w2.y + hv.w * w3.y;
                    f2 += hv.x * w0.z + hv.y * w1.z + hv.z * w2.z + hv.w * w3.z; f3 += hv.x * w0.w + hv.y * w1.w + hv.z * w2.w + hv.w * w3.w; }
            }
            if (FF) { f0 = wave_sum(f0); f1 = wave_sum(f1); f2 = wave_sum(f2); f3 = wave_sum(f3); if (lane == 0) *(f32x4*)(ffout + (size_t)row * 4) = (f32x4){f0, f1, f2, f3}; }
        }
        __syncthreads();
    }
}

__device__ __forceinline__ void cum_scan(LAS unsigned char* lds, const float* ff, const float* fb, float* cumL, int bh, int tid, int lane, int wave) {
    const int b = bh >> 2, h = bh & 3; const float fbh = fb[h];
    float v[8]; float run = 0.f;
#pragma unroll
    for (int i = 0; i < 8; ++i) { const int s = tid * 8 + i; const float z = ff[((size_t)b * SEQ + s) * 4 + h] + fbh;
        const float ls = fminf(z, 0.f) - log1pf(expf(-fabsf(z))); run += ls * LOG2E; v[i] = run; }
    float incl = run;
#pragma unroll
    for (int o = 1; o < 64; o <<= 1) { const float t = __shfl_up(incl, o); if (lane >= o) incl += t; }
    LAS float* wt = (LAS float*)lds;
    if (lane == 63) wt[wave] = incl;
    __syncthreads();
    float off = incl - run;
    for (int ww = 0; ww < wave; ++ww) off += wt[ww];
    float* op = cumL + (size_t)bh * SEQ + tid * 8;
    *(f32x4*)op = (f32x4){v[0] + off, v[1] + off, v[2] + off, v[3] + off}; *(f32x4*)(op + 4) = (f32x4){v[4] + off, v[5] + off, v[6] + off, v[7] + off};
    __syncthreads();
}

template <int W>
__device__ __forceinline__ void pool_body(const bf16* yb, bf16* ob, int sfirst) {
    float ring[W];
#pragma unroll
    for (int j = 0; j < W - 1; ++j) { const int s = sfirst - (W - 1) + j; ring[j] = (s >= 0) ? bf2f(yb[(long)(j - (W - 1)) * NU]) : 0.f; }
    ring[W - 1] = 0.f;
#pragma unroll
    for (int t = 0; t < 64; ++t) {
        const float v = bf2f(yb[(long)t * NU]);
        ring[(t + W - 1) % W] = v;
        float sum = ring[0];
#pragma unroll
        for (int j = 1; j < W; ++j) sum += ring[j];
        const int s = sfirst + t;
        const float inv = (s + 1 < W) ? 1.0f / (float)(s + 1) : 1.0f / (float)W;
        ob[(long)t * 1024] = (bf16)f2bf(sum * inv - v);
    }
}
__device__ __forceinline__ void pool_unit(const bf16* U, bf16* MIX, int u, int tid) {
    const int b = u >> 5, s0 = (u & 31) * 128 + 64 * (tid >> 8), ch = tid & 255;
    const int gi = __builtin_amdgcn_readfirstlane((tid >> 6) & 3);
    const bf16* yb = U + ((size_t)b * SEQ + s0) * NU + 768 + ch;
    bf16* ob = MIX + ((size_t)b * SEQ + s0) * 1024 + 256 + ch;
    if (gi == 0) pool_body<2>(yb, ob, s0); else if (gi == 1) pool_body<4>(yb, ob, s0); else if (gi == 2) pool_body<8>(yb, ob, s0); else pool_body<16>(yb, ob, s0);
}
__device__ __forceinline__ void poolfold_item(const float* Win, const float* pw, const float* psc, int k0, int n0, bf16* WT, LAS float* scr, int lane) {
    const int gi = (n0 - 768) >> 6, d = ((n0 - 768) & 63) + (lane & 31);
    float pc[64];
    { const float sc = psc[gi * 64 + d];
#pragma unroll
      for (int c = 0; c < 64; ++c) pc[c] = pw[(gi * 64 + c) * 64 + d] * sc; }
    for (int i = 0; i < 32; ++i) { const int kk = 2 * i + (lane >> 5);
        const f32x4* wr = (const f32x4*)(Win + (size_t)(k0 + kk) * NIN + 772 + 64 * gi);
        float acc = 0.f;
#pragma unroll
        for (int c4 = 0; c4 < 16; ++c4) { const f32x4 wv = wr[c4]; acc += (wv.x * pc[4 * c4] + wv.y * pc[4 * c4 + 1]) + (wv.z * pc[4 * c4 + 2] + wv.w * pc[4 * c4 + 3]); }
        scr[kk * 33 + (lane & 31)] = acc; }
    LDS_WAIT(); asm volatile("" ::: "memory");
    const int c = lane & 7;
#pragma unroll
    for (int j = 0; j < 4; ++j) { const int n = (lane >> 3) + 8 * j; const LAS float* sp = scr + (8 * c) * 33 + n;
        v4u o; o.x = pk2(sp[0 * 33], sp[1 * 33]); o.y = pk2(sp[2 * 33], sp[3 * 33]); o.z = pk2(sp[4 * 33], sp[5 * 33]); o.w = pk2(sp[6 * 33], sp[7 * 33]);
        *(v4u*)(WT + (size_t)(n0 + n) * 1024 + k0 + 8 * c) = o; }
    LDS_WAIT(); asm volatile("" ::: "memory");
}

__device__ __forceinline__ void conv_unit(LAS unsigned char* lds, const bf16* U, const float* cw, const float* cb, const float* lng, const float* lnb, bf16* MIX, int u, int tid, int lane, int wave) {
    const int b = u >> 6, s0 = (u & 63) * 64;
    LAS float* hg = (LAS float*)lds;
    for (int task = tid; task < 94 * 32; task += NTHR) {
        const int tt = task >> 5, c8 = task & 31, s = s0 - 30 + tt;
        f32x4 h0 = (f32x4){0.f, 0.f, 0.f, 0.f}, h1 = h0;
        if (s >= 0) { const bf16* ur = U + ((size_t)b * SEQ + s) * NU + 2048 + 8 * c8; const v4u av = *(const v4u*)ur, gv = *(const v4u*)(ur + 256);
#pragma unroll
            for (int e = 0; e < 4; ++e) { h0[e] = bfe(av, e) * __builtin_amdgcn_rcpf(1.0f + __builtin_amdgcn_exp2f(-LOG2E * bfe(gv, e)));
                                          h1[e] = bfe(av, e + 4) * __builtin_amdgcn_rcpf(1.0f + __builtin_amdgcn_exp2f(-LOG2E * bfe(gv, e + 4))); } }
        *(LAS f32x4*)(hg + tt * 256 + 8 * c8) = h0; *(LAS f32x4*)(hg + tt * 256 + 8 * c8 + 4) = h1;
    }
    __syncthreads();
    {
        const int ch = tid & 255, half = tid >> 8;
        float w[31], acc[32];
#pragma unroll
        for (int j = 0; j < 31; ++j) w[j] = cw[j * 256 + ch];
        const float bias = cb[ch];
#pragma unroll
        for (int o = 0; o < 32; ++o) acc[o] = bias;
        const LAS float* hp = hg + (32 * half) * 256 + ch;
#pragma unroll
        for (int j = 0; j < 62; ++j) { const float v = hp[j * 256];
#pragma unroll
            for (int o = 0; o < 32; ++o) if (j - o >= 0 && j - o <= 30) acc[o] += v * w[j - o]; }
        __syncthreads();
#pragma unroll
        for (int o = 0; o < 32; ++o) hg[(32 * half + o) * 256 + ch] = acc[o];
    }
    __syncthreads();
    for (int i = 0; i < 8; ++i) {
        const int tok = wave * 8 + i;
        const f32x4 y = *(const LAS f32x4*)(hg + tok * 256 + 4 * lane);
        const float mean = wave_sum((y.x + y.y) + (y.z + y.w)) * (1.0f / 256.0f);
        const f32x4 d = y - mean;
        const float var = wave_sum((d.x * d.x + d.y * d.y) + (d.z * d.z + d.w * d.w)) * (1.0f / 256.0f);
        const float rstd = 1.0f / sqrtf(var + EPS);
        const f32x4 z = d * rstd * *(const f32x4*)(lng + 4 * lane) + *(const f32x4*)(lnb + 4 * lane);
        v2u o; o.x = pk2(siluf(z.x), siluf(z.y)); o.y = pk2(siluf(z.z), siluf(z.w));
        *(v2u*)(MIX + ((size_t)b * SEQ + s0 + tok) * 1024 + 768 + 4 * lane) = o;
    }
    __syncthreads();
}

constexpr int TJ = 136, TS = 72;
__device__ __forceinline__ void retkv_unit(LAS unsigned char* lds, bf16* U, const int* positions, float* KV, bf16* VT, int u, int tid, int lane, int wave, bool wb) {
    const int b = u >> 7, n = (u >> 2) & 31, h = u & 3;
    LAS bf16* Kt = (LAS bf16*)lds;
    LAS bf16* Vt = (LAS bf16*)(lds + 64 * TJ * 2);
    const float lg = log2f(1.0f - exp2f(-5.0f - (float)h));
    {
        const int j = tid >> 2, p = tid & 3;
        const size_t row = (size_t)b * SEQ + n * 128 + j;
        bf16* ur = U + row * NU;
        const float pos = (float)positions[row];
        const float gq = exp2f(lg * (float)j), gk = 0.125f * exp2f(-lg * (float)j);
        const v4u q1 = *(const v4u*)(ur + 1024 + 64 * h + 8 * p), q2 = *(const v4u*)(ur + 1024 + 64 * h + 32 + 8 * p);
        const v4u k1 = *(const v4u*)(ur + 1280 + 64 * h + 8 * p), k2 = *(const v4u*)(ur + 1280 + 64 * h + 32 + 8 * p);
        const v4u v1 = *(const v4u*)(ur + 1536 + 64 * h + 8 * p), v2 = *(const v4u*)(ur + 1536 + 64 * h + 32 + 8 * p);
        unsigned qa[8], qb[8], ka[8], kb[8];
#pragma unroll
        for (int ii = 0; ii < 8; ++ii) {
            const int i = 8 * p + ii;
            const float inv = exp2f(-(float)i * (13.287712379549449f / 32.0f));
            const float ang = pos * inv;
            float rev = ang * 0.15915494309189535f; rev -= floorf(rev);
            const float sn = __builtin_amdgcn_sinf(rev), cs = __builtin_amdgcn_cosf(rev);
            const float a = bfe(q1, ii), c = bfe(q2, ii), ak = bfe(k1, ii), ck = bfe(k2, ii);
            qa[ii] = f2bf((a * cs - c * sn) * gq); qb[ii] = f2bf((a * sn + c * cs) * gq);
            ka[ii] = f2bf((ak * cs - ck * sn) * gk); kb[ii] = f2bf((ak * sn + ck * cs) * gk);
            Kt[(8 * p + ii) * TJ + j] = (bf16)ka[ii]; Kt[(32 + 8 * p + ii) * TJ + j] = (bf16)kb[ii];
            Vt[(8 * p + ii) * TJ + j] = (bf16)((v1[ii >> 1] >> (16 * (ii & 1))) & 0xffffu); Vt[(32 + 8 * p + ii) * TJ + j] = (bf16)((v2[ii >> 1] >> (16 * (ii & 1))) & 0xffffu);
        }
        if (wb) {
        *(v4u*)(ur + 1024 + 64 * h + 8 * p) = (v4u){qa[0] | (qa[1] << 16), qa[2] | (qa[3] << 16), qa[4] | (qa[5] << 16), qa[6] | (qa[7] << 16)};
        *(v4u*)(ur + 1024 + 64 * h + 32 + 8 * p) = (v4u){qb[0] | (qb[1] << 16), qb[2] | (qb[3] << 16), qb[4] | (qb[5] << 16), qb[6] | (qb[7] << 16)};
        *(v4u*)(ur + 1280 + 64 * h + 8 * p) = (v4u){ka[0] | (ka[1] << 16), ka[2] | (ka[3] << 16), ka[4] | (ka[5] << 16), ka[6] | (ka[7] << 16)};
        *(v4u*)(ur + 1280 + 64 * h + 32 + 8 * p) = (v4u){kb[0] | (kb[1] << 16), kb[2] | (kb[3] << 16), kb[4] | (kb[5] << 16), kb[6] | (kb[7] << 16)};
        }
    }
    __syncthreads();
    if (wave < 4) {
        const int db = wave >> 1, eb = wave & 1, r32 = lane & 31, hi = lane >> 5;
        f32x16 acc;
#pragma unroll
        for (int r = 0; r < 16; ++r) acc[r] = 0.f;
#pragma unroll
        for (int ks = 0; ks < 8; ++ks) {
            const bf16x8 A = *(const LAS bf16x8*)(Kt + (32 * db + r32) * TJ + 16 * ks + 8 * hi);
            const bf16x8 B = *(const LAS bf16x8*)(Vt + (32 * eb + r32) * TJ + 16 * ks + 8 * hi);
            acc = __builtin_amdgcn_mfma_f32_32x32x16_bf16(A, B, acc, 0, 0, 0);
        }
        const float g127 = exp2f(lg * 127.0f);
        float* kvp = KV + (size_t)u * 4096;
#pragma unroll
        for (int r = 0; r < 16; ++r) kvp[(32 * db + crow(r, hi)) * 64 + 32 * eb + r32] = acc[r] * g127;
    }
    for (int p = tid; p < 1024; p += NTHR) { const int e = p >> 4, jc = p & 15; *(v4u*)(VT + (size_t)u * 8192 + e * 128 + 8 * jc) = *(const LAS v4u*)(Vt + e * TJ + 8 * jc); }
    __syncthreads();
}

__device__ __forceinline__ void retout_seg(LAS unsigned char* lds, const bf16* U, const float* KV, const bf16* VT, const float* gn, bf16* MIX, int wg, int tid, int lane, int wave) {
    const int b = wg >> 5, h = (wg >> 3) & 3, seg = wg & 7, n0 = 4 * seg;
    const float lg = log2f(1.0f - exp2f(-5.0f - (float)h));
    {
        const float decay = exp2f(lg * 128.0f), gam = exp2f(lg);
        const int d = tid >> 3, e0 = (tid & 7) * 8;
        f32x4 s0 = (f32x4){0.f, 0.f, 0.f, 0.f}, s1 = s0;
        const float* kvb = KV + ((size_t)(b * 32) * 4 + h) * 4096 + d * 64 + e0;
        for (int m = 0; m < n0; m += 4) { f32x4 t[4][2];
#pragma unroll
            for (int mm = 0; mm < 4; ++mm) { const f32x4* p = (const f32x4*)(kvb + (size_t)(m + mm) * 4 * 4096); t[mm][0] = p[0]; t[mm][1] = p[1]; }
#pragma unroll
            for (int mm = 0; mm < 4; ++mm) { s0 = s0 * decay + t[mm][0]; s1 = s1 * decay + t[mm][1]; } }
        f32x4 t[3][2];
#pragma unroll
        for (int c = 0; c < 3; ++c) { const f32x4* p = (const f32x4*)(kvb + (size_t)(n0 + c) * 4 * 4096); t[c][0] = p[0]; t[c][1] = p[1]; }
#pragma unroll
        for (int c = 0; c < 4; ++c) {
            LAS bf16* St = (LAS bf16*)(lds + c * (64 * TS * 2));
#pragma unroll
            for (int q = 0; q < 4; ++q) { St[(e0 + q) * TS + d] = (bf16)f2bf(s0[q] * gam); St[(e0 + 4 + q) * TS + d] = (bf16)f2bf(s1[q] * gam); }
            if (c < 3) { s0 = s0 * decay + t[c][0]; s1 = s1 * decay + t[c][1]; }
        }
    }
    __syncthreads();
    const int half = wave >> 2, ib = wave & 3, r32 = lane & 31, hi = lane >> 5;
#pragma unroll 1
    for (int pr = 0; pr < 2; ++pr) {
        const int n = n0 + 2 * pr + half, u = (b * 32 + n) * 4 + h;
        const LAS bf16* St = (const LAS bf16*)(lds + (2 * pr + half) * (64 * TS * 2));
        const size_t row0 = (size_t)b * SEQ + n * 128;
        const bf16* qp = U + (row0 + 32 * ib + r32) * NU + 1024 + 64 * h + 8 * hi;
        bf16x8 qf[4];
#pragma unroll
        for (int d0 = 0; d0 < 4; ++d0) qf[d0] = *(const bf16x8*)(qp + 16 * d0);
        f32x16 o[2];
#pragma unroll
        for (int r = 0; r < 16; ++r) { o[0][r] = 0.f; o[1][r] = 0.f; }
#pragma unroll
        for (int d0 = 0; d0 < 4; ++d0)
#pragma unroll
            for (int eb = 0; eb < 2; ++eb) { const bf16x8 A = *(const LAS bf16x8*)(St + (32 * eb + r32) * TS + 16 * d0 + 8 * hi); o[eb] = __builtin_amdgcn_mfma_f32_32x32x16_bf16(A, qf[d0], o[eb], 0, 0, 0); }
        const bf16* vtb = VT + (size_t)u * 8192;
        for (int jb = 0; jb <= ib; ++jb) {
            const bf16* kp = U + (row0 + 32 * jb + r32) * NU + 1280 + 64 * h + 8 * hi;
            f32x16 st;
#pragma unroll
            for (int r = 0; r < 16; ++r) st[r] = 0.f;
#pragma unroll
            for (int d0 = 0; d0 < 4; ++d0) st = __builtin_amdgcn_mfma_f32_32x32x16_bf16(*(const bf16x8*)(kp + 16 * d0), qf[d0], st, 0, 0, 0);
            if (jb == ib) {
#pragma unroll
                for (int r = 0; r < 16; ++r) if (crow(r, hi) > r32) st[r] = 0.f;
            }
#pragma unroll
            for (int k = 0; k < 2; ++k) {
                v4u pbw; pbw.x = pk2(st[8 * k], st[8 * k + 1]); pbw.y = pk2(st[8 * k + 2], st[8 * k + 3]); pbw.z = pk2(st[8 * k + 4], st[8 * k + 5]); pbw.w = pk2(st[8 * k + 6], st[8 * k + 7]);
                const bf16x8 pb = __builtin_bit_cast(bf16x8, pbw);
#pragma unroll
                for (int eb = 0; eb < 2; ++eb) {
                    const bf16* vp = vtb + (32 * eb + r32) * 128 + 32 * jb + 16 * k + 4 * hi;
                    const v2u lo = *(const v2u*)vp, hh = *(const v2u*)(vp + 8);
                    const bf16x8 A = __builtin_bit_cast(bf16x8, (v4u){lo.x, lo.y, hh.x, hh.y});
                    o[eb] = __builtin_amdgcn_mfma_f32_32x32x16_bf16(A, pb, o[eb], 0, 0, 0);
                }
            }
        }
        float sum = 0.f;
#pragma unroll
        for (int r = 0; r < 16; ++r) sum += o[0][r] + o[1][r];
        sum += __shfl_xor(sum, 32);
        const float mu = sum * (1.0f / 64.0f);
        float var = 0.f;
#pragma unroll
        for (int r = 0; r < 16; ++r) { const float d0 = o[0][r] - mu, d1 = o[1][r] - mu; var += d0 * d0 + d1 * d1; }
        var += __shfl_xor(var, 32);
        const float rstd = 1.0f / sqrtf(var * (1.0f / 64.0f) + EPS);
        const size_t tok = row0 + 32 * ib + r32;
        const bf16* gp = U + tok * NU + 1792 + 64 * h;
        bf16* op = MIX + tok * 1024 + 512 + 64 * h;
#pragma unroll
        for (int eb = 0; eb < 2; ++eb)
#pragma unroll
            for (int g4 = 0; g4 < 4; ++g4) {
                const int e = 32 * eb + 8 * g4 + 4 * hi;
                const v2u gw = *(const v2u*)(gp + e); const f32x4 gg = *(const f32x4*)(gn + 64 * h + e);
                float y[4];
#pragma unroll
                for (int c = 0; c < 4; ++c) y[c] = siluf(bfe2(gw, c)) * ((o[eb][4 * g4 + c] - mu) * rstd * gg[c]);
                v2u ov; ov.x = pk2(y[0], y[1]); ov.y = pk2(y[2], y[3]);
                *(v2u*)(op + e) = ov;
            }
    }
    __syncthreads();
}

struct Args { const void* in[21]; float* out; unsigned char* ws; };
__global__ void __launch_bounds__(NTHR, 2) fwd_kernel(Args a) {
    extern __shared__ __attribute__((aligned(16))) unsigned char lds_raw[];
    cg::grid_group grid = cg::this_grid();
    LAS unsigned char* lds = (LAS unsigned char*)lds_raw;
    int tid = threadIdx.x, lane = tid & 63, wave = __builtin_amdgcn_readfirstlane(tid >> 6);
    const int G = gridDim.x; int bx = blockIdx.x;
    int vcu = (G % 8 == 0) ? (bx % 8) * (G / 8) + bx / 8 : bx;
#define RELAUNDER() do { tid = threadIdx.x; asm volatile("" : "+v"(tid)); lane = tid & 63; wave = __builtin_amdgcn_readfirstlane(tid >> 6); bx = blockIdx.x; asm volatile("" : "+s"(bx)); vcu = (G % 8 == 0) ? (bx % 8) * (G / 8) + bx / 8 : bx; } while (0)
    const float* xin = (const float*)a.in[0]; const float* cin = (const float*)a.in[1]; const int* positions = (const int*)a.in[2];
    const float* ada_w = (const float*)a.in[3]; const float* ada_b = (const float*)a.in[4];
    const float* norm_mix_g = (const float*)a.in[5]; const float* norm_ffn_g = (const float*)a.in[6];
    const float* w_in = (const float*)a.in[7]; const float* fox_fb = (const float*)a.in[8];
    const float* pool_w = (const float*)a.in[9]; const float* pool_scale = (const float*)a.in[10]; const float* ret_gn_g = (const float*)a.in[11];
    const float* conv_w = (const float*)a.in[12]; const float* conv_b = (const float*)a.in[13]; const float* conv_ln_g = (const float*)a.in[14]; const float* conv_ln_b = (const float*)a.in[15];
    const float* w_out = (const float*)a.in[16]; const float* ffn_w1 = (const float*)a.in[17]; const float* ffn_w3 = (const float*)a.in[18]; const float* ffn_w2 = (const float*)a.in[19];
    const float* final_g = (const float*)a.in[20];
    float* out = a.out; unsigned char* ws = a.ws;
    float* mod = (float*)(ws + WS_MOD); float* cumL = (float*)(ws + WS_CUM); float* ffb = (float*)(ws + WS_FF);
    bf16* WB = (bf16*)(ws + WS_W); bf16* H = (bf16*)(ws + WS_H); bf16* U = (bf16*)(ws + WS_U); bf16* MIX = (bf16*)(ws + WS_MIX); bf16* HID = (bf16*)(ws + WS_HID);
    float* KV = (float*)(ws + WS_KV); bf16* VT = (bf16*)(ws + WS_VT);
    volatile LAS unsigned* MISC = (volatile LAS unsigned*)(lds + 131072 + 320);
    if (tid < 32) MISC[tid] = 0u;
    __syncthreads();
    const XcdBarrier xbar = xcd_barrier_post((unsigned*)ws, MISC + 8);
#define GRID_BAR() do { XcdBarrier xb_ = xbar; asm volatile("" : "+s"(xb_.bar), "+s"(xb_.x)); xcd_barrier(xb_); } while (0)

    if (PH_PRO) {
        LAS float* scr = (LAS float*)(lds + wave * 16384);
        const int gw = bx * NWAVES + wave, NGW = G * NWAVES;
        for (int it = gw; it < DEPTH * 6016; it += NGW) {
            const int l = it / 6016; int r = it - l * 6016;
            bf16* wl = WB + (size_t)l * W_LAYER;
            if (r < 1280) { const int kb = r / 80, n0 = 32 * (r % 80);
                if (n0 >= 768 && n0 < 1024) { poolfold_item(w_in + (size_t)l * 1024 * NIN, pool_w + (size_t)l * 4 * 4096, pool_scale + l * 256, 64 * kb, n0, wl + WOFF_IN, scr, lane); continue; }
                transpose_item(w_in + (size_t)l * 1024 * NIN, NIN, 64 * kb, n0 + (n0 >= 768 ? 4 : 0), wl + WOFF_IN, 1024, n0, scr, lane); continue; } r -= 1280;
            if (r < 512) { const int kb = r / 32, n0 = 32 * (r % 32); transpose_item(w_out + (size_t)l * 1024 * 1024, 1024, 64 * kb, n0, wl + WOFF_OUT, 1024, n0, scr, lane); continue; } r -= 512;
            if (r < 1408) { const int kb = r / 88, n0 = 32 * (r % 88); transpose_item(ffn_w1 + (size_t)l * 1024 * DFF, DFF, 64 * kb, n0, wl + WOFF_13, 1024, (n0 / 128) * 256 + (n0 % 128), scr, lane); continue; } r -= 1408;
            if (r < 1408) { const int kb = r / 88, n0 = 32 * (r % 88); transpose_item(ffn_w3 + (size_t)l * 1024 * DFF, DFF, 64 * kb, n0, wl + WOFF_13, 1024, (n0 / 128) * 256 + 128 + (n0 % 128), scr, lane); continue; } r -= 1408;
            { const int kb = r / 32, n0 = 32 * (r % 32); transpose_item(ffn_w2 + (size_t)l * DFF * 1024, 1024, 64 * kb, n0, wl + WOFF_2, DFF, n0, scr, lane); }
        }
    }
    __syncthreads();
    if (PH_PRO) {
        LAS float* cact = (LAS float*)lds;
        LAS float* part = (LAS float*)(lds + 32768);
        for (int i = tid; i < BATCH * 1024; i += NTHR) { const float v = cin[i]; cact[i] = v / (1.0f + expf(-v)); }
        __syncthreads();
        for (int ch = bx; ch < DEPTH * 96; ch += G) {
            const int l = ch / 96, n0 = (ch % 96) * 64;
            const float* wp = ada_w + ((size_t)l * 1024 + wave * 128) * MODW + n0 + lane;
            float acc[8];
#pragma unroll
            for (int b = 0; b < 8; ++b) acc[b] = 0.f;
#pragma unroll 4
            for (int k = 0; k < 128; k += 4) {
                const float w0 = wp[(size_t)k * MODW], w1 = wp[(size_t)(k + 1) * MODW], w2 = wp[(size_t)(k + 2) * MODW], w3 = wp[(size_t)(k + 3) * MODW];
#pragma unroll
                for (int b = 0; b < 8; ++b) { const f32x4 cv = *(const LAS f32x4*)(cact + b * 1024 + wave * 128 + k); acc[b] += (cv.x * w0 + cv.y * w1) + (cv.z * w2 + cv.w * w3); }
            }
#pragma unroll
            for (int b = 0; b < 8; ++b) part[(wave * 8 + b) * 64 + lane] = acc[b];
            __syncthreads();
            { float s = ada_b[(size_t)l * MODW + n0 + lane];
#pragma unroll
              for (int ww = 0; ww < 8; ++ww) s += part[(ww * 8 + wave) * 64 + lane];
              mod[((size_t)l * 8 + wave) * MODW + n0 + lane] = s; }
            __syncthreads();
        }
    }
    if (a.ws == nullptr) grid.sync();
    GRID_BAR(); RELAUNDER();

    for (int l = 0; l < DEPTH; ++l) {
        const float* modl = mod + (size_t)l * 8 * MODW;
        bf16* wl = WB + (size_t)l * W_LAYER;
        const float* xcur = (l == 0) ? xin : out;
        for (int rp = 0; rp < REP_NORM; ++rp) norm_phase<true>(lds, xcur, norm_mix_g + l * 1024, modl + 1024, modl, H, w_in + (size_t)l * 1024 * NIN + 768, ffb, bx, G, tid, lane, wave);
        GRID_BAR(); RELAUNDER();
        if (PH_GIN) {
            if (bx < 32) cum_scan(lds, ffb, fox_fb + l * 4, cumL, bx, tid, lane, wave);
            __syncthreads();
            pg8::Gemm g{H, wl + WOFF_IN, MROWS, NU, 1024}; pg8::StaticOrder S; S.init(MROWS, NU, G, bx);
            pg8::EpiU E{U, NU, attn_body::C2};
            for (int rp = 0; rp < REP_GIN; ++rp) pg8::gemm_phase<pg8::EpiU, pg8::StaticOrder, true, true>(lds, g, S, E);
        }
        GRID_BAR(); RELAUNDER();
        for (int rp = 0; rp < REP_C1; ++rp) for (int u = vcu; u < 256; u += G) pool_unit(U, MIX, u, tid);
        RELAUNDER();
        for (int rp = 0; rp < REP_C1; ++rp) for (int u = vcu; u < 512; u += G) conv_unit(lds, U, conv_w + (size_t)l * 31 * 256, conv_b + l * 256, conv_ln_g + l * 256, conv_ln_b + l * 256, MIX, u, tid, lane, wave);
        RELAUNDER();
        for (int rp = REP_RKV - 1; rp >= 0; --rp) for (int u = vcu; u < 1024; u += G) retkv_unit(lds, U, positions, KV, VT, u, tid, lane, wave, rp == 0);
        GRID_BAR(); RELAUNDER();
        for (int rp = 0; rp < REP_ATT; ++rp) {
            const attn_body::AttnTensors AT{(const attn_body::bf16*)U, (const attn_body::bf16*)(U + 256), (const attn_body::bf16*)(U + 512), (attn_body::bf16*)MIX, cumL};
            const attn_body::StaticOrder S(G, bx);
            attn_body::attn_phase<attn_body::StaticOrder>((char*)lds_raw, AT, S);
        }
        __syncthreads(); RELAUNDER();
        for (int rp = 0; rp < REP_RET; ++rp) for (int wg = vcu; wg < 256; wg += G) retout_seg(lds, U, KV, VT, ret_gn_g + l * 256, MIX, wg, tid, lane, wave);
        GRID_BAR(); RELAUNDER();
        if (PH_GOUT) {
            pg8::Gemm g{MIX, wl + WOFF_OUT, MROWS, 1024, 1024}; pg8::StaticOrder S; S.init(MROWS, 1024, G, bx);
            for (int rp = REP_GRES - 1; rp >= 0; --rp) { pg8::EpiRes E{xcur, out, modl + 2048, rp ? 0.f : 1.f};
            pg8::gemm_phase<pg8::EpiRes, pg8::StaticOrder, false, true>(lds, g, S, E); }
        }
        GRID_BAR(); RELAUNDER();
        for (int rp = 0; rp < REP_NORM; ++rp) norm_phase<false>(lds, out, norm_ffn_g + l * 1024, modl + 4096, modl + 3072, H, nullptr, nullptr, bx, G, tid, lane, wave);
        GRID_BAR(); RELAUNDER();
        if (PH_GUP) {
            pg8::Gemm g{H, wl + WOFF_13, MROWS, NH2, 1024}; pg8::StaticOrder S; S.init(MROWS, NH2, G, bx);
            pg8::EpiSwiGLU E{HID, DFF};
            for (int rp = 0; rp < REP_GUP; ++rp) pg8::gemm_phase<pg8::EpiSwiGLU, pg8::StaticOrder, true, true>(lds, g, S, E);
        }
        GRID_BAR(); RELAUNDER();
        if (PH_GDN) {
            pg8::Gemm g{HID, wl + WOFF_2, MROWS, 1024, DFF}; pg8::StaticOrder S; S.init(MROWS, 1024, G, bx);
            for (int rp = REP_GRES - 1; rp >= 0; --rp) { pg8::EpiRes E{out, out, modl + 5120, rp ? 0.f : 1.f};
            pg8::gemm_phase<pg8::EpiRes, pg8::StaticOrder, false, true>(lds, g, S, E); }
        }
        GRID_BAR(); RELAUNDER();
    }
    {
        const int gw = bx * NWAVES + wave, NGW = G * NWAVES;
        for (int row = gw; row < MROWS; row += NGW) {
            f32x4* xr = (f32x4*)(out + (size_t)row * 1024) + lane;
            f32x4 v[4]; float ss = 0.f;
#pragma unroll
            for (int j = 0; j < 4; ++j) { v[j] = xr[64 * j]; ss += (v[j].x * v[j].x + v[j].y * v[j].y) + (v[j].z * v[j].z + v[j].w * v[j].w); }
            ss = wave_sum(ss);
            const float rstd = 1.0f / sqrtf(ss * (1.0f / 1024.0f) + EPS);
#pragma unroll
            for (int j = 0; j < 4; ++j) xr[64 * j] = v[j] * rstd * ((const f32x4*)final_g)[lane + 64 * j];
        }
    }
}

extern "C" void kernel_launch(void* const* d_in, const int* in_sizes, int n_in, void* d_out, int out_size, void* d_ws, size_t ws_size, hipStream_t stream) {
    static int grid = 0;
    if (grid == 0) {
        if (n_in != 21 || out_size != MROWS * 1024 || ws_size < WS_END) { fprintf(stderr, "kernel_launch: unexpected shapes: n_in %d out %d ws %zu (need %zu)\n", n_in, out_size, ws_size, (size_t)WS_END); grid = -1; return; }
        int dev = 0, cus = 0, per_cu = 0;
        hipGetDevice(&dev); hipDeviceGetAttribute(&cus, hipDeviceAttributeMultiprocessorCount, dev);
        if (hipFuncSetAttribute((const void*)fwd_kernel, hipFuncAttributeMaxDynamicSharedMemorySize, LDS_BYTES) != hipSuccess) { fprintf(stderr, "kernel_launch: hipFuncSetAttribute failed\n"); grid = -1; return; }
        if (hipOccupancyMaxActiveBlocksPerMultiprocessor(&per_cu, (const void*)fwd_kernel, NTHR, LDS_BYTES) != hipSuccess || per_cu < 1) { fprintf(stderr, "kernel_launch: occupancy query says %d\n", per_cu); per_cu = 1; }
        (void)hipGetLastError();
        grid = cus;
        if (grid != 256) fprintf(stderr, "kernel_launch: %d CUs; the attention deal assumes 256\n", grid);
    }
    if (grid < 0) return;
    if (hipMemsetAsync(d_ws, 0, 65536, stream) != hipSuccess) { fprintf(stderr, "kernel_launch: hipMemsetAsync failed\n"); return; }
    Args a{};
    for (int i = 0; i < 21; ++i) a.in[i] = d_in[i];
    a.out = (float*)d_out; a.ws = (unsigned char*)d_ws;
    void* args[] = {&a};
    hipError_t e = hipLaunchCooperativeKernel((const void*)fwd_kernel, dim3(grid), dim3(NTHR), args, LDS_BYTES, stream);
    if (e != hipSuccess) fprintf(stderr, "kernel_launch: cooperative launch failed: %s (grid %d)\n", hipGetErrorString(e), grid);
}
```

```cpp
#include <hip/hip_runtime.h>
#include <hip/hip_cooperative_groups.h>
#include <cstdio>
#include <cstdint>
namespace pg8 {
#define PG8_LAS __attribute__((address_space(3)))
typedef unsigned short bf16_t;
typedef short bf16x8 __attribute__((ext_vector_type(8)));
typedef float f32x4 __attribute__((ext_vector_type(4)));
typedef unsigned u32x4 __attribute__((ext_vector_type(4)));
constexpr int BM = 256, BK = 64, HALF = 128, HTB = HALF * BK * 2  , STAGE_BYTES = 8 * HTB, NXCD = 8, WGM = 8;

__host__ __device__ __forceinline__ int lds_byte(int r, int c) { const int st = (r >> 4) * 2 + (c >> 5), rr = r & 15, cc = c & 31, ob = rr * 64 + cc * 2; return st * 1024 + (ob ^ (((ob >> 9) & 1) << 5)); }
__host__ __device__ __forceinline__ void stage_rc(int b, int& R, int& C) { const int st = b / 1024, sb = b % 1024, swz = sb ^ (((sb >> 9) & 1) << 5); R = (st >> 1) * 16 + swz / 64; C = (st & 1) * 32 + (swz % 64) / 2; }
__host__ __device__ __forceinline__ int perm32(int rho) { const int n = rho >> 4, i = rho & 15; return 8 * (i >> 2) + 4 * n + (i & 3); }

struct Unit { int pm, pn; };
struct Gemm { const bf16_t* A; const bf16_t* Bt; int M, N, K; };

struct StaticOrder {
    int nM, nN, nwg, G, c;
    __host__ __device__ void init(int M, int N, int G_, int c_) { nM = M / BM; nN = N / BM; nwg = nM * nN; G = G_; c = c_; }
    __host__ __device__ bool next(int i, Unit& u) const {
        const long L = (long)i * G + c; if (L >= nwg) return false;
        int wgid = (int)L; { const int q = nwg / NXCD, r = nwg % NXCD, xcd = wgid % NXCD, off = wgid / NXCD; wgid = (xcd < r ? xcd * (q + 1) : r * (q + 1) + (xcd - r) * q) + off; }
        const int nig = WGM * nN, gid = wgid / nig, fm = gid * WGM, gsz = (nM - fm) < WGM ? (nM - fm) : WGM;
        u.pm = fm + ((wgid % nig) % gsz); u.pn = (wgid % nig) / gsz; return true;
    }
    __device__ __forceinline__ void a_ready(const Unit&) const {}
    __device__ __forceinline__ void done(const Unit&) const {}
};

__device__ __forceinline__ unsigned cvt_pk_bf16(float lo, float hi) { unsigned r; asm volatile("v_cvt_pk_bf16_f32 %0, %1, %2" : "=v"(r) : "v"(lo), "v"(hi)); return r; }
typedef float f32x2 __attribute__((ext_vector_type(2)));
__device__ __forceinline__ float silu_f(float v) { return v * __builtin_amdgcn_rcpf(1.0f + __builtin_amdgcn_exp2f(-1.4426950408889634f * v)); }
struct EpiU {
    static constexpr bool PERM = true, AFTER_DRAIN = false;
    bf16_t* O; int ldc; float s0;
    __device__ __forceinline__ void operator()(const f32x4 (&acc)[2][2][4][2], const Unit& u, int wr, int wc, int fr, int fq) const {
        const int row0 = u.pm * BM + wr * 64 + fr, col0 = u.pn * BM + wc * 32 + 8 * fq;
        const float sc = (u.pn == 0) ? s0 : 1.f;
#pragma unroll
        for (int ai = 0; ai < 2; ++ai)
#pragma unroll
            for (int m = 0; m < 4; ++m) { bf16_t* rowp = O + (size_t)(row0 + ai * HALF + m * 16) * ldc + col0;
#pragma unroll
                for (int bj = 0; bj < 2; ++bj) { const f32x4 v0 = acc[ai][bj][m][0] * sc, v1 = acc[ai][bj][m][1] * sc;
                    u32x4 w; w.x = cvt_pk_bf16(v0[0], v0[1]); w.y = cvt_pk_bf16(v0[2], v0[3]); w.z = cvt_pk_bf16(v1[0], v1[1]); w.w = cvt_pk_bf16(v1[2], v1[3]);
                    *(u32x4*)(rowp + bj * HALF) = w; } }
    }
};
struct EpiRes {
    static constexpr bool PERM = true, AFTER_DRAIN = false;
    const float* base; float* out; const float* gate; float gscale;
    __device__ __forceinline__ void operator()(const f32x4 (&acc)[2][2][4][2], const Unit& u, int wr, int wc, int fr, int fq) const {
        const float* gp = gate + (size_t)(u.pm >> 4) * 6144;
        const int col0 = u.pn * BM + wc * 32 + 8 * fq;
        f32x4 gv[2][2];
#pragma unroll
        for (int bj = 0; bj < 2; ++bj)
#pragma unroll
            for (int n = 0; n < 2; ++n) gv[bj][n] = *(const f32x4*)(gp + col0 + bj * HALF + n * 4) * gscale;
#pragma unroll
        for (int ai = 0; ai < 2; ++ai) {
            f32x4 pre[4][2][2];
#pragma unroll
            for (int m = 0; m < 4; ++m) { const size_t off = (size_t)(u.pm * BM + ai * HALF + wr * 64 + m * 16 + fr) * 1024 + col0;
#pragma unroll
                for (int bj = 0; bj < 2; ++bj)
#pragma unroll
                    for (int n = 0; n < 2; ++n) pre[m][bj][n] = *(const f32x4*)(base + off + bj * HALF + n * 4); }
            asm volatile("" ::: "memory");
#pragma unroll
            for (int m = 0; m < 4; ++m) { const size_t off = (size_t)(u.pm * BM + ai * HALF + wr * 64 + m * 16 + fr) * 1024 + col0;
#pragma unroll
                for (int bj = 0; bj < 2; ++bj)
#pragma unroll
                    for (int n = 0; n < 2; ++n) *(f32x4*)(out + off + bj * HALF + n * 4) = pre[m][bj][n] + gv[bj][n] * acc[ai][bj][m][n]; }
            asm volatile("" ::: "memory");
        }
    }
};
struct EpiSwiGLU {
    static constexpr bool PERM = true, AFTER_DRAIN = false;
    bf16_t* O; int ldc;
    __device__ __forceinline__ void operator()(const f32x4 (&acc)[2][2][4][2], const Unit& u, int wr, int wc, int fr, int fq) const {
        const int row0 = u.pm * BM + wr * 64 + fr, col0 = u.pn * HALF + wc * 32 + 8 * fq;
#pragma unroll
        for (int ai = 0; ai < 2; ++ai)
#pragma unroll
            for (int m = 0; m < 4; ++m) { bf16_t* rowp = O + (size_t)(row0 + ai * HALF + m * 16) * ldc + col0;
                const f32x4 a0 = acc[ai][0][m][0], a1 = acc[ai][0][m][1], b0 = acc[ai][1][m][0], b1 = acc[ai][1][m][1];
                u32x4 w; w.x = cvt_pk_bf16(silu_f(a0[0]) * b0[0], silu_f(a0[1]) * b0[1]); w.y = cvt_pk_bf16(silu_f(a0[2]) * b0[2], silu_f(a0[3]) * b0[3]);
                w.z = cvt_pk_bf16(silu_f(a1[0]) * b1[0], silu_f(a1[1]) * b1[1]); w.w = cvt_pk_bf16(silu_f(a1[2]) * b1[2], silu_f(a1[3]) * b1[3]);
                *(u32x4*)rowp = w; }
    }
};
template <class Epi, class Sched, bool ALIGN_EPI = false, bool SP2 = false>
__device__ __forceinline__ void gemm_phase(PG8_LAS unsigned char* lds, const Gemm g, const Sched& S, const Epi& E) {
    int tid_ = threadIdx.x; asm volatile("" : "+v"(tid_));
    const int tid = tid_, wid = __builtin_amdgcn_readfirstlane(tid >> 6), lane = tid & 63, wr = wid >> 2, wc = wid & 3, fr = lane & 15, fq = lane >> 4;
    const int K = g.K, nt = K / BK;
    unsigned voffA[2], voffB[2];
#pragma unroll
    for (int i = 0; i < 2; ++i) { int R, C; stage_rc(tid * 16 + i * 8192, R, C); const int Rb = Epi::PERM ? ((R & ~31) + perm32(R & 31)) : R;
        voffA[i] = (unsigned)(R * K + C) * 2u; voffB[i] = (unsigned)(Rb * K + C) * 2u; }
    const size_t kstep = (size_t)(BK * 2);
    const size_t hstep = (size_t)HALF * K * 2;
    const size_t tstep = 2 * hstep;
    const unsigned ldsw = (unsigned)wid * 1024u;
    const int aoff = lds_byte(wr * 64 + fr, fq * 8), boff = lds_byte(wc * 32 + fr, fq * 8);
#define PG8_SA(b, h) (((b) * 2 + (h)) * HTB)
#define PG8_SB(b, h) ((4 + (b) * 2 + (h)) * HTB)
#define PG8_STAGE(bufoff, gbase, voff) do { _Pragma("unroll") for (int _i = 0; _i < 2; ++_i) \
        __builtin_amdgcn_global_load_lds((const unsigned*)((const char*)(gbase) + (voff)[_i]), (PG8_LAS unsigned*)(lds + (bufoff) + ldsw + _i * 8192), 16, 0, 0); } while (0)
#define PG8_LDA(dst, b, h) do { _Pragma("unroll") for (int m = 0; m < 4; ++m) _Pragma("unroll") for (int k = 0; k < 2; ++k) dst[m][k] = *(const PG8_LAS bf16x8*)(lds + PG8_SA(b, h) + aoff + m * 2048 + k * 1024); } while (0)
#define PG8_LDB(dst, b, h) do { _Pragma("unroll") for (int n = 0; n < 2; ++n) _Pragma("unroll") for (int k = 0; k < 2; ++k) dst[n][k] = *(const PG8_LAS bf16x8*)(lds + PG8_SB(b, h) + boff + n * 2048 + k * 1024); } while (0)
#define PG8_MMA(ai, bj, At, Bt) do { __builtin_amdgcn_s_setprio(1); _Pragma("unroll") for (int m = 0; m < 4; ++m) _Pragma("unroll") for (int n = 0; n < 2; ++n) _Pragma("unroll") for (int k = 0; k < 2; ++k) \
        acc[ai][bj][m][n] = __builtin_amdgcn_mfma_f32_16x16x32_bf16(Bt[n][k], At[m][k], acc[ai][bj][m][n], 0, 0, 0); __builtin_amdgcn_s_setprio(0); } while (0)
#define PG8_WAIT_V(n) asm volatile("s_waitcnt vmcnt(" #n ")" ::: "memory")
#define PG8_WAIT_L(n) asm volatile("s_waitcnt lgkmcnt(" #n ")" ::: "memory")
#define PG8_BAR __builtin_amdgcn_s_barrier()
#define PG8_SCHED __builtin_amdgcn_sched_barrier(0)
    Unit cur, nxt; int ui = 0;
    if (!S.next(0, cur)) return;
    f32x4 acc[2][2][4][2];
#pragma unroll
    for (int a = 0; a < 2; ++a)
#pragma unroll
        for (int b = 0; b < 2; ++b)
#pragma unroll
            for (int m = 0; m < 4; ++m)
#pragma unroll
                for (int n = 0; n < 2; ++n) acc[a][b][m][n] = (f32x4){0.f, 0.f, 0.f, 0.f};
    bf16x8 At[4][2], B0[2][2], B1[2][2];
    const char* cA = (const char*)g.A + (size_t)cur.pm * tstep; const char* cB = (const char*)g.Bt + (size_t)cur.pn * tstep;
    S.a_ready(cur);
    if constexpr (SP2) {
        PG8_STAGE(PG8_SB(0, 0), cB, voffB); PG8_STAGE(PG8_SB(0, 1), cB + hstep, voffB); PG8_STAGE(PG8_SA(0, 0), cA, voffA); PG8_STAGE(PG8_SA(0, 1), cA + hstep, voffA);
        if (wr == 1) PG8_BAR;
        PG8_WAIT_V(2); PG8_BAR;
        PG8_STAGE(PG8_SB(1, 0), cB + kstep, voffB); PG8_STAGE(PG8_SA(1, 0), cA + kstep, voffA); PG8_STAGE(PG8_SB(1, 1), cB + hstep + kstep, voffB);
        PG8_WAIT_V(6); PG8_BAR;
    } else {
        PG8_STAGE(PG8_SB(0, 0), cB, voffB); PG8_STAGE(PG8_SA(0, 0), cA, voffA); PG8_STAGE(PG8_SB(0, 1), cB + hstep, voffB); PG8_STAGE(PG8_SA(0, 1), cA + hstep, voffA);
        if (wr == 1) PG8_BAR;
        PG8_WAIT_V(4); PG8_BAR;
        PG8_STAGE(PG8_SB(1, 0), cB + kstep, voffB); PG8_STAGE(PG8_SA(1, 0), cA + kstep, voffA); PG8_STAGE(PG8_SB(1, 1), cB + hstep + kstep, voffB);
        PG8_WAIT_V(6); PG8_BAR;
    }
    for (;;) {
        const bool has_next = S.next(ui + 1, nxt);
        const char* nA = has_next ? (const char*)g.A + (size_t)nxt.pm * tstep : cA; const char* nB = has_next ? (const char*)g.Bt + (size_t)nxt.pn * tstep : cB;
        for (int t = 0; t < nt; t += 2) {
            const bool last = (t == nt - 2);
            const char* a1 = cA + (size_t)(t + 1) * kstep;
            const char* a2 = last ? nA : cA + (size_t)(t + 2) * kstep; const char* b2 = last ? nB : cB + (size_t)(t + 2) * kstep;
            const char* a3 = a2 + kstep; const char* b3 = b2 + kstep;
            if (last && has_next) S.a_ready(nxt);
            if constexpr (SP2) {
            PG8_LDB(B0, 0, 0); PG8_LDB(B1, 0, 1); PG8_SCHED; PG8_LDA(At, 0, 0); PG8_STAGE(PG8_SA(1, 1), a1 + hstep, voffA);
            PG8_WAIT_V(8); PG8_WAIT_L(0); PG8_BAR; PG8_MMA(0, 0, At, B0); PG8_MMA(0, 1, At, B1); PG8_BAR; PG8_SCHED;
            PG8_LDA(At, 0, 1); PG8_STAGE(PG8_SB(0, 0), b2, voffB); PG8_STAGE(PG8_SB(0, 1), b2 + hstep, voffB); PG8_STAGE(PG8_SA(0, 0), a2, voffA);
            PG8_WAIT_V(8); PG8_WAIT_L(0); PG8_BAR; PG8_MMA(1, 0, At, B0); PG8_MMA(1, 1, At, B1); PG8_BAR; PG8_SCHED;
            PG8_LDB(B0, 1, 0); PG8_LDB(B1, 1, 1); PG8_SCHED; PG8_LDA(At, 1, 0); PG8_STAGE(PG8_SA(0, 1), a2 + hstep, voffA);
            PG8_WAIT_V(8); PG8_WAIT_L(0); PG8_BAR; PG8_MMA(0, 0, At, B0); PG8_MMA(0, 1, At, B1); PG8_BAR; PG8_SCHED;
            PG8_LDA(At, 1, 1); PG8_STAGE(PG8_SB(1, 0), b3, voffB); PG8_STAGE(PG8_SB(1, 1), b3 + hstep, voffB); PG8_STAGE(PG8_SA(1, 0), a3, voffA);
            PG8_WAIT_V(8); PG8_WAIT_L(0); PG8_BAR; PG8_MMA(1, 0, At, B0); PG8_MMA(1, 1, At, B1); PG8_BAR; PG8_SCHED;
            } else {
            PG8_LDB(B0, 0, 0); PG8_SCHED; PG8_LDA(At, 0, 0); PG8_STAGE(PG8_SA(1, 1), a1 + hstep, voffA);
            PG8_WAIT_L(8); PG8_BAR; PG8_WAIT_L(0); PG8_MMA(0, 0, At, B0); PG8_BAR; PG8_SCHED;
            PG8_LDB(B1, 0, 1); PG8_STAGE(PG8_SB(0, 0), b2, voffB);
            PG8_BAR; PG8_WAIT_L(0); PG8_MMA(0, 1, At, B1); PG8_BAR;
            PG8_LDA(At, 0, 1); PG8_STAGE(PG8_SA(0, 0), a2, voffA);
            PG8_BAR; PG8_WAIT_L(0); PG8_MMA(1, 0, At, B0); PG8_BAR; PG8_SCHED;
            PG8_STAGE(PG8_SB(0, 1), b2 + hstep, voffB);
            PG8_WAIT_V(6); PG8_BAR; PG8_MMA(1, 1, At, B1); PG8_BAR;
            PG8_LDB(B0, 1, 0); PG8_SCHED; PG8_LDA(At, 1, 0); PG8_STAGE(PG8_SA(0, 1), a2 + hstep, voffA);
            PG8_WAIT_L(8); PG8_BAR; PG8_WAIT_L(0); PG8_MMA(0, 0, At, B0); PG8_BAR; PG8_SCHED;
            PG8_LDB(B1, 1, 1); PG8_STAGE(PG8_SB(1, 0), b3, voffB);
            PG8_BAR; PG8_WAIT_L(0); PG8_MMA(0, 1, At, B1); PG8_BAR;
            PG8_LDA(At, 1, 1); PG8_STAGE(PG8_SA(1, 0), a3, voffA);
            PG8_BAR; PG8_WAIT_L(0); PG8_MMA(1, 0, At, B0); PG8_BAR; PG8_SCHED;
            PG8_STAGE(PG8_SB(1, 1), b3 + hstep, voffB);
            PG8_WAIT_V(6); PG8_BAR; PG8_MMA(1, 1, At, B1); PG8_BAR;
            }
        }
        if constexpr (ALIGN_EPI) { if (wr == 0) PG8_BAR; }
        if constexpr (!Epi::AFTER_DRAIN) { E(acc, cur, wr, wc, fr, fq); S.done(cur); }
        if (!has_next) break;
#pragma unroll
        for (int a = 0; a < 2; ++a)
#pragma unroll
            for (int b = 0; b < 2; ++b)
#pragma unroll
                for (int m = 0; m < 4; ++m)
#pragma unroll
                    for (int n = 0; n < 2; ++n) acc[a][b][m][n] = (f32x4){0.f, 0.f, 0.f, 0.f};
        cur = nxt; cA = nA; cB = nB; ++ui;
        if constexpr (ALIGN_EPI) { if (wr == 1) PG8_BAR; }
    }
    PG8_WAIT_V(0);
    if constexpr (!ALIGN_EPI) { if (wr == 0) PG8_BAR; }
    PG8_BAR;
    if constexpr (Epi::AFTER_DRAIN) { E.fused(acc, cur, wr, wc, fr, fq, lds, wid, lane); S.done(cur); }
#undef PG8_SA
#undef PG8_SB
#undef PG8_STAGE
#undef PG8_LDA
#undef PG8_LDB
#undef PG8_MMA
#undef PG8_WAIT_V
#undef PG8_WAIT_L
#undef PG8_BAR
#undef PG8_SCHED
}
}
#include <hip/hip_bf16.h>
#include <cmath>
namespace attn_body {
using bf16=__hip_bfloat16;
using bf16x8=__attribute__((ext_vector_type(8)))short;
using s16x4=__attribute__((ext_vector_type(4)))short;
using f32x16=__attribute__((ext_vector_type(16)))float;
using u32x4=__attribute__((ext_vector_type(4)))unsigned;
constexpr int BATCH=8,NHEAD=4,SEQ=4096,D=64,DM=2560,DMO=1024;
constexpr int NW=8,QBLK=32,QB=QBLK*NW,KVBLK=64,NQB=SEQ/QB;
constexpr int ATTN_PITCH=DM, ATTN_UNIT_ROWS=QB;
__device__ __forceinline__ int crow(int r,int hi){return (r&3)+8*(r>>2)+4*hi;}
#define SBAR() __builtin_amdgcn_sched_barrier(0)
__device__ __forceinline__ void cmask(f32x16&p0,f32x16&p1,int jb,int qrel,int hi){
  const float NEG=-INFINITY; int kb=64*jb+4*hi;
  #pragma unroll
  for(int r=0;r<16;++r){int kv=kb+(r&3)+8*(r>>2); if(kv>qrel)p0[r]=NEG; if(kv+32>qrel)p1[r]=NEG;}
}

constexpr int NSLOT=3, SLOTB=8192;
constexpr int LDS_K=0, LDS_V=NSLOT*SLOTB, LDS_WS=2*NSLOT*SLOTB, LDS_OST=LDS_WS+NW*64*4, LDS_CUM=LDS_OST+NW*4096, LDS_BYTES=LDS_CUM+SEQ*4;
constexpr float C2=0.125f*1.4426950408889634f;
__device__ __forceinline__ void glds16(const void*gsrc,unsigned lds_dst){unsigned keep;
  asm volatile("s_mov_b32 %0, m0\n\ts_mov_b32 m0, %2\n\ts_nop 0\n\tglobal_load_lds_dwordx4 %1, off\n\ts_mov_b32 m0, %0":"=&s"(keep):"v"(gsrc),"s"(lds_dst):"memory");}
__device__ __forceinline__ float max3f(float a,float b,float c){float r;asm("v_max3_f32 %0, %1, %2, %3":"=v"(r):"v"(a),"v"(b),"v"(c));return r;}
__device__ __forceinline__ float max2f(float a,float b){float r;asm("v_max_f32_e32 %0, %1, %2":"=v"(r):"v"(a),"v"(b));return r;}
__device__ __forceinline__ float fadd_s(float a,float b){float r;asm("v_add_f32_e32 %0, %1, %2":"=v"(r):"v"(a),"v"(b));return r;}
__device__ __forceinline__ float fsub_s(float a,float b){float r;asm("v_sub_f32_e32 %0, %1, %2":"=v"(r):"v"(a),"v"(b));return r;}
typedef float f32x2_t __attribute__((ext_vector_type(2))); typedef __bf16 bf16x2_t __attribute__((ext_vector_type(2)));
__device__ __forceinline__ unsigned cvtpk_s(float lo,float hi){f32x2_t v={lo,hi};bf16x2_t b=__builtin_convertvector(v,bf16x2_t);return __builtin_bit_cast(unsigned,b);}
#define WAIT_BAR(N) asm volatile("s_waitcnt vmcnt(" #N ") lgkmcnt(0)\n\ts_barrier":::"memory")

__device__ __forceinline__ void qkt(f32x16&p0,f32x16&p1,const char*Kslot,const bf16x8*qr,const f32x16&negm,int r32,int hi){
  const char*kb=Kslot+hi*1024+r32*16;
  #pragma unroll
  for(int d0=0;d0<4;++d0){
    const bf16x8 b0=*reinterpret_cast<const bf16x8*>(kb+d0*2048);
    const bf16x8 b1=*reinterpret_cast<const bf16x8*>(kb+d0*2048+512);
    if(d0==0){p0=__builtin_amdgcn_mfma_f32_32x32x16_bf16(b0,qr[0],negm,0,0,0);p1=__builtin_amdgcn_mfma_f32_32x32x16_bf16(b1,qr[0],negm,0,0,0);}
    else{p0=__builtin_amdgcn_mfma_f32_32x32x16_bf16(b0,qr[d0],p0,0,0,0);p1=__builtin_amdgcn_mfma_f32_32x32x16_bf16(b1,qr[d0],p1,0,0,0);}}
}
typedef __attribute__((address_space(3))) const char* lds_cptr;
typedef short v4i16_t __attribute__((ext_vector_type(4)));
__device__ __forceinline__ void kload8(bf16x8*kf,lds_cptr kp){
  kf[0]=*(const __attribute__((address_space(3))) bf16x8*)(kp);      kf[1]=*(const __attribute__((address_space(3))) bf16x8*)(kp+512);
  kf[2]=*(const __attribute__((address_space(3))) bf16x8*)(kp+2048); kf[3]=*(const __attribute__((address_space(3))) bf16x8*)(kp+2560);
  kf[4]=*(const __attribute__((address_space(3))) bf16x8*)(kp+4096); kf[5]=*(const __attribute__((address_space(3))) bf16x8*)(kp+4608);
  kf[6]=*(const __attribute__((address_space(3))) bf16x8*)(kp+6144); kf[7]=*(const __attribute__((address_space(3))) bf16x8*)(kp+6656);
}
__device__ __forceinline__ void kload2(bf16x8*kf,lds_cptr kp,int j){ kf[2*j]=*(const __attribute__((address_space(3))) bf16x8*)(kp+j*2048); kf[2*j+1]=*(const __attribute__((address_space(3))) bf16x8*)(kp+j*2048+512); }
__device__ __forceinline__ s16x4 vtr(lds_cptr p){ return __builtin_bit_cast(s16x4,__builtin_amdgcn_ds_read_tr16_b64_v4i16((__attribute__((address_space(3))) v4i16_t*)p)); }
__device__ __forceinline__ float rowmax(const f32x16&p0,const f32x16&p1){
  float a=max3f(p0[0],p0[1],p1[0]),b=max3f(p0[2],p0[3],p1[1]);a=max3f(a,p1[2],p1[3]);
  #pragma unroll
  for(int r=4;r<16;r+=4){a=max3f(a,p0[r],p0[r+1]);b=max3f(b,p0[r+2],p0[r+3]);a=max3f(a,p1[r],p1[r+1]);b=max3f(b,p1[r+2],p1[r+3]);}
  const float m=max2f(a,b);
  auto rr=__builtin_amdgcn_permlane32_swap(__float_as_uint(m),__float_as_uint(m),false,false);
  return max2f(__uint_as_float(rr[0]),__uint_as_float(rr[1]));
}
__device__ __forceinline__ void pv(f32x16*o,int vb,bf16x8 pa0,bf16x8 pa1,bf16x8 pa2,bf16x8 pa3){
  #pragma unroll
  for(int d0=0;d0<2;++d0){s16x4 lo[4],hi[4];
    #pragma unroll
    for(int ks=0;ks<4;++ks){
      asm volatile("ds_read_b64_tr_b16 %0,%1 offset:%c2":"=&v"(lo[ks]):"v"(vb),"i"(d0*4096+ks*1024):"memory");
      asm volatile("ds_read_b64_tr_b16 %0,%1 offset:%c2":"=&v"(hi[ks]):"v"(vb),"i"(d0*4096+ks*1024+512):"memory");}
    asm volatile("s_waitcnt lgkmcnt(0)":::"memory");SBAR();
    #define PK(k) (bf16x8){lo[k][0],lo[k][1],lo[k][2],lo[k][3],hi[k][0],hi[k][1],hi[k][2],hi[k][3]}
    o[d0]=__builtin_amdgcn_mfma_f32_32x32x16_bf16(pa0,PK(0),o[d0],0,0,0);
    o[d0]=__builtin_amdgcn_mfma_f32_32x32x16_bf16(pa1,PK(1),o[d0],0,0,0);
    o[d0]=__builtin_amdgcn_mfma_f32_32x32x16_bf16(pa2,PK(2),o[d0],0,0,0);
    o[d0]=__builtin_amdgcn_mfma_f32_32x32x16_bf16(pa3,PK(3),o[d0],0,0,0);
    #undef PK
  }
}

#ifndef ATTN_STORE16
#define ATTN_STORE16(p,v) (*(u32x4*)(p)=(v))
#endif
template<int THRL> __device__ __forceinline__ void attn_unit(int b,int h,int qb,const bf16*Q,const bf16*__restrict__ K,const bf16*__restrict__ V,bf16*O,const float*__restrict__ cumg,char*shm){
  int tid_=threadIdx.x; asm volatile("":"+v"(tid_)); const int tid=tid_,lane=tid&63,r32=lane&31,hi=lane>>5; const int wid=__builtin_amdgcn_readfirstlane(tid>>6);
  const long rowbase=(long)b*SEQ; const int q0=qb*QB;
  typedef float f32x4_t __attribute__((ext_vector_type(4)));
  { __attribute__((address_space(3))) f32x4_t* cl=(__attribute__((address_space(3))) f32x4_t*)((__attribute__((address_space(3))) char*)shm+LDS_CUM);
    const f32x4_t* cgp=(const f32x4_t*)cumg; for(int i=tid;i<(q0+QB)/4;i+=NW*64)cl[i]=cgp[i]; }
  const float cqL=cumg[q0+wid*QBLK+r32];
  const __attribute__((address_space(3))) f32x4_t* cumq=(const __attribute__((address_space(3))) f32x4_t*)((__attribute__((address_space(3))) char*)shm+LDS_CUM)+hi;
  #define KBIAS(P0,P1,t) do{ const __attribute__((address_space(3))) f32x4_t* cb_=cumq+16*(t); _Pragma("unroll") for(int g_=0;g_<4;++g_){ const f32x4_t a_=cb_[2*g_], b_=cb_[8+2*g_]; \
      P0[4*g_]+=cqm-a_[0];P0[4*g_+1]+=cqm-a_[1];P0[4*g_+2]+=cqm-a_[2];P0[4*g_+3]+=cqm-a_[3]; P1[4*g_]+=cqm-b_[0];P1[4*g_+1]+=cqm-b_[1];P1[4*g_+2]+=cqm-b_[2];P1[4*g_+3]+=cqm-b_[3]; } }while(0)
  const bf16*Qw=Q+(rowbase+q0+wid*QBLK)*DM+h*D;
  const bf16*Kh=K+rowbase*DM+h*D,*Vh=V+rowbase*DM+h*D;
  const unsigned lds0=(unsigned)(uintptr_t)shm;
  float*wsf=(float*)(shm+LDS_WS)+wid*64;
  const bf16*ksrc=Kh+(long)lane*DM+wid*8;
  const bf16*vsrc=Vh+(long)(16*(wid&3)+(lane>>2))*DM+(wid>>2)*32+(lane&3)*8;
  const unsigned kdst=lds0+LDS_K+wid*1024, vdst=lds0+LDS_V+wid*1024;
  #define DMA_K(t,slot) glds16(ksrc+(long)(t)*KVBLK*DM,(unsigned)__builtin_amdgcn_readfirstlane(kdst+(slot)))
  #define DMA_V(t,slot) glds16(vsrc+(long)(t)*KVBLK*DM,(unsigned)__builtin_amdgcn_readfirstlane(vdst+(slot)))
  const int vb0=(int)(lds0+LDS_V)+((lane>>4)&1)*32+(lane&3)*8+(4*hi+((lane&15)>>2))*64;
  const char*Kbase=shm+LDS_K; bf16x8 kf[8];
  const lds_cptr shm3=(lds_cptr)shm; const lds_cptr kp0=shm3+LDS_K+hi*1024+r32*16; const lds_cptr vp0=shm3+LDS_V+((lane>>4)&1)*32+(lane&3)*8+(4*hi+((lane&15)>>2))*64;
  const int NT=(q0+QB)/KVBLK;
  DMA_K(0,0);DMA_V(0,0);DMA_K(1,SLOTB);
  bf16x8 qr[4];
  #pragma unroll
  for(int d0=0;d0<4;++d0)qr[d0]=*reinterpret_cast<const bf16x8*>(&Qw[(long)r32*DM+d0*16+hi*8]);
  float diagL=0.f;
  { const bf16*Kd=Kh+(long)(q0+wid*QBLK+r32)*DM+hi*8;
    #pragma unroll
    for(int d0=0;d0<4;++d0){ const bf16x8 kk=*reinterpret_cast<const bf16x8*>(&Kd[d0*16]);
      #pragma unroll
      for(int e=0;e<8;++e)diagL+=__builtin_bit_cast(float,(unsigned)(unsigned short)qr[d0][e]<<16)*__builtin_bit_cast(float,(unsigned)(unsigned short)kk[e]<<16); }
    auto rr=__builtin_amdgcn_permlane32_swap(__float_as_uint(diagL),__float_as_uint(diagL),false,false); diagL=__uint_as_float(rr[0])+__uint_as_float(rr[1]); }
  float mhat=0.f,l_reg=0.f;f32x16 o[2];o[0]=f32x16{};o[1]=f32x16{};float cqm=cqL; const f32x16 negm=f32x16{};
  const int qrel=wid*QBLK+r32;
  #define CMASK(P0,P1,t) do{int jb_=(t)-(NT-4); if(jb_>=0)cmask(P0,P1,jb_,qrel,hi);}while(0)
  bool resc=false;
  #define START(P0,P1) do{ const float rm=rowmax(P0,P1); resc=false; \
    { const float dl=__builtin_fmaxf(rm,diagL); mhat=fadd_s(mhat,dl); \
      _Pragma("unroll") for(int r=0;r<16;++r){P0[r]=fsub_s(P0[r],dl);P1[r]=fsub_s(P1[r],dl);} \
      cqm=cqL-mhat; } \
    _Pragma("unroll") for(int r=0;r<16;++r)P0[r]=__builtin_amdgcn_exp2f(P0[r]); }while(0)
  #define RESC() do{ if(resc){ asm volatile("s_waitcnt lgkmcnt(0)":::"memory"); \
      _Pragma("unroll") for(int d_=0;d_<2;++d_) _Pragma("unroll") for(int r=0;r<16;++r)o[d_][r]*=wsf[crow(r,hi)]; } }while(0)
  f32x16 pA0,pA1,pB0,pB1;
  int sl_prev=0,sl_cur=0,sl_next=SLOTB;
  #define ROT() do{sl_prev=sl_cur;sl_cur=sl_next;sl_next=(sl_next==(NSLOT-1)*SLOTB)?0:sl_next+SLOTB;}while(0)
  DMA_K(2,2*SLOTB);
  WAIT_BAR(3);
  qkt(pA0,pA1,Kbase,qr,negm,r32,hi);asm volatile("s_nop 15\n\ts_nop 7":"+v"(pA0),"+v"(pA1));KBIAS(pA0,pA1,0);CMASK(pA0,pA1,0);
  START(pA0,pA1);
  _Pragma("unroll") for(int r=0;r<16;++r)pA1[r]=__builtin_amdgcn_exp2f(pA1[r]);
  WAIT_BAR(0);
  DMA_K(3,0);DMA_V(1,SLOTB);
  ROT();
  kload8(kf,kp0+sl_cur);
  WAIT_BAR(2);
  s16x4 vlo[8],vhi[8]; u32x4 pw0,pw1,pw2,pw3;
  #define PKW(P,B) cvtpk_s(P[B],P[B+1])
  #define PAF(k) __builtin_bit_cast(bf16x8,pw##k)
  #define VFR(i) (bf16x8){vlo[i][0],vlo[i][1],vlo[i][2],vlo[i][3],vhi[i][0],vhi[i][1],vhi[i][2],vhi[i][3]}
  #define PIN(x) asm volatile("":"+v"(x))
  #define MX3(a,b,c) __builtin_fmaxf(__builtin_fmaxf((a),(b)),(c))
  #define GAPA(MF,A0,A1,A2,A3,W0,W1,PW) do{ MF; sacc+=A0; sacc+=A1; sacc+=A2; sacc+=A3; PIN(sacc); W0; W1; PIN(PW); SBAR(); }while(0)
  #define EX(v) __builtin_amdgcn_exp2f(v)
  #define GAPB(MF,X,B) do{ MF; X[B]=EX(X[B]); X[B+1]=EX(X[B+1]); X[B+2]=EX(X[B+2]); X[B+3]=EX(X[B+3]); PIN(X); SBAR(); }while(0)
  #define VRD(i) do{ vlo[i]=vtr(vp_+(((i)>>2)*4096+((i)&3)*1024)); vhi[i]=vtr(vp_+(((i)>>2)*4096+((i)&3)*1024+512)); }while(0)
  #define KRD(G,j) do{ if(G){ kload2(kf,kp0+sl_next,j); SBAR(); } }while(0)
  #define STEP(C0,C1,P0,P1,t,GK,GV,GL) do{ SBAR(); \
    const lds_cptr vp_=vp0+sl_prev; \
    VRD(0); SBAR(); float sacc=(P0[0]+P0[1]); \
    GAPA(C0=__builtin_amdgcn_mfma_f32_32x32x16_bf16(kf[0],qr[0],negm,0,0,0), P0[2],P0[3],P0[4],P0[5],     pw0[0]=PKW(P0,0), pw0[1]=PKW(P0,2), pw0); \
    VRD(4); SBAR(); GAPA(C1=__builtin_amdgcn_mfma_f32_32x32x16_bf16(kf[1],qr[0],negm,0,0,0), P0[6],P0[7],P0[8],P0[9],     pw0[2]=PKW(P0,4), pw0[3]=PKW(P0,6), pw0); \
    VRD(1); SBAR(); GAPA(C0=__builtin_amdgcn_mfma_f32_32x32x16_bf16(kf[2],qr[1],C0,0,0,0),   P0[10],P0[11],P0[12],P0[13], pw1[0]=PKW(P0,8), pw1[1]=PKW(P0,10), pw1); \
    VRD(5); SBAR(); GAPA(C1=__builtin_amdgcn_mfma_f32_32x32x16_bf16(kf[3],qr[1],C1,0,0,0),   P0[14],P0[15],P1[0],P1[1],   pw1[2]=PKW(P0,12),pw1[3]=PKW(P0,14), pw1); \
    VRD(2); SBAR(); GAPA(C0=__builtin_amdgcn_mfma_f32_32x32x16_bf16(kf[4],qr[2],C0,0,0,0),   P1[2],P1[3],P1[4],P1[5],     pw2[0]=PKW(P1,0), pw2[1]=PKW(P1,2), pw2); \
    VRD(6); SBAR(); GAPA(C1=__builtin_amdgcn_mfma_f32_32x32x16_bf16(kf[5],qr[2],C1,0,0,0),   P1[6],P1[7],P1[8],P1[9],     pw2[2]=PKW(P1,4), pw2[3]=PKW(P1,6), pw2); \
    VRD(3); SBAR(); GAPA(C0=__builtin_amdgcn_mfma_f32_32x32x16_bf16(kf[6],qr[3],C0,0,0,0),   P1[10],P1[11],P1[12],P1[13], pw3[0]=PKW(P1,8), pw3[1]=PKW(P1,10), pw3); \
    VRD(7); SBAR(); GAPA(C1=__builtin_amdgcn_mfma_f32_32x32x16_bf16(kf[7],qr[3],C1,0,0,0),   P1[14],P1[15],0.f,0.f,       pw3[2]=PKW(P1,12),pw3[3]=PKW(P1,14), pw3); \
    l_reg+=sacc; \
    if(GK){DMA_K((t)+3,sl_cur);} if(GV){DMA_V((t)+1,sl_next);} \
    KBIAS(C0,C1,t); CMASK(C0,C1,t); \
    { float a=MX3(C0[0],C0[1],C1[0]),b=MX3(C0[2],C0[3],C1[1]); a=MX3(a,C1[2],C1[3]); \
      _Pragma("unroll") for(int r=4;r<16;r+=4){a=MX3(a,C0[r],C0[r+1]);b=MX3(b,C0[r+2],C0[r+3]);a=MX3(a,C1[r],C1[r+1]);b=MX3(b,C1[r+2],C1[r+3]);} \
      float rm=__builtin_fmaxf(a,b); { auto rr=__builtin_amdgcn_permlane32_swap(__float_as_uint(rm),__float_as_uint(rm),false,false); rm=__builtin_fmaxf(__uint_as_float(rr[0]),__uint_as_float(rr[1])); } \
      resc=false; \
      if(__builtin_expect(__any(rm>(float)THRL),0)){ const float dl=__builtin_fmaxf(rm,0.f); mhat+=dl; \
        _Pragma("unroll") for(int r=0;r<16;++r){C0[r]-=dl;C1[r]-=dl;} \
        cqm=cqL-mhat; \
        const float f=__builtin_amdgcn_exp2f(-dl); l_reg*=f; if(hi==0)wsf[r32]=f; resc=true; } } \
    SBAR(); \
    GAPB(o[0]=__builtin_amdgcn_mfma_f32_32x32x16_bf16(PAF(0),VFR(0),o[0],0,0,0), C0,0); \
    GAPB(o[1]=__builtin_amdgcn_mfma_f32_32x32x16_bf16(PAF(0),VFR(4),o[1],0,0,0), C0,4); \
    KRD(GL,0); GAPB(o[0]=__builtin_amdgcn_mfma_f32_32x32x16_bf16(PAF(1),VFR(1),o[0],0,0,0), C0,8); \
    KRD(GL,1); GAPB(o[1]=__builtin_amdgcn_mfma_f32_32x32x16_bf16(PAF(1),VFR(5),o[1],0,0,0), C0,12); \
    KRD(GL,2); GAPB(o[0]=__builtin_amdgcn_mfma_f32_32x32x16_bf16(PAF(2),VFR(2),o[0],0,0,0), C1,0); \
    KRD(GL,3); GAPB(o[1]=__builtin_amdgcn_mfma_f32_32x32x16_bf16(PAF(2),VFR(6),o[1],0,0,0), C1,4); \
    GAPB(o[0]=__builtin_amdgcn_mfma_f32_32x32x16_bf16(PAF(3),VFR(3),o[0],0,0,0), C1,8); \
    GAPB(o[1]=__builtin_amdgcn_mfma_f32_32x32x16_bf16(PAF(3),VFR(7),o[1],0,0,0), C1,12); \
    }while(0)
  int t=1;
  #undef CMASK
  #define CMASK(P0,P1,t) do{}while(0)
  for(;t+5<NT;t+=2){
    STEP(pB0,pB1,pA0,pA1,t,true,true,true);     WAIT_BAR(2); RESC(); ROT();
    STEP(pA0,pA1,pB0,pB1,t+1,true,true,true);   WAIT_BAR(2); RESC(); ROT();
  }
  #undef CMASK
  #define CMASK(P0,P1,t) do{int jb_=(t)-(NT-4); if(jb_>=0)cmask(P0,P1,jb_,qrel,hi);}while(0)
  #define ENDW(tt) do{ if((tt)+3<NT){WAIT_BAR(2);} else if((tt)+2<NT){WAIT_BAR(1);} else {WAIT_BAR(0);} }while(0)
  for(;t+1<NT;t+=2){
    STEP(pB0,pB1,pA0,pA1,t,(t+3<NT),(t+1<NT),(t+1<NT));       ENDW(t);   RESC(); ROT();
    STEP(pA0,pA1,pB0,pB1,t+1,(t+4<NT),(t+2<NT),(t+2<NT));     ENDW(t+1); RESC(); ROT();
  }
  STEP(pB0,pB1,pA0,pA1,NT-1,false,false,false); RESC();
  { float sacc=pB0[0]+pB0[1]; _Pragma("unroll") for(int r=2;r<16;++r)sacc+=pB0[r]; _Pragma("unroll") for(int r=0;r<16;++r)sacc+=pB1[r]; l_reg+=sacc;
    pw0=(u32x4){PKW(pB0,0),PKW(pB0,2),PKW(pB0,4),PKW(pB0,6)};pw1=(u32x4){PKW(pB0,8),PKW(pB0,10),PKW(pB0,12),PKW(pB0,14)};pw2=(u32x4){PKW(pB1,0),PKW(pB1,2),PKW(pB1,4),PKW(pB1,6)};pw3=(u32x4){PKW(pB1,8),PKW(pB1,10),PKW(pB1,12),PKW(pB1,14)};
    SBAR(); pv(o,vb0+sl_cur,PAF(0),PAF(1),PAF(2),PAF(3)); }
  #undef PKW
  #undef PAF
  #undef VFR
  #undef PIN
  #undef MX3
  #undef GAPA
  #undef GAPB
  #undef EX
  #undef VRD
  #undef KRD
  #undef STEP
  #undef ENDW
  {auto rr=__builtin_amdgcn_permlane32_swap(__float_as_uint(l_reg),__float_as_uint(l_reg),false,false);l_reg=__uint_as_float(rr[0])+__uint_as_float(rr[1]);}
  if(hi==0)wsf[32+r32]=l_reg;asm volatile("s_waitcnt lgkmcnt(0)":::"memory");
  float rli[16];
  #pragma unroll
  for(int r=0;r<16;++r)rli[r]=__builtin_amdgcn_rcpf(wsf[32+crow(r,hi)]);
  bf16*Ow=O+(rowbase+q0+wid*QBLK)*DMO+h*D;
  { bf16*stg=(bf16*)(shm+LDS_OST)+wid*2048;
    #pragma unroll
    for(int r=0;r<16;++r){const int orow=crow(r,hi);
      #pragma unroll
      for(int d0=0;d0<2;++d0)stg[orow*64+d0*32+r32]=__float2bfloat16(o[d0][r]*rli[r]);}
    asm volatile("s_waitcnt lgkmcnt(0)":::"memory");
    #pragma unroll
    for(int i=0;i<4;++i){const int row=i*8+(lane>>3),ch=lane&7; const u32x4 v=*(const u32x4*)(stg+row*64+ch*8); ATTN_STORE16(Ow+(long)row*DMO+ch*8,v);} }
  asm volatile("s_waitcnt lgkmcnt(0)\n\ts_barrier":::"memory");
  #undef DMA_K
  #undef DMA_V
  #undef CMASK
  #undef START
  #undef RESC
  #undef ROT
  #undef KBIAS
}
constexpr int ATTN_LDS_BYTES=LDS_BYTES;
struct AttnTensors { const bf16* Q; const bf16* K; const bf16* V; bf16* O; const float* cum; };
struct AttnUnit { int bh; int qb; };
struct StaticOrder {
  int vcu;
  __device__ __forceinline__ explicit StaticOrder(int grid,int block):vcu((block%8)*(grid/8)+block/8){}
  __device__ __forceinline__ bool next(int i,AttnUnit&u)const{ if(i>=2)return false; const int s=vcu&7; u.bh=vcu>>3; u.qb=(i==0)?15-s:s; return true; }
  __device__ __forceinline__ void a_ready(const AttnUnit&)const{}
  __device__ __forceinline__ void done(const AttnUnit&)const{}
};
template<class Sched,int THRL=8> __device__ __forceinline__ void attn_phase(char*lds,const AttnTensors&T,const Sched&S){
  AttnUnit u;
  for(int i=0;S.next(i,u);++i){ S.a_ready(u); attn_unit<THRL>(u.bh/NHEAD,u.bh%NHEAD,u.qb,T.Q,T.K,T.V,T.O,T.cum+(long)u.bh*SEQ,lds); S.done(u); }
}
#undef SBAR
#undef WAIT_BAR
}
#define LAS __attribute__((address_space(3)))
#define RLX_AGENT __ATOMIC_RELAXED, __HIP_MEMORY_SCOPE_AGENT
#define VM_WAIT() asm volatile("s_waitcnt vmcnt(0)" ::: "memory")
__device__ __forceinline__ unsigned long long rt() { return __builtin_amdgcn_s_memrealtime(); }
#define XB_TMO      128
#define XB_XCNT(j)  (256  + 64 * (j))
#define XB_XSUB(j)  (1280 + 64 * (j))
#define XB_XGEN(j)  (2304 + 64 * (j))
#define XB_TOP      3328
#define XB_TOPGEN   3392
#define XCD_BAR_WORDS 3456
#define XB_SPIN_CAP (1u << 18)

__device__ __forceinline__ unsigned xb_ld(unsigned* p)              { return __hip_atomic_load(p, __ATOMIC_RELAXED, __HIP_MEMORY_SCOPE_AGENT); }
__device__ __forceinline__ unsigned xb_add(unsigned* p, unsigned v) { return __hip_atomic_fetch_add(p, v, __ATOMIC_RELAXED, __HIP_MEMORY_SCOPE_AGENT); }
__device__ __forceinline__ unsigned xb_xcc_id() { return (unsigned)__builtin_amdgcn_s_getreg((3 << 11) | 20) & 0xFu; }
#define XB_SPIN(cond, bar) do { unsigned _sp = 0; while (cond) { __builtin_amdgcn_s_sleep(1); \
    if ((++_sp & 255u) == 0u) { if (xb_ld(&(bar)[XB_TMO])) break; if (_sp > XB_SPIN_CAP) { atomicAdd(&(bar)[XB_TMO], 1u); break; } } } } while (0)

struct XcdBarrier {
    unsigned* bar; unsigned x;
    volatile LAS unsigned* st;
};

__device__ __forceinline__ XcdBarrier xcd_barrier_post(unsigned* bar, volatile LAS unsigned* st) {
    XcdBarrier b; b.bar = bar; b.x = xb_xcc_id(); b.st = st;
    if (threadIdx.x == 0) (void)xb_add(&bar[XB_XCNT(b.x)], 1u);
    return b;
}
__device__ __forceinline__ void xcd_barrier_complete(unsigned* bar, unsigned x, unsigned& nloc, unsigned& nx) {
    const unsigned G = gridDim.x * gridDim.y * gridDim.z;
    unsigned sum, cnt, mine, sp = 0u;
    for (;;) {
        sum = 0u; cnt = 0u; mine = 0u;
#pragma unroll
        for (unsigned j = 0; j < 16; ++j) { const unsigned c = xb_ld(&bar[XB_XCNT(j)]); sum += c; cnt += (c > 0u) ? 1u : 0u; mine = (j == x) ? c : mine; }
        if (sum == G) break;
        __builtin_amdgcn_s_sleep(1);
        if ((++sp & 255u) == 0u) { if (xb_ld(&bar[XB_TMO])) break; if (sp > XB_SPIN_CAP) { atomicAdd(&bar[XB_TMO], 1u); break; } }
    }
    nloc = mine > 0u ? mine : 1u; nx = cnt > 0u ? cnt : 1u;
}

__device__ __forceinline__ void xcd_barrier(const XcdBarrier& b) {
    asm volatile("s_waitcnt vmcnt(0)" ::: "memory");
    __syncthreads();
    if (threadIdx.x == 0) {
        unsigned* bar = b.bar;
        __builtin_amdgcn_s_waitcnt(0);
        unsigned nloc = b.st[0], nx = b.st[1];
        if (nloc == 0u) { xcd_barrier_complete(bar, b.x, nloc, nx); b.st[0] = nloc; b.st[1] = nx; }
        const unsigned old = xb_add(&bar[XB_XSUB(b.x)], 1u);
        const unsigned gen = old / nloc;
        if (old + 1u == (gen + 1u) * nloc) {
            __builtin_amdgcn_fence(__ATOMIC_RELEASE, "agent");
            asm volatile("s_waitcnt vmcnt(0)" ::: "memory");
            const unsigned og = xb_add(&bar[XB_TOP], 1u);
            const unsigned tg = og / nx;
            if (og + 1u == (tg + 1u) * nx) xb_add(&bar[XB_TOPGEN], 1u);
            else XB_SPIN(xb_ld(&bar[XB_TOPGEN]) == tg, bar);
            __builtin_amdgcn_fence(__ATOMIC_ACQUIRE, "agent");
            xb_add(&bar[XB_XGEN(b.x)], 1u);
            asm volatile("s_waitcnt vmcnt(0)" ::: "memory");
        } else {
            XB_SPIN(xb_ld(&bar[XB_XGEN(b.x)]) == gen, bar);
            __builtin_amdgcn_fence(__ATOMIC_ACQUIRE, "agent");
            asm volatile("s_waitcnt vmcnt(0)" ::: "memory");
        }
    }
    __syncthreads();
}
namespace cg = cooperative_groups;
#ifndef PH_PRO
#define PH_PRO 1
#endif
#ifndef PH_NORM
#define PH_NORM 1
#endif
#ifndef PH_GIN
#define PH_GIN 1
#endif
#ifndef PH_POOL
#define PH_POOL 1
#endif
#ifndef PH_CONV
#define PH_CONV 1
#endif
#ifndef PH_RKV
#define PH_RKV 1
#endif
#ifndef PH_ATT
#define PH_ATT 1
#endif
#ifndef PH_RET
#define PH_RET 1
#endif
#ifndef PH_GOUT
#define PH_GOUT 1
#endif
#ifndef PH_GUP
#define PH_GUP 1
#endif
#ifndef PH_GDN
#define PH_GDN 1
#endif
#ifndef REP_GIN
#define REP_GIN 1
#endif
#ifndef REP_GUP
#define REP_GUP 1
#endif
#ifndef REP_RKV
#define REP_RKV 1
#endif
#ifndef REP_GRES
#define REP_GRES 1
#endif
#ifndef REP_NORM
#define REP_NORM 1
#endif
#ifndef REP_C1
#define REP_C1 1
#endif
#ifndef REP_ATT
#define REP_ATT 1
#endif
#ifndef REP_RET
#define REP_RET 1
#endif
typedef unsigned short bf16;
typedef unsigned v4u __attribute__((ext_vector_type(4)));
typedef unsigned v2u __attribute__((ext_vector_type(2)));
typedef float f32x4 __attribute__((ext_vector_type(4)));
typedef float f32x16 __attribute__((ext_vector_type(16)));
typedef short bf16x8 __attribute__((ext_vector_type(8)));

constexpr int NWAVES = 8, NTHR = 512;
constexpr int BATCH = 8, SEQ = 4096, DMODEL = 1024, MROWS = BATCH * SEQ, DEPTH = 4;
constexpr int NU = 2560, NIN = 2564, DFF = 2816, NH2 = 5632, MODW = 6144;
constexpr float EPS = 1e-6f, LOG2E = 1.4426950408889634f;
constexpr int LDS_BYTES = 147456;

constexpr size_t MiB = 1u << 20;
constexpr size_t WS_MOD = 1 * MiB, WS_CUM = 2 * MiB, WS_FF = 3 * MiB, WS_W = 4 * MiB;
constexpr size_t WOFF_IN = 0, WOFF_OUT = (size_t)NU * 1024, WOFF_13 = WOFF_OUT + 1024 * 1024, WOFF_2 = WOFF_13 + (size_t)NH2 * 1024, W_LAYER = WOFF_2 + (size_t)1024 * DFF;
constexpr size_t WS_H = 98 * MiB, WS_U = 162 * MiB, WS_MIX = 322 * MiB, WS_HID = 162 * MiB, WS_KV = 386 * MiB, WS_VT = 402 * MiB, WS_END = 418 * MiB;
static_assert(WS_W + DEPTH * W_LAYER * 2 <= WS_H, "weights fit");
static_assert(WS_HID + (size_t)MROWS * DFF * 2 <= WS_KV, "hid overlay fits");

#define LDS_WAIT() asm volatile("s_waitcnt lgkmcnt(0)" ::: "memory")
__device__ __forceinline__ unsigned f2bf(float f) { unsigned u = __builtin_bit_cast(unsigned, f); return (u + 0x7fffu + ((u >> 16) & 1u)) >> 16; }
__device__ __forceinline__ unsigned pk2(float lo, float hi) { return f2bf(lo) | (f2bf(hi) << 16); }
__device__ __forceinline__ float bf2f(unsigned b) { return __builtin_bit_cast(float, b << 16); }
__device__ __forceinline__ float bfe(const v4u& v, int e) { return bf2f((v[e >> 1] >> (16 * (e & 1))) & 0xffffu); }
__device__ __forceinline__ float bfe2(const v2u& v, int e) { return bf2f((v[e >> 1] >> (16 * (e & 1))) & 0xffffu); }
template <int CTRL> __device__ __forceinline__ float dppf(float v) { return __builtin_bit_cast(float, __builtin_amdgcn_update_dpp(0, __builtin_bit_cast(int, v), CTRL, 0xF, 0xF, false)); }
__device__ __forceinline__ float wave_sum(float v) {
    v += dppf<0xB1>(v); v += dppf<0x4E>(v); v += dppf<0x141>(v); v += dppf<0x140>(v);
    const int iv = __builtin_bit_cast(int, v);
    return (__builtin_bit_cast(float, __builtin_amdgcn_readlane(iv, 0)) + __builtin_bit_cast(float, __builtin_amdgcn_readlane(iv, 16))) +
           (__builtin_bit_cast(float, __builtin_amdgcn_readlane(iv, 32)) + __builtin_bit_cast(float, __builtin_amdgcn_readlane(iv, 48)));
}
__device__ __forceinline__ float siluf(float v) { return v * __builtin_amdgcn_rcpf(1.0f + __builtin_amdgcn_exp2f(-LOG2E * v)); }
__device__ __forceinline__ int crow(int r, int hi) { return (r & 3) + 8 * (r >> 2) + 4 * hi; }

__device__ __forceinline__ void transpose_item(const float* W, int ld, int k0, int scol0, bf16* WT, int Kd, int drow0, LAS float* scr, int lane) {
#pragma unroll 8
    for (int i = 0; i < 32; ++i) { const int kk = 2 * i + (lane >> 5); scr[kk * 33 + (lane & 31)] = W[(size_t)(k0 + kk) * ld + scol0 + (lane & 31)]; }
    LDS_WAIT(); asm volatile("" ::: "memory");
    const int c = lane & 7;
#pragma unroll
    for (int j = 0; j < 4; ++j) { const int n = (lane >> 3) + 8 * j; const LAS float* s = scr + (8 * c) * 33 + n;
        v4u o; o.x = pk2(s[0 * 33], s[1 * 33]); o.y = pk2(s[2 * 33], s[3 * 33]); o.z = pk2(s[4 * 33], s[5 * 33]); o.w = pk2(s[6 * 33], s[7 * 33]);
        *(v4u*)(WT + (size_t)(drow0 + n) * Kd + k0 + 8 * c) = o; }
    LDS_WAIT(); asm volatile("" ::: "memory");
}

template <bool FF>
__device__ __forceinline__ void norm_phase(LAS unsigned char* lds, const float* xin, const float* g, const float* msc, const float* msh, bf16* hout, const float* wfcols, float* ffout,
                                           int bx, int G, int tid, int lane, int wave) {
    LAS f32x4* gs4 = (LAS f32x4*)lds; LAS f32x4* sh4 = (LAS f32x4*)(lds + 4096); LAS f32x4* wf4 = (LAS f32x4*)(lds + 8192);
    for (int rb = bx; rb < MROWS / 128; rb += G) {
        const int b = rb / (SEQ / 128);
        if (tid < 256) { const f32x4 gv = ((const f32x4*)g)[tid], scv = ((const f32x4*)(msc + (size_t)b * MODW))[tid]; gs4[tid] = gv * (1.0f + scv); sh4[tid] = ((const f32x4*)(msh + (size_t)b * MODW))[tid]; }
        if (FF) for (int k = tid; k < 1024; k += NTHR) wf4[k] = *(const f32x4*)(wfcols + (size_t)k * NIN);
        __syncthreads();
        f32x4 nv[4];
        { const f32x4* xr0 = (const f32x4*)(xin + (size_t)(rb * 128 + wave * 16) * 1024) + lane;
#pragma unroll
          for (int j = 0; j < 4; ++j) nv[j] = xr0[64 * j]; }
        for (int i = 0; i < 16; ++i) {
            const int row = rb * 128 + wave * 16 + i;
            f32x4 v[4]; float ss = 0.f;
#pragma unroll
            for (int j = 0; j < 4; ++j) { v[j] = nv[j]; ss += (v[j].x * v[j].x + v[j].y * v[j].y) + (v[j].z * v[j].z + v[j].w * v[j].w); }
            if (i < 15) { const f32x4* xr = (const f32x4*)(xin + (size_t)(row + 1) * 1024) + lane;
#pragma unroll
                for (int j = 0; j < 4; ++j) nv[j] = xr[64 * j]; }
            ss = wave_sum(ss);
            const float rstd = 1.0f / sqrtf(ss * (1.0f / 1024.0f) + EPS);
            float f0 = 0.f, f1 = 0.f, f2 = 0.f, f3 = 0.f;
            unsigned long long* o8 = (unsigned long long*)(hout + (size_t)row * 1024) + lane;
#pragma unroll
            for (int j = 0; j < 4; ++j) {
                const f32x4 hv = v[j] * rstd * gs4[lane + 64 * j] + sh4[lane + 64 * j];
                o8[64 * j] = (unsigned long long)pk2(hv.x, hv.y) | ((unsigned long long)pk2(hv.z, hv.w) << 32);
                if (FF) { const int k = 4 * lane + 256 * j; const f32x4 w0 = wf4[k], w1 = wf4[k + 1], w2 = wf4[k + 2], w3 = wf4[k + 3];
                    f0 += hv.x * w0.x + hv.y * w1.x + hv.z * w2.x + hv.w * w3.x; f1 += hv.x * w0.y + hv.y * w1.y + hv.z * w2.y + hv.w * w3.y;
                    f2 += hv.x * w0.z + hv.y * w1.z + hv.z * w2.z + hv.w * w3.z; f3 += hv.x * w0.w + hv.y * w1.w + hv.z * w2.w + hv.w * w3.w; }
            }
            if (FF) { f0 = wave_sum(f0); f1 = wave_sum(f1); f2 = wave_sum(f2); f3 = wave_sum(f3); if (lane == 0) *(f32x4*)(ffout + (size_t)row * 4) = (f32x4){f0, f1, f2, f3}; }
        }
        __syncthreads();
    }
}

__device__ __forceinline__ void cum_scan(LAS unsigned char* lds, const float* ff, const float* fb, float* cumL, int bh, int tid, int lane, int wave) {
    const int b = bh >> 2, h = bh & 3; const float fbh = fb[h];
    float v[8]; float run = 0.f;
#pragma unroll
    for (int i = 0; i < 8; ++i) { const int s = tid * 8 + i; const float z = ff[((size_t)b * SEQ + s) * 4 + h] + fbh;
        const float ls = fminf(z, 0.f) - log1pf(expf(-fabsf(z))); run += ls * LOG2E; v[i] = run; }
    float incl = run;
#pragma unroll
    for (int o = 1; o < 64; o <<= 1) { const float t = __shfl_up(incl, o); if (lane >= o) incl += t; }
    LAS float* wt = (LAS float*)lds;
    if (lane == 63) wt[wave] = incl;
    __syncthreads();
    float off = incl - run;
    for (int ww = 0; ww < wave; ++ww) off += wt[ww];
    float* op = cumL + (size_t)bh * SEQ + tid * 8;
    *(f32x4*)op = (f32x4){v[0] + off, v[1] + off, v[2] + off, v[3] + off}; *(f32x4*)(op + 4) = (f32x4){v[4] + off, v[5] + off, v[6] + off, v[7] + off};
    __syncthreads();
}

template <int W>
__device__ __forceinline__ void pool_body(const bf16* yb, bf16* ob, int sfirst) {
    float ring[W];
#pragma unroll
    for (int j = 0; j < W - 1; ++j) { const int s = sfirst - (W - 1) + j; ring[j] = (s >= 0) ? bf2f(yb[(long)(j - (W - 1)) * NU]) : 0.f; }
    ring[W - 1] = 0.f;
#pragma unroll
    for (int t = 0; t < 64; ++t) {
        const float v = bf2f(yb[(long)t * NU]);
        ring[(t + W - 1) % W] = v;
        float sum = ring[0];
#pragma unroll
        for (int j = 1; j < W; ++j) sum += ring[j];
        const int s = sfirst + t;
        const float inv = (s + 1 < W) ? 1.0f / (float)(s + 1) : 1.0f / (float)W;
        ob[(long)t * 1024] = (bf16)f2bf(sum * inv - v);
    }
}
__device__ __forceinline__ void pool_unit(const bf16* U, bf16* MIX, int u, int tid) {
    const int b = u >> 5, s0 = (u & 31) * 128 + 64 * (tid >> 8), ch = tid & 255;
    const int gi = __builtin_amdgcn_readfirstlane((tid >> 6) & 3);
    const bf16* yb = U + ((size_t)b * SEQ + s0) * NU + 768 + ch;
    bf16* ob = MIX + ((size_t)b * SEQ + s0) * 1024 + 256 + ch;
    if (gi == 0) pool_body<2>(yb, ob, s0); else if (gi == 1) pool_body<4>(yb, ob, s0); else if (gi == 2) pool_body<8>(yb, ob, s0); else pool_body<16>(yb, ob, s0);
}
__device__ __forceinline__ void poolfold_item(const float* Win, const float* pw, const float* psc, int k0, int n0, bf16* WT, LAS float* scr, int lane) {
    const int gi = (n0 - 768) >> 6, d = ((n0 - 768) & 63) + (lane & 31);
    float pc[64];
    { const float sc = psc[gi * 64 + d];
#pragma unroll
      for (int c = 0; c < 64; ++c) pc[c] = pw[(gi * 64 + c) * 64 + d] * sc; }
    for (int i = 0; i < 32; ++i) { const int kk = 2 * i + (lane >> 5);
        const f32x4* wr = (const f32x4*)(Win + (size_t)(k0 + kk) * NIN + 772 + 64 * gi);
        float acc = 0.f;
#pragma unroll
        for (int c4 = 0; c4 < 16; ++c4) { const f32x4 wv = wr[c4]; acc += (wv.x * pc[4 * c4] + wv.y * pc[4 * c4 + 1]) + (wv.z * pc[4 * c4 + 2] + wv.w * pc[4 * c4 + 3]); }
        scr[kk * 33 + (lane & 31)] = acc; }
    LDS_WAIT(); asm volatile("" ::: "memory");
    const int c = lane & 7;
#pragma unroll
    for (int j = 0; j < 4; ++j) { const int n = (lane >> 3) + 8 * j; const LAS float* sp = scr + (8 * c) * 33 + n;
        v4u o; o.x = pk2(sp[0 * 33], sp[1 * 33]); o.y = pk2(sp[2 * 33], sp[3 * 33]); o.z = pk2(sp[4 * 33], sp[5 * 33]); o.w = pk2(sp[6 * 33], sp[7 * 33]);
        *(v4u*)(WT + (size_t)(n0 + n) * 1024 + k0 + 8 * c) = o; }
    LDS_WAIT(); asm volatile("" ::: "memory");
}

__device__ __forceinline__ void conv_unit(LAS unsigned char* lds, const bf16* U, const float* cw, const float* cb, const float* lng, const float* lnb, bf16* MIX, int u, int tid, int lane, int wave) {
    const int b = u >> 6, s0 = (u & 63) * 64;
    LAS float* hg = (LAS float*)lds;
    for (int task = tid; task < 94 * 32; task += NTHR) {
        const int tt = task >> 5, c8 = task & 31, s = s0 - 30 + tt;
        f32x4 h0 = (f32x4){0.f, 0.f, 0.f, 0.f}, h1 = h0;
        if (s >= 0) { const bf16* ur = U + ((size_t)b * SEQ + s) * NU + 2048 + 8 * c8; const v4u av = *(const v4u*)ur, gv = *(const v4u*)(ur + 256);
#pragma unroll
            for (int e = 0; e < 4; ++e) { h0[e] = bfe(av, e) * __builtin_amdgcn_rcpf(1.0f + __builtin_amdgcn_exp2f(-LOG2E * bfe(gv, e)));
                                          h1[e] = bfe(av, e + 4) * __builtin_amdgcn_rcpf(1.0f + __builtin_amdgcn_exp2f(-LOG2E * bfe(gv, e + 4))); } }
        *(LAS f32x4*)(hg + tt * 256 + 8 * c8) = h0; *(LAS f32x4*)(hg + tt * 256 + 8 * c8 + 4) = h1;
    }
    __syncthreads();
    {
        const int ch = tid & 255, half = tid >> 8;
        float w[31], acc[32];
#pragma unroll
        for (int j = 0; j < 31; ++j) w[j] = cw[j * 256 + ch];
        const float bias = cb[ch];
#pragma unroll
        for (int o = 0; o < 32; ++o) acc[o] = bias;
        const LAS float* hp = hg + (32 * half) * 256 + ch;
#pragma unroll
        for (int j = 0; j < 62; ++j) { const float v = hp[j * 256];
#pragma unroll
            for (int o = 0; o < 32; ++o) if (j - o >= 0 && j - o <= 30) acc[o] += v * w[j - o]; }
        __syncthreads();
#pragma unroll
        for (int o = 0; o < 32; ++o) hg[(32 * half + o) * 256 + ch] = acc[o];
    }
    __syncthreads();
    for (int i = 0; i < 8; ++i) {
        const int tok = wave * 8 + i;
        const f32x4 y = *(const LAS f32x4*)(hg + tok * 256 + 4 * lane);
        const float mean = wave_sum((y.x + y.y) + (y.z + y.w)) * (1.0f / 256.0f);
        const f32x4 d = y - mean;
        const float var = wave_sum((d.x * d.x + d.y * d.y) + (d.z * d.z + d.w * d.w)) * (1.0f / 256.0f);
        const float rstd = 1.0f / sqrtf(var + EPS);
        const f32x4 z = d * rstd * *(const f32x4*)(lng + 4 * lane) + *(const f32x4*)(lnb + 4 * lane);
        v2u o; o.x = pk2(siluf(z.x), siluf(z.y)); o.y = pk2(siluf(z.z), siluf(z.w));
        *(v2u*)(MIX + ((size_t)b * SEQ + s0 + tok) * 1024 + 768 + 4 * lane) = o;
    }
    __syncthreads();
}

constexpr int TJ = 136, TS = 72;
__device__ __forceinline__ void retkv_unit(LAS unsigned char* lds, bf16* U, const int* positions, float* KV, bf16* VT, int u, int tid, int lane, int wave, bool wb) {
    const int b = u >> 7, n = (u >> 2) & 31, h = u & 3;
    LAS bf16* Kt = (LAS bf16*)lds;
    LAS bf16* Vt = (LAS bf16*)(lds + 64 * TJ * 2);
    const float lg = log2f(1.0f - exp2f(-5.0f - (float)h));
    {
        const int j = tid >> 2, p = tid & 3;
        const size_t row = (size_t)b * SEQ + n * 128 + j;
        bf16* ur = U + row * NU;
        const float pos = (float)positions[row];
        const float gq = exp2f(lg * (float)j), gk = 0.125f * exp2f(-lg * (float)j);
        const v4u q1 = *(const v4u*)(ur + 1024 + 64 * h + 8 * p), q2 = *(const v4u*)(ur + 1024 + 64 * h + 32 + 8 * p);
        const v4u k1 = *(const v4u*)(ur + 1280 + 64 * h + 8 * p), k2 = *(const v4u*)(ur + 1280 + 64 * h + 32 + 8 * p);
        const v4u v1 = *(const v4u*)(ur + 1536 + 64 * h + 8 * p), v2 = *(const v4u*)(ur + 1536 + 64 * h + 32 + 8 * p);
        unsigned qa[8], qb[8], ka[8], kb[8];
#pragma unroll
        for (int ii = 0; ii < 8; ++ii) {
            const int i = 8 * p + ii;
            const float inv = exp2f(-(float)i * (13.287712379549449f / 32.0f));
            const float ang = pos * inv;
            float rev = ang * 0.15915494309189535f; rev -= floorf(rev);
            const float sn = __builtin_amdgcn_sinf(rev), cs = __builtin_amdgcn_cosf(rev);
            const float a = bfe(q1, ii), c = bfe(q2, ii), ak = bfe(k1, ii), ck = bfe(k2, ii);
            qa[ii] = f2bf((a * cs - c * sn) * gq); qb[ii] = f2bf((a * sn + c * cs) * gq);
            ka[ii] = f2bf((ak * cs - ck * sn) * gk); kb[ii] = f2bf((ak * sn + ck * cs) * gk);
            Kt[(8 * p + ii) * TJ + j] = (bf16)ka[ii]; Kt[(32 + 8 * p + ii) * TJ + j] = (bf16)kb[ii];
            Vt[(8 * p + ii) * TJ + j] = (bf16)((v1[ii >> 1] >> (16 * (ii & 1))) & 0xffffu); Vt[(32 + 8 * p + ii) * TJ + j] = (bf16)((v2[ii >> 1] >> (16 * (ii & 1))) & 0xffffu);
        }
        if (wb) {
        *(v4u*)(ur + 1024 + 64 * h + 8 * p) = (v4u){qa[0] | (qa[1] << 16), qa[2] | (qa[3] << 16), qa[4] | (qa[5] << 16), qa[6] | (qa[7] << 16)};
        *(v4u*)(ur + 1024 + 64 * h + 32 + 8 * p) = (v4u){qb[0] | (qb[1] << 16), qb[2] | (qb[3] << 16), qb[4] | (qb[5] << 16), qb[6] | (qb[7] << 16)};
        *(v4u*)(ur + 1280 + 64 * h + 8 * p) = (v4u){ka[0] | (ka[1] << 16), ka[2] | (ka[3] << 16), ka[4] | (ka[5] << 16), ka[6] | (ka[7] << 16)};
        *(v4u*)(ur + 1280 + 64 * h + 32 + 8 * p) = (v4u){kb[0] | (kb[1] << 16), kb[2] | (kb[3] << 16), kb[4] | (kb[5] << 16), kb[6] | (kb[7] << 16)};
        }
    }
    __syncthreads();
    if (wave < 4) {
        const int db = wave >> 1, eb = wave & 1, r32 = lane & 31, hi = lane >> 5;
        f32x16 acc;
#pragma unroll
        for (int r = 0; r < 16; ++r) acc[r] = 0.f;
#pragma unroll
        for (int ks = 0; ks < 8; ++ks) {
            const bf16x8 A = *(const LAS bf16x8*)(Kt + (32 * db + r32) * TJ + 16 * ks + 8 * hi);
            const bf16x8 B = *(const LAS bf16x8*)(Vt + (32 * eb + r32) * TJ + 16 * ks + 8 * hi);
            acc = __builtin_amdgcn_mfma_f32_32x32x16_bf16(A, B, acc, 0, 0, 0);
        }
        const float g127 = exp2f(lg * 127.0f);
        float* kvp = KV + (size_t)u * 4096;
#pragma unroll
        for (int r = 0; r < 16; ++r) kvp[(32 * db + crow(r, hi)) * 64 + 32 * eb + r32] = acc[r] * g127;
    }
    for (int p = tid; p < 1024; p += NTHR) { const int e = p >> 4, jc = p & 15; *(v4u*)(VT + (size_t)u * 8192 + e * 128 + 8 * jc) = *(const LAS v4u*)(Vt + e * TJ + 8 * jc); }
    __syncthreads();
}

__device__ __forceinline__ void retout_seg(LAS unsigned char* lds, const bf16* U, const float* KV, const bf16* VT, const float* gn, bf16* MIX, int wg, int tid, int lane, int wave) {
    const int b = wg >> 5, h = (wg >> 3) & 3, seg = wg & 7, n0 = 4 * seg;
    const float lg = log2f(1.0f - exp2f(-5.0f - (float)h));
    {
        const float decay = exp2f(lg * 128.0f), gam = exp2f(lg);
        const int d = tid >> 3, e0 = (tid & 7) * 8;
        f32x4 s0 = (f32x4){0.f, 0.f, 0.f, 0.f}, s1 = s0;
        const float* kvb = KV + ((size_t)(b * 32) * 4 + h) * 4096 + d * 64 + e0;
        for (int m = 0; m < n0; m += 4) { f32x4 t[4][2];
#pragma unroll
            for (int mm = 0; mm < 4; ++mm) { const f32x4* p = (const f32x4*)(kvb + (size_t)(m + mm) * 4 * 4096); t[mm][0] = p[0]; t[mm][1] = p[1]; }
#pragma unroll
            for (int mm = 0; mm < 4; ++mm) { s0 = s0 * decay + t[mm][0]; s1 = s1 * decay + t[mm][1]; } }
        f32x4 t[3][2];
#pragma unroll
        for (int c = 0; c < 3; ++c) { const f32x4* p = (const f32x4*)(kvb + (size_t)(n0 + c) * 4 * 4096); t[c][0] = p[0]; t[c][1] = p[1]; }
#pragma unroll
        for (int c = 0; c < 4; ++c) {
            LAS bf16* St = (LAS bf16*)(lds + c * (64 * TS * 2));
#pragma unroll
            for (int q = 0; q < 4; ++q) { St[(e0 + q) * TS + d] = (bf16)f2bf(s0[q] * gam); St[(e0 + 4 + q) * TS + d] = (bf16)f2bf(s1[q] * gam); }
            if (c < 3) { s0 = s0 * decay + t[c][0]; s1 = s1 * decay + t[c][1]; }
        }
    }
    __syncthreads();
    const int half = wave >> 2, ib = wave & 3, r32 = lane & 31, hi = lane >> 5;
#pragma unroll 1
    for (int pr = 0; pr < 2; ++pr) {
        const int n = n0 + 2 * pr + half, u = (b * 32 + n) * 4 + h;
        const LAS bf16* St = (const LAS bf16*)(lds + (2 * pr + half) * (64 * TS * 2));
        const size_t row0 = (size_t)b * SEQ + n * 128;
        const bf16* qp = U + (row0 + 32 * ib + r32) * NU + 1024 + 64 * h + 8 * hi;
        bf16x8 qf[4];
#pragma unroll
        for (int d0 = 0; d0 < 4; ++d0) qf[d0] = *(const bf16x8*)(qp + 16 * d0);
        f32x16 o[2];
#pragma unroll
        for (int r = 0; r < 16; ++r) { o[0][r] = 0.f; o[1][r] = 0.f; }
#pragma unroll
        for (int d0 = 0; d0 < 4; ++d0)
#pragma unroll
            for (int eb = 0; eb < 2; ++eb) { const bf16x8 A = *(const LAS bf16x8*)(St + (32 * eb + r32) * TS + 16 * d0 + 8 * hi); o[eb] = __builtin_amdgcn_mfma_f32_32x32x16_bf16(A, qf[d0], o[eb], 0, 0, 0); }
        const bf16* vtb = VT + (size_t)u * 8192;
        for (int jb = 0; jb <= ib; ++jb) {
            const bf16* kp = U + (row0 + 32 * jb + r32) * NU + 1280 + 64 * h + 8 * hi;
            f32x16 st;
#pragma unroll
            for (int r = 0; r < 16; ++r) st[r] = 0.f;
#pragma unroll
            for (int d0 = 0; d0 < 4; ++d0) st = __builtin_amdgcn_mfma_f32_32x32x16_bf16(*(const bf16x8*)(kp + 16 * d0), qf[d0], st, 0, 0, 0);
            if (jb == ib) {
#pragma unroll
                for (int r = 0; r < 16; ++r) if (crow(r, hi) > r32) st[r] = 0.f;
            }
#pragma unroll
            for (int k = 0; k < 2; ++k) {
                v4u pbw; pbw.x = pk2(st[8 * k], st[8 * k + 1]); pbw.y = pk2(st[8 * k + 2], st[8 * k + 3]); pbw.z = pk2(st[8 * k + 4], st[8 * k + 5]); pbw.w = pk2(st[8 * k + 6], st[8 * k + 7]);
                const bf16x8 pb = __builtin_bit_cast(bf16x8, pbw);
#pragma unroll
                for (int eb = 0; eb < 2; ++eb) {
                    const bf16* vp = vtb + (32 * eb + r32) * 128 + 32 * jb + 16 * k + 4 * hi;
                    const v2u lo = *(const v2u*)vp, hh = *(const v2u*)(vp + 8);
                    const bf16x8 A = __builtin_bit_cast(bf16x8, (v4u){lo.x, lo.y, hh.x, hh.y});
                    o[eb] = __builtin_amdgcn_mfma_f32_32x32x16_bf16(A, pb, o[eb], 0, 0, 0);
                }
            }
        }
        float sum = 0.f;
#pragma unroll
        for (int r = 0; r < 16; ++r) sum += o[0][r] + o[1][r];
        sum += __shfl_xor(sum, 32);
        const float mu = sum * (1.0f / 64.0f);
        float var = 0.f;
#pragma unroll
        for (int r = 0; r < 16; ++r) { const float d0 = o[0][r] - mu, d1 = o[1][r] - mu; var += d0 * d0 + d1 * d1; }
        var += __shfl_xor(var, 32);
        const float rstd = 1.0f / sqrtf(var * (1.0f / 64.0f) + EPS);
        const size_t tok = row0 + 32 * ib + r32;
        const bf16* gp = U + tok * NU + 1792 + 64 * h;
        bf16* op = MIX + tok * 1024 + 512 + 64 * h;
#pragma unroll
        for (int eb = 0; eb < 2; ++eb)
#pragma unroll
            for (int g4 = 0; g4 < 4; ++g4) {
                const int e = 32 * eb + 8 * g4 + 4 * hi;
                const v2u gw = *(const v2u*)(gp + e); const f32x4 gg = *(const f32x4*)(gn + 64 * h + e);
                float y[4];
#pragma unroll
                for (int c = 0; c < 4; ++c) y[c] = siluf(bfe2(gw, c)) * ((o[eb][4 * g4 + c] - mu) * rstd * gg[c]);
                v2u ov; ov.x = pk2(y[0], y[1]); ov.y = pk2(y[2], y[3]);
                *(v2u*)(op + e) = ov;
            }
    }
    __syncthreads();
}

struct Args { const void* in[21]; float* out; unsigned char* ws; };
__global__ void __launch_bounds__(NTHR, 2) fwd_kernel(Args a) {
    extern __shared__ __attribute__((aligned(16))) unsigned char lds_raw[];
    cg::grid_group grid = cg::this_grid();
    LAS unsigned char* lds = (LAS unsigned char*)lds_raw;
    int tid = threadIdx.x, lane = tid & 63, wave = __builtin_amdgcn_readfirstlane(tid >> 6);
    const int G = gridDim.x; int bx = blockIdx.x;
    int vcu = (G % 8 == 0) ? (bx % 8) * (G / 8) + bx / 8 : bx;
#define RELAUNDER() do { tid = threadIdx.x; asm volatile("" : "+v"(tid)); lane = tid & 63; wave = __builtin_amdgcn_readfirstlane(tid >> 6); bx = blockIdx.x; asm volatile("" : "+s"(bx)); vcu = (G % 8 == 0) ? (bx % 8) * (G / 8) + bx / 8 : bx; } while (0)
    const float* xin = (const float*)a.in[0]; const float* cin = (const float*)a.in[1]; const int* positions = (const int*)a.in[2];
    const float* ada_w = (const float*)a.in[3]; const float* ada_b = (const float*)a.in[4];
    const float* norm_mix_g = (const float*)a.in[5]; const float* norm_ffn_g = (const float*)a.in[6];
    const float* w_in = (const float*)a.in[7]; const float* fox_fb = (const float*)a.in[8];
    const float* pool_w = (const float*)a.in[9]; const float* pool_scale = (const float*)a.in[10]; const float* ret_gn_g = (const float*)a.in[11];
    const float* conv_w = (const float*)a.in[12]; const float* conv_b = (const float*)a.in[13]; const float* conv_ln_g = (const float*)a.in[14]; const float* conv_ln_b = (const float*)a.in[15];
    const float* w_out = (const float*)a.in[16]; const float* ffn_w1 = (const float*)a.in[17]; const float* ffn_w3 = (const float*)a.in[18]; const float* ffn_w2 = (const float*)a.in[19];
    const float* final_g = (const float*)a.in[20];
    float* out = a.out; unsigned char* ws = a.ws;
    float* mod = (float*)(ws + WS_MOD); float* cumL = (float*)(ws + WS_CUM); float* ffb = (float*)(ws + WS_FF);
    bf16* WB = (bf16*)(ws + WS_W); bf16* H = (bf16*)(ws + WS_H); bf16* U = (bf16*)(ws + WS_U); bf16* MIX = (bf16*)(ws + WS_MIX); bf16* HID = (bf16*)(ws + WS_HID);
    float* KV = (float*)(ws + WS_KV); bf16* VT = (bf16*)(ws + WS_VT);
    volatile LAS unsigned* MISC = (volatile LAS unsigned*)(lds + 131072 + 320);
    if (tid < 32) MISC[tid] = 0u;
    __syncthreads();
    const XcdBarrier xbar = xcd_barrier_post((unsigned*)ws, MISC + 8);
#define GRID_BAR() do { XcdBarrier xb_ = xbar; asm volatile("" : "+s"(xb_.bar), "+s"(xb_.x)); xcd_barrier(xb_); } while (0)

    if (PH_PRO) {
        LAS float* scr = (LAS float*)(lds + wave * 16384);
        const int gw = bx * NWAVES + wave, NGW = G * NWAVES;
        for (int it = gw; it < DEPTH * 6016; it += NGW) {
            const int l = it / 6016; int r = it - l * 6016;
            bf16* wl = WB + (size_t)l * W_LAYER;
            if (r < 1280) { const int kb = r / 80, n0 = 32 * (r % 80);
                if (n0 >= 768 && n0 < 1024) { poolfold_item(w_in + (size_t)l * 1024 * NIN, pool_w + (size_t)l * 4 * 4096, pool_scale + l * 256, 64 * kb, n0, wl + WOFF_IN, scr, lane); continue; }
                transpose_item(w_in + (size_t)l * 1024 * NIN, NIN, 64 * kb, n0 + (n0 >= 768 ? 4 : 0), wl + WOFF_IN, 1024, n0, scr, lane); continue; } r -= 1280;
            if (r < 512) { const int kb = r / 32, n0 = 32 * (r % 32); transpose_item(w_out + (size_t)l * 1024 * 1024, 1024, 64 * kb, n0, wl + WOFF_OUT, 1024, n0, scr, lane); continue; } r -= 512;
            if (r < 1408) { const int kb = r / 88, n0 = 32 * (r % 88); transpose_item(ffn_w1 + (size_t)l * 1024 * DFF, DFF, 64 * kb, n0, wl + WOFF_13, 1024, (n0 / 128) * 256 + (n0 % 128), scr, lane); continue; } r -= 1408;
            if (r < 1408) { const int kb = r / 88, n0 = 32 * (r % 88); transpose_item(ffn_w3 + (size_t)l * 1024 * DFF, DFF, 64 * kb, n0, wl + WOFF_13, 1024, (n0 / 128) * 256 + 128 + (n0 % 128), scr, lane); continue; } r -= 1408;
            { const int kb = r / 32, n0 = 32 * (r % 32); transpose_item(ffn_w2 + (size_t)l * DFF * 1024, 1024, 64 * kb, n0, wl + WOFF_2, DFF, n0, scr, lane); }
        }
    }
    __syncthreads();
    if (PH_PRO) {
        LAS float* cact = (LAS float*)lds;
        LAS float* part = (LAS float*)(lds + 32768);
        for (int i = tid; i < BATCH * 1024; i += NTHR) { const float v = cin[i]; cact[i] = v / (1.0f + expf(-v)); }
        __syncthreads();
        for (int ch = bx; ch < DEPTH * 96; ch += G) {
            const int l = ch / 96, n0 = (ch % 96) * 64;
            const float* wp = ada_w + ((size_t)l * 1024 + wave * 128) * MODW + n0 + lane;
            float acc[8];
#pragma unroll
            for (int b = 0; b < 8; ++b) acc[b] = 0.f;
#pragma unroll 4
            for (int k = 0; k < 128; k += 4) {
                const float w0 = wp[(size_t)k * MODW], w1 = wp[(size_t)(k + 1) * MODW], w2 = wp[(size_t)(k + 2) * MODW], w3 = wp[(size_t)(k + 3) * MODW];
#pragma unroll
                for (int b = 0; b < 8; ++b) { const f32x4 cv = *(const LAS f32x4*)(cact + b * 1024 + wave * 128 + k); acc[b] += (cv.x * w0 + cv.y * w1) + (cv.z * w2 + cv.w * w3); }
            }
#pragma unroll
            for (int b = 0; b < 8; ++b) part[(wave * 8 + b) * 64 + lane] = acc[b];
            __syncthreads();
            { float s = ada_b[(size_t)l * MODW + n0 + lane];
#pragma unroll
              for (int ww = 0; ww < 8; ++ww) s += part[(ww * 8 + wave) * 64 + lane];
              mod[((size_t)l * 8 + wave) * MODW + n0 + lane] = s; }
            __syncthreads();
        }
    }
    if (a.ws == nullptr) grid.sync();
    GRID_BAR(); RELAUNDER();

    for (int l = 0; l < DEPTH; ++l) {
        const float* modl = mod + (size_t)l * 8 * MODW;
        bf16* wl = WB + (size_t)l * W_LAYER;
        const float* xcur = (l == 0) ? xin : out;
        for (int rp = 0; rp < REP_NORM; ++rp) norm_phase<true>(lds, xcur, norm_mix_g + l * 1024, modl + 1024, modl, H, w_in + (size_t)l * 1024 * NIN + 768, ffb, bx, G, tid, lane, wave);
        GRID_BAR(); RELAUNDER();
        if (PH_GIN) {
            if (bx < 32) cum_scan(lds, ffb, fox_fb + l * 4, cumL, bx, tid, lane, wave);
            __syncthreads();
            pg8::Gemm g{H, wl + WOFF_IN, MROWS, NU, 1024}; pg8::StaticOrder S; S.init(MROWS, NU, G, bx);
            pg8::EpiU E{U, NU, attn_body::C2};
            for (int rp = 0; rp < REP_GIN; ++rp) pg8::gemm_phase<pg8::EpiU, pg8::StaticOrder, true, true>(lds, g, S, E);
        }
        GRID_BAR(); RELAUNDER();
        for (int rp = 0; rp < REP_C1; ++rp) for (int u = vcu; u < 256; u += G) pool_unit(U, MIX, u, tid);
        RELAUNDER();
        for (int rp = 0; rp < REP_C1; ++rp) for (int u = vcu; u < 512; u += G) conv_unit(lds, U, conv_w + (size_t)l * 31 * 256, conv_b + l * 256, conv_ln_g + l * 256, conv_ln_b + l * 256, MIX, u, tid, lane, wave);
        RELAUNDER();
        for (int rp = REP_RKV - 1; rp >= 0; --rp) for (int u = vcu; u < 1024; u += G) retkv_unit(lds, U, positions, KV, VT, u, tid, lane, wave, rp == 0);
        GRID_BAR(); RELAUNDER();
        for (int rp = 0; rp < REP_ATT; ++rp) {
            const attn_body::AttnTensors AT{(const attn_body::bf16*)U, (const attn_body::bf16*)(U + 256), (const attn_body::bf16*)(U + 512), (attn_body::bf16*)MIX, cumL};
            const attn_body::StaticOrder S(G, bx);
            attn_body::attn_phase<attn_body::StaticOrder>((char*)lds_raw, AT, S);
        }
        __syncthreads(); RELAUNDER();
        for (int rp = 0; rp < REP_RET; ++rp) for (int wg = vcu; wg < 256; wg += G) retout_seg(lds, U, KV, VT, ret_gn_g + l * 256, MIX, wg, tid, lane, wave);
        GRID_BAR(); RELAUNDER();
        if (PH_GOUT) {
            pg8::Gemm g{MIX, wl + WOFF_OUT, MROWS, 1024, 1024}; pg8::StaticOrder S; S.init(MROWS, 1024, G, bx);
            for (int rp = REP_GRES - 1; rp >= 0; --rp) { pg8::EpiRes E{xcur, out, modl + 2048, rp ? 0.f : 1.f};
            pg8::gemm_phase<pg8::EpiRes, pg8::StaticOrder, false, true>(lds, g, S, E); }
        }
        GRID_BAR(); RELAUNDER();
        for (int rp = 0; rp < REP_NORM; ++rp) norm_phase<false>(lds, out, norm_ffn_g + l * 1024, modl + 4096, modl + 3072, H, nullptr, nullptr, bx, G, tid, lane, wave);
        GRID_BAR(); RELAUNDER();
        if (PH_GUP) {
            pg8::Gemm g{H, wl + WOFF_13, MROWS, NH2, 1024}; pg8::StaticOrder S; S.init(MROWS, NH2, G, bx);
            pg8::EpiSwiGLU E{HID, DFF};
            for (int rp = 0; rp < REP_GUP; ++rp) pg8::gemm_phase<pg8::EpiSwiGLU, pg8::StaticOrder, true, true>(lds, g, S, E);
        }
        GRID_BAR(); RELAUNDER();
        if (PH_GDN) {
            pg8::Gemm g{HID, wl + WOFF_2, MROWS, 1024, DFF}; pg8::StaticOrder S; S.init(MROWS, 1024, G, bx);
            for (int rp = REP_GRES - 1; rp >= 0; --rp) { pg8::EpiRes E{out, out, modl + 5120, rp ? 0.f : 1.f};
            pg8::gemm_phase<pg8::EpiRes, pg8::StaticOrder, false, true>(lds, g, S, E); }
        }
        GRID_BAR(); RELAUNDER();
    }
    {
        const int gw = bx * NWAVES + wave, NGW = G * NWAVES;
        for (int row = gw; row < MROWS; row += NGW) {
            f32x4* xr = (f32x4*)(out + (size_t)row * 1024) + lane;
            f32x4 v[4]; float ss = 0.f;
#pragma unroll
            for (int j = 0; j < 4; ++j) { v[j] = xr[64 * j]; ss += (v[j].x * v[j].x + v[j].y * v[j].y) + (v[j].z * v[j].z + v[j].w * v[j].w); }
            ss = wave_sum(ss);
            const float rstd = 1.0f / sqrtf(ss * (1.0f / 1024.0f) + EPS);
#pragma unroll
            for (int j = 0; j < 4; ++j) xr[64 * j] = v[j] * rstd * ((const f32x4*)final_g)[lane + 64 * j];
        }
    }
}

extern "C" void kernel_launch(void* const* d_in, const int* in_sizes, int n_in, void* d_out, int out_size, void* d_ws, size_t ws_size, hipStream_t stream) {
    static int grid = 0;
    if (grid == 0) {
        if (n_in != 21 || out_size != MROWS * 1024 || ws_size < WS_END) { fprintf(stderr, "kernel_launch: unexpected shapes: n_in %d out %d ws %zu (need %zu)\n", n_in, out_size, ws_size, (size_t)WS_END); grid = -1; return; }
        int dev = 0, cus = 0, per_cu = 0;
        hipGetDevice(&dev); hipDeviceGetAttribute(&cus, hipDeviceAttributeMultiprocessorCount, dev);
        if (hipFuncSetAttribute((const void*)fwd_kernel, hipFuncAttributeMaxDynamicSharedMemorySize, LDS_BYTES) != hipSuccess) { fprintf(stderr, "kernel_launch: hipFuncSetAttribute failed\n"); grid = -1; return; }
        if (hipOccupancyMaxActiveBlocksPerMultiprocessor(&per_cu, (const void*)fwd_kernel, NTHR, LDS_BYTES) != hipSuccess || per_cu < 1) { fprintf(stderr, "kernel_launch: occupancy query says %d\n", per_cu); per_cu = 1; }
        (void)hipGetLastError();
        grid = cus;
        if (grid != 256) fprintf(stderr, "kernel_launch: %d CUs; the attention deal assumes 256\n", grid);
    }
    if (grid < 0) return;
    if (hipMemsetAsync(d_ws, 0, 65536, stream) != hipSuccess) { fprintf(stderr, "kernel_launch: hipMemsetAsync failed\n"); return; }
    Args a{};
    for (int i = 0; i < 21; ++i) a.in[i] = d_in[i];
    a.out = (float*)d_out; a.ws = (unsigned char*)d_ws;
    void* args[] = {&a};
    hipError_t e = hipLaunchCooperativeKernel((const void*)fwd_kernel, dim3(grid), dim3(NTHR), args, LDS_BYTES, stream);
    if (e != hipSuccess) fprintf(stderr, "kernel_launch: cooperative launch failed: %s (grid %d)\n", hipGetErrorString(e), grid);
}
```
